# Optimizing an MI355X kernel written in HIP

```python
import math
import jax, jax.numpy as jnp
from jax import lax
import numpy as np

D_MODEL = 2048
BATCH = 4
SEQ = 2048
DEPTH = 1

MIX_WIDTH = D_MODEL
ATTN_WIDTH = MIX_WIDTH // 2
SSM_WIDTH = MIX_WIDTH - ATTN_WIDTH
ATTN_HEAD_DIM = 64
ATTN_VALUE_DIM = 2 * ATTN_HEAD_DIM
ATTN_HEADS = ATTN_WIDTH // ATTN_VALUE_DIM
SSM_GROUP = 16
SSM_GROUPS = SSM_WIDTH // SSM_GROUP
SSM_STATE = 64
D_FF = ((8 * D_MODEL // 3 + 255) // 256) * 256
IN_COLS = 3 * ATTN_WIDTH + SSM_WIDTH
QBLOCK = 128
NORM_EPS = 1e-6
DT_MIN = 1e-3
DT_MAX = 1e-1

kernel_name = "hybrid_diffattn_s5_macaron_encoder"


def rms_norm(x, g):
    xf = x.astype(jnp.float32)
    y = xf * lax.rsqrt(jnp.mean(xf * xf, axis=-1, keepdims=True) + NORM_EPS)
    return (y * g.astype(jnp.float32)).astype(x.dtype)


def swiglu(x, w_gate, w_up, w_down):
    return (jax.nn.silu(x @ w_gate) * (x @ w_up)) @ w_down


def alibi_slopes():
    h = np.arange(ATTN_HEADS) + 1
    return jnp.asarray(2.0 ** (-8.0 * h / ATTN_HEADS), dtype=jnp.float32)


def diff_attention(q, k, v, lam, slopes):
    B, S, H, _, dh = q.shape
    nblk = S // QBLOCK
    qb = (q * (dh ** -0.5)).reshape(B, nblk, QBLOCK, H, 2, dh).transpose(1, 0, 2, 3, 4, 5)
    starts = jnp.arange(nblk, dtype=jnp.int32) * QBLOCK
    kpos = jnp.arange(S, dtype=jnp.int32)

    def block(args):
        qblk, start = args
        s = jnp.einsum('bqhcd,bkhcd->bhcqk', qblk, k).astype(jnp.float32)
        qpos = start + jnp.arange(QBLOCK, dtype=jnp.int32)
        dist = jnp.abs(qpos[:, None] - kpos[None, :]).astype(jnp.float32)
        s = s - slopes[None, :, None, None, None] * dist[None, None, None]
        p = jax.nn.softmax(s, axis=-1)
        w = p[:, :, 0] - lam * p[:, :, 1]
        return jnp.einsum('bhqk,bkhe->bqhe', w.astype(v.dtype), v)

    out = lax.map(block, (qb, starts))
    return out.transpose(1, 0, 2, 3, 4).reshape(B, S, H, v.shape[-1])


def _complex_affine_combine(e1, e2):
    a1r, a1i, x1r, x1i = e1
    a2r, a2i, x2r, x2i = e2
    return (a2r * a1r - a2i * a1i,
            a2r * a1i + a2i * a1r,
            a2r * x1r - a2i * x1i + x2r,
            a2r * x1i + a2i * x1r + x2i)


def s5_direction(u, lam_re, lam_im, log_dt, b_re, b_im, c_re, c_im, reverse):
    f32 = jnp.float32
    lam_re = lam_re.astype(f32); lam_im = lam_im.astype(f32)
    dt = jnp.exp(log_dt.astype(f32))[:, None]
    mag = jnp.exp(lam_re * dt)
    a_re = mag * jnp.cos(lam_im * dt)
    a_im = mag * jnp.sin(lam_im * dt)
    den = lam_re * lam_re + lam_im * lam_im
    nr = a_re - 1.0
    f_re = (nr * lam_re + a_im * lam_im) / den
    f_im = (a_im * lam_re - nr * lam_im) / den
    b_re = b_re.astype(f32); b_im = b_im.astype(f32)
    bb_re = f_re[..., None] * b_re - f_im[..., None] * b_im
    bb_im = f_re[..., None] * b_im + f_im[..., None] * b_re
    bu_re = jnp.einsum('bsgp,gnp->bsgn', u, bb_re)
    bu_im = jnp.einsum('bsgp,gnp->bsgn', u, bb_im)
    ar = jnp.broadcast_to(a_re, bu_re.shape)
    ai = jnp.broadcast_to(a_im, bu_re.shape)
    _, _, h_re, h_im = lax.associative_scan(
        _complex_affine_combine, (ar, ai, bu_re, bu_im), reverse=reverse, axis=1)
    return (jnp.einsum('gpn,bsgn->bsgp', c_re.astype(f32), h_re)
            - jnp.einsum('gpn,bsgn->bsgp', c_im.astype(f32), h_im))


def s5_mixer(u, lam_re, lam_im, log_dt, b_re, b_im, c_re, c_im, d, w_glu, b_glu, out_g):
    B, S, _ = u.shape
    uf = u.astype(jnp.float32).reshape(B, S, SSM_GROUPS, SSM_GROUP)
    y = (s5_direction(uf, lam_re[0], lam_im[0], log_dt[0], b_re[0], b_im[0], c_re[0], c_im[0], False)
         + s5_direction(uf, lam_re[1], lam_im[1], log_dt[1], b_re[1], b_im[1], c_re[1], c_im[1], True)
         + d.astype(jnp.float32) * uf)
    y = y.reshape(B, S, SSM_WIDTH).astype(u.dtype)
    g = jax.nn.gelu(y)
    g = g * jax.nn.sigmoid(g @ w_glu + b_glu)
    return rms_norm(g, out_g)


def setup_inputs(seed: int = 0) -> dict:
    key = jax.random.key(seed)
    ks = iter(jax.random.split(key, 40))
    f32 = jnp.float32

    def nrm(shape, scale):
        return jax.random.normal(next(ks), shape, f32) * scale

    def gain(shape):
        return 1.0 + nrm(shape, 0.02)

    L, G, N, P = DEPTH, SSM_GROUPS, SSM_STATE, SSM_GROUP
    n_idx = jnp.arange(N, dtype=f32)
    return {
        "x": nrm((BATCH, SEQ, D_MODEL), 1.0),
        "ff1_pre_g": gain((L, D_MODEL)),
        "ff1_w_gate": nrm((L, D_MODEL, D_FF), D_MODEL ** -0.5),
        "ff1_w_up": nrm((L, D_MODEL, D_FF), D_MODEL ** -0.5),
        "ff1_w_down": nrm((L, D_FF, D_MODEL), D_FF ** -0.5),
        "ff1_post_g": gain((L, D_MODEL)),
        "mix_pre_g": gain((L, D_MODEL)),
        "w_in": nrm((L, D_MODEL, IN_COLS), D_MODEL ** -0.5),
        "lam_q1": nrm((L, ATTN_HEAD_DIM), 0.1),
        "lam_k1": nrm((L, ATTN_HEAD_DIM), 0.1),
        "lam_q2": nrm((L, ATTN_HEAD_DIM), 0.1),
        "lam_k2": nrm((L, ATTN_HEAD_DIM), 0.1),
        "attn_head_g": gain((L, ATTN_VALUE_DIM)),
        "ssm_lam_re": -0.5 + nrm((L, 2, G, N), 0.01),
        "ssm_lam_im": jnp.pi * n_idx + nrm((L, 2, G, N), 0.01),
        "ssm_log_dt": jax.random.uniform(next(ks), (L, 2, G), f32, math.log(DT_MIN), math.log(DT_MAX)),
        "ssm_b_re": nrm((L, 2, G, N, P), P ** -0.5),
        "ssm_b_im": nrm((L, 2, G, N, P), P ** -0.5),
        "ssm_c_re": nrm((L, 2, G, P, N), N ** -0.5),
        "ssm_c_im": nrm((L, 2, G, P, N), N ** -0.5),
        "ssm_d": nrm((L, G, P), 0.5),
        "ssm_w_glu": nrm((L, SSM_WIDTH, SSM_WIDTH), SSM_WIDTH ** -0.5),
        "ssm_b_glu": nrm((L, SSM_WIDTH), 0.01),
        "ssm_out_g": gain((L, SSM_WIDTH)),
        "w_out": nrm((L, MIX_WIDTH, D_MODEL), MIX_WIDTH ** -0.5),
        "mix_post_g": gain((L, D_MODEL)),
        "ff2_pre_g": gain((L, D_MODEL)),
        "ff2_w_gate": nrm((L, D_MODEL, D_FF), D_MODEL ** -0.5),
        "ff2_w_up": nrm((L, D_MODEL, D_FF), D_MODEL ** -0.5),
        "ff2_w_down": nrm((L, D_FF, D_MODEL), D_FF ** -0.5),
        "ff2_post_g": gain((L, D_MODEL)),
    }


def reference(x, ff1_pre_g, ff1_w_gate, ff1_w_up, ff1_w_down, ff1_post_g,
              mix_pre_g, w_in, lam_q1, lam_k1, lam_q2, lam_k2, attn_head_g,
              ssm_lam_re, ssm_lam_im, ssm_log_dt, ssm_b_re, ssm_b_im, ssm_c_re, ssm_c_im,
              ssm_d, ssm_w_glu, ssm_b_glu, ssm_out_g, w_out, mix_post_g,
              ff2_pre_g, ff2_w_gate, ff2_w_up, ff2_w_down, ff2_post_g):
    B, S, _ = x.shape
    slopes = alibi_slopes()
    f32 = jnp.float32
    for l in range(DEPTH):
        h = rms_norm(x, ff1_pre_g[l])
        x = x + 0.5 * rms_norm(swiglu(h, ff1_w_gate[l], ff1_w_up[l], ff1_w_down[l]), ff1_post_g[l])

        h = rms_norm(x, mix_pre_g[l])
        proj = h @ w_in[l]
        q, k, v, u = jnp.split(proj, [ATTN_WIDTH, 2 * ATTN_WIDTH, 3 * ATTN_WIDTH], axis=-1)
        q = q.reshape(B, S, ATTN_HEADS, 2, ATTN_HEAD_DIM)
        k = k.reshape(B, S, ATTN_HEADS, 2, ATTN_HEAD_DIM)
        v = v.reshape(B, S, ATTN_HEADS, ATTN_VALUE_DIM)
        lam_init = 0.8 - 0.6 * math.exp(-0.3 * l)
        lam = (jnp.exp(jnp.sum(lam_q1[l].astype(f32) * lam_k1[l].astype(f32)))
               - jnp.exp(jnp.sum(lam_q2[l].astype(f32) * lam_k2[l].astype(f32))) + lam_init)
        a = diff_attention(q, k, v, lam, slopes)
        a = (rms_norm(a, attn_head_g[l]) * (1.0 - lam_init)).reshape(B, S, ATTN_WIDTH)
        s = s5_mixer(u, ssm_lam_re[l], ssm_lam_im[l], ssm_log_dt[l], ssm_b_re[l], ssm_b_im[l],
                     ssm_c_re[l], ssm_c_im[l], ssm_d[l], ssm_w_glu[l], ssm_b_glu[l], ssm_out_g[l])
        mixed = jnp.concatenate([a, s], axis=-1) @ w_out[l]
        x = x + rms_norm(mixed, mix_post_g[l])

        h = rms_norm(x, ff2_pre_g[l])
        x = x + 0.5 * rms_norm(swiglu(h, ff2_w_gate[l], ff2_w_up[l], ff2_w_down[l]), ff2_post_g[l])
    return x
```

```cpp
#include <hip/hip_runtime.h>
#include <hip/hip_cooperative_groups.h>
#include <cstdio>
#include <cstdint>
namespace cg = cooperative_groups;
#ifndef MK_N_LAUNCHES
#define MK_N_LAUNCHES 1
#endif
namespace pg8 {
#define PG8_LAS __attribute__((address_space(3)))
typedef unsigned short bf16_t;
typedef short bf16x8 __attribute__((ext_vector_type(8)));
typedef float f32x4 __attribute__((ext_vector_type(4)));
typedef unsigned u32x4 __attribute__((ext_vector_type(4)));
constexpr int BM = 256, BK = 64, HALF = 128, HTB = HALF * BK * 2  , STAGE_BYTES = 8 * HTB, NXCD = 8, WGM = 8;

__host__ __device__ __forceinline__ int lds_byte(int r, int c) { const int st = (r >> 4) * 2 + (c >> 5), rr = r & 15, cc = c & 31, ob = rr * 64 + cc * 2; return st * 1024 + (ob ^ (((ob >> 9) & 1) << 5)); }
__host__ __device__ __forceinline__ void stage_rc(int b, int& R, int& C) { const int st = b / 1024, sb = b % 1024, swz = sb ^ (((sb >> 9) & 1) << 5); R = (st >> 1) * 16 + swz / 64; C = (st & 1) * 32 + (swz % 64) / 2; }
__host__ __device__ __forceinline__ int perm32(int rho) { const int n = rho >> 4, i = rho & 15; return 8 * (i >> 2) + 4 * n + (i & 3); }

struct Unit { int pm, pn; };
struct Gemm { const bf16_t* A; const bf16_t* Bt; int M, N, K; };

struct StaticOrder {
    int nM, nN, nwg, G, c;
    __host__ __device__ void init(int M, int N, int G_, int c_) { nM = M / BM; nN = N / BM; nwg = nM * nN; G = G_; c = c_; }
    __host__ __device__ bool next(int i, Unit& u) const {
        const long L = (long)i * G + c; if (L >= nwg) return false;
        int wgid = (int)L; { const int q = nwg / NXCD, r = nwg % NXCD, xcd = wgid % NXCD, off = wgid / NXCD; wgid = (xcd < r ? xcd * (q + 1) : r * (q + 1) + (xcd - r) * q) + off; }
        const int nig = WGM * nN, gid = wgid / nig, fm = gid * WGM, gsz = (nM - fm) < WGM ? (nM - fm) : WGM;
        u.pm = fm + ((wgid % nig) % gsz); u.pn = (wgid % nig) / gsz; return true;
    }
    __device__ __forceinline__ void a_ready(const Unit&) const {}
    __device__ __forceinline__ void done(const Unit&) const {}
};

__device__ __forceinline__ unsigned cvt_pk_bf16(float lo, float hi) { unsigned r; asm volatile("v_cvt_pk_bf16_f32 %0, %1, %2" : "=v"(r) : "v"(lo), "v"(hi)); return r; }
typedef unsigned u32x2 __attribute__((ext_vector_type(2)));
__device__ __forceinline__ float bf_lo(unsigned w) { return __uint_as_float(w << 16); }
__device__ __forceinline__ float bf_hi(unsigned w) { return __uint_as_float(w & 0xffff0000u); }
__device__ __forceinline__ float sigmoid_f(float z) { return __builtin_amdgcn_rcpf(1.0f + __builtin_amdgcn_exp2f(-1.4426950408889634f * z)); }
__device__ __forceinline__ float silu_f(float z) { return z * sigmoid_f(z); }

struct EpiSwiGLU {
    static constexpr bool PERM = true, AFTER_DRAIN = false;
    bf16_t* O; int ldc;
    __device__ __forceinline__ void operator()(const f32x4 (&acc)[2][2][4][2], const Unit& u, int wr, int wc, int fr, int fq) const {
        const int row0 = u.pm * BM + wr * 64 + fr, col0 = u.pn * HALF + wc * 32 + 8 * fq;
#pragma unroll
        for (int ai = 0; ai < 2; ++ai)
#pragma unroll
            for (int m = 0; m < 4; ++m) {
                bf16_t* rowp = O + (size_t)(row0 + ai * HALF + m * 16) * ldc + col0;
                const f32x4 g0 = acc[ai][0][m][0], g1 = acc[ai][0][m][1], u0 = acc[ai][1][m][0], u1 = acc[ai][1][m][1];
                u32x4 w;
                w.x = cvt_pk_bf16(silu_f(g0[0]) * u0[0], silu_f(g0[1]) * u0[1]); w.y = cvt_pk_bf16(silu_f(g0[2]) * u0[2], silu_f(g0[3]) * u0[3]);
                w.z = cvt_pk_bf16(silu_f(g1[0]) * u1[0], silu_f(g1[1]) * u1[1]); w.w = cvt_pk_bf16(silu_f(g1[2]) * u1[2], silu_f(g1[3]) * u1[3]);
                *(u32x4*)rowp = w;
            }
    }
};
struct EpiQKVU {
    static constexpr bool PERM = true, AFTER_DRAIN = false;
    bf16_t* QKV; bf16_t* UG; float qscale;
    __device__ __forceinline__ void operator()(const f32x4 (&acc)[2][2][4][2], const Unit& u, int wr, int wc, int fr, int fq) const {
        const int row0 = u.pm * BM + wr * 64 + fr, colt = u.pn * BM;
        const float sc = colt < 1024 ? qscale : 1.0f;
#pragma unroll
        for (int ai = 0; ai < 2; ++ai)
#pragma unroll
            for (int m = 0; m < 4; ++m) {
                const int row = row0 + ai * HALF + m * 16;
#pragma unroll
                for (int bj = 0; bj < 2; ++bj) {
                    const int col = colt + bj * HALF + wc * 32 + 8 * fq;
                    const f32x4 v0 = acc[ai][bj][m][0] * sc, v1 = acc[ai][bj][m][1] * sc;
                    u32x4 w; w.x = cvt_pk_bf16(v0[0], v0[1]); w.y = cvt_pk_bf16(v0[2], v0[3]); w.z = cvt_pk_bf16(v1[0], v1[1]); w.w = cvt_pk_bf16(v1[2], v1[3]);
                    bf16_t* dst;
                    if (colt < 3072) dst = QKV + (size_t)row * 3072 + col;
                    else { const int cc = col - 3072; dst = UG + ((size_t)((cc >> 4) * 512 + (row >> 4)) * 256 + (row & 15) * 16 + (cc & 15)); }
                    *(u32x4*)dst = w;
                }
            }
    }
};
struct EpiYSsq {
    static constexpr bool PERM = false, AFTER_DRAIN = false;
    float* Y; float* SSQ; int npart;
    __device__ __forceinline__ void operator()(const f32x4 (&acc)[2][2][4][2], const Unit& u, int wr, int wc, int fr, int fq) const {
        const int row0 = u.pm * BM + wr * 64 + fr, col0 = u.pn * BM + wc * 32 + 4 * fq;
#pragma unroll
        for (int ai = 0; ai < 2; ++ai)
#pragma unroll
            for (int m = 0; m < 4; ++m) {
                const int row = row0 + ai * HALF + m * 16; float s = 0.f;
#pragma unroll
                for (int bj = 0; bj < 2; ++bj)
#pragma unroll
                    for (int n = 0; n < 2; ++n) { const f32x4 v = acc[ai][bj][m][n]; s += (v[0] * v[0] + v[1] * v[1]) + (v[2] * v[2] + v[3] * v[3]);
                        *(f32x4*)(Y + (size_t)row * 2048 + col0 + bj * HALF + n * 16) = v; }
                s += __shfl_xor(s, 16); s += __shfl_xor(s, 32);
                if (fq == 0) SSQ[(size_t)row * npart + u.pn * 4 + wc] = s;
            }
    }
};
struct EpiGLU {
    static constexpr bool PERM = true, AFTER_DRAIN = false;
    const bf16_t* GB; bf16_t* SPRE; const float* bias; float* SSQ2;
    __device__ __forceinline__ void operator()(const f32x4 (&acc)[2][2][4][2], const Unit& u, int wr, int wc, int fr, int fq) const {
        const int row0 = u.pm * BM + wr * 64 + fr, colb = u.pn * BM + wc * 32 + 8 * fq;
#pragma unroll
        for (int ai = 0; ai < 2; ++ai)
#pragma unroll
            for (int m = 0; m < 4; ++m) {
                const int row = row0 + ai * HALF + m * 16; float s = 0.f;
#pragma unroll
                for (int bj = 0; bj < 2; ++bj) {
                    const int col = colb + bj * HALF;
                    const u32x4 gw = *(const u32x4*)(GB + (size_t)row * 1024 + col);
                    const f32x4 b0 = *(const f32x4*)(bias + col), b1 = *(const f32x4*)(bias + col + 4);
                    const f32x4 z0 = acc[ai][bj][m][0] + b0, z1 = acc[ai][bj][m][1] + b1;
                    float o[8];
                    o[0] = bf_lo(gw.x) * sigmoid_f(z0[0]); o[1] = bf_hi(gw.x) * sigmoid_f(z0[1]); o[2] = bf_lo(gw.y) * sigmoid_f(z0[2]); o[3] = bf_hi(gw.y) * sigmoid_f(z0[3]);
                    o[4] = bf_lo(gw.z) * sigmoid_f(z1[0]); o[5] = bf_hi(gw.z) * sigmoid_f(z1[1]); o[6] = bf_lo(gw.w) * sigmoid_f(z1[2]); o[7] = bf_hi(gw.w) * sigmoid_f(z1[3]);
#pragma unroll
                    for (int k = 0; k < 8; ++k) s += o[k] * o[k];
                    u32x4 w; w.x = cvt_pk_bf16(o[0], o[1]); w.y = cvt_pk_bf16(o[2], o[3]); w.z = cvt_pk_bf16(o[4], o[5]); w.w = cvt_pk_bf16(o[6], o[7]);
                    *(u32x4*)(SPRE + (size_t)row * 1024 + col) = w;
                }
                s += __shfl_xor(s, 16); s += __shfl_xor(s, 32);
                if (fq == 0) SSQ2[(size_t)row * 16 + u.pn * 4 + wc] = s;
            }
    }
};
template <class Epi, class Sched, bool ALIGN_EPI = false, bool SP2 = false>
__device__ __forceinline__ void gemm_phase(PG8_LAS unsigned char* lds, const Gemm g, const Sched& S, const Epi& E) {
    const int tid = threadIdx.x, wid = __builtin_amdgcn_readfirstlane(tid >> 6), lane = tid & 63, wr = wid >> 2, wc = wid & 3, fr = lane & 15, fq = lane >> 4;
    const int K = g.K, nt = K / BK;
    unsigned voffA[2], voffB[2];
#pragma unroll
    for (int i = 0; i < 2; ++i) { int R, C; stage_rc(tid * 16 + i * 8192, R, C); const int Rb = Epi::PERM ? ((R & ~31) + perm32(R & 31)) : R;
        voffA[i] = (unsigned)(R * K + C) * 2u; voffB[i] = (unsigned)(Rb * K + C) * 2u; }
    const size_t kstep = (size_t)(BK * 2);
    const size_t hstep = (size_t)HALF * K * 2;
    const size_t tstep = 2 * hstep;
    const unsigned ldsw = (unsigned)wid * 1024u;
    const int aoff = lds_byte(wr * 64 + fr, fq * 8), boff = lds_byte(wc * 32 + fr, fq * 8);
#define PG8_SA(b, h) (((b) * 2 + (h)) * HTB)
#define PG8_SB(b, h) ((4 + (b) * 2 + (h)) * HTB)
#define PG8_STAGE(bufoff, gbase, voff) do { _Pragma("unroll") for (int _i = 0; _i < 2; ++_i) \
        __builtin_amdgcn_global_load_lds((const unsigned*)((const char*)(gbase) + (voff)[_i]), (PG8_LAS unsigned*)(lds + (bufoff) + ldsw + _i * 8192), 16, 0, 0); } while (0)
#define PG8_LDA(dst, b, h) do { _Pragma("unroll") for (int m = 0; m < 4; ++m) _Pragma("unroll") for (int k = 0; k < 2; ++k) dst[m][k] = *(const PG8_LAS bf16x8*)(lds + PG8_SA(b, h) + aoff + m * 2048 + k * 1024); } while (0)
#define PG8_LDB(dst, b, h) do { _Pragma("unroll") for (int n = 0; n < 2; ++n) _Pragma("unroll") for (int k = 0; k < 2; ++k) dst[n][k] = *(const PG8_LAS bf16x8*)(lds + PG8_SB(b, h) + boff + n * 2048 + k * 1024); } while (0)
#define PG8_MMA(ai, bj, At, Bt) do { __builtin_amdgcn_s_setprio(1); _Pragma("unroll") for (int m = 0; m < 4; ++m) _Pragma("unroll") for (int n = 0; n < 2; ++n) _Pragma("unroll") for (int k = 0; k < 2; ++k) \
        acc[ai][bj][m][n] = __builtin_amdgcn_mfma_f32_16x16x32_bf16(Bt[n][k], At[m][k], acc[ai][bj][m][n], 0, 0, 0); __builtin_amdgcn_s_setprio(0); } while (0)
#define PG8_WAIT_V(n) asm volatile("s_waitcnt vmcnt(" #n ")" ::: "memory")
#define PG8_WAIT_L(n) asm volatile("s_waitcnt lgkmcnt(" #n ")" ::: "memory")
#define PG8_BAR __builtin_amdgcn_s_barrier()
#define PG8_SCHED __builtin_amdgcn_sched_barrier(0)
    Unit cur, nxt; int ui = 0;
    if (!S.next(0, cur)) return;
    f32x4 acc[2][2][4][2];
#pragma unroll
    for (int a = 0; a < 2; ++a)
#pragma unroll
        for (int b = 0; b < 2; ++b)
#pragma unroll
            for (int m = 0; m < 4; ++m)
#pragma unroll
                for (int n = 0; n < 2; ++n) acc[a][b][m][n] = (f32x4){0.f, 0.f, 0.f, 0.f};
    bf16x8 At[4][2], B0[2][2], B1[2][2];
    const char* cA = (const char*)g.A + (size_t)cur.pm * tstep; const char* cB = (const char*)g.Bt + (size_t)cur.pn * tstep;
    S.a_ready(cur);
    if constexpr (SP2) {
        PG8_STAGE(PG8_SB(0, 0), cB, voffB); PG8_STAGE(PG8_SB(0, 1), cB + hstep, voffB); PG8_STAGE(PG8_SA(0, 0), cA, voffA); PG8_STAGE(PG8_SA(0, 1), cA + hstep, voffA);
        if (wr == 1) PG8_BAR;
        PG8_WAIT_V(2); PG8_BAR;
        PG8_STAGE(PG8_SB(1, 0), cB + kstep, voffB); PG8_STAGE(PG8_SA(1, 0), cA + kstep, voffA); PG8_STAGE(PG8_SB(1, 1), cB + hstep + kstep, voffB);
        PG8_WAIT_V(6); PG8_BAR;
    } else {
        PG8_STAGE(PG8_SB(0, 0), cB, voffB); PG8_STAGE(PG8_SA(0, 0), cA, voffA); PG8_STAGE(PG8_SB(0, 1), cB + hstep, voffB); PG8_STAGE(PG8_SA(0, 1), cA + hstep, voffA);
        if (wr == 1) PG8_BAR;
        PG8_WAIT_V(4); PG8_BAR;
        PG8_STAGE(PG8_SB(1, 0), cB + kstep, voffB); PG8_STAGE(PG8_SA(1, 0), cA + kstep, voffA); PG8_STAGE(PG8_SB(1, 1), cB + hstep + kstep, voffB);
        PG8_WAIT_V(6); PG8_BAR;
    }
    for (;;) {
        const bool has_next = S.next(ui + 1, nxt);
        const char* nA = has_next ? (const char*)g.A + (size_t)nxt.pm * tstep : cA; const char* nB = has_next ? (const char*)g.Bt + (size_t)nxt.pn * tstep : cB;
        for (int t = 0; t < nt; t += 2) {
            const bool last = (t == nt - 2);
            const char* a1 = cA + (size_t)(t + 1) * kstep;
            const char* a2 = last ? nA : cA + (size_t)(t + 2) * kstep; const char* b2 = last ? nB : cB + (size_t)(t + 2) * kstep;
            const char* a3 = a2 + kstep; const char* b3 = b2 + kstep;
            if (last && has_next) S.a_ready(nxt);
            if constexpr (SP2) {
            PG8_LDB(B0, 0, 0); PG8_LDB(B1, 0, 1); PG8_SCHED; PG8_LDA(At, 0, 0); PG8_STAGE(PG8_SA(1, 1), a1 + hstep, voffA);
            PG8_WAIT_V(8); PG8_WAIT_L(0); PG8_BAR; PG8_MMA(0, 0, At, B0); PG8_MMA(0, 1, At, B1); PG8_BAR; PG8_SCHED;
            PG8_LDA(At, 0, 1); PG8_STAGE(PG8_SB(0, 0), b2, voffB); PG8_STAGE(PG8_SB(0, 1), b2 + hstep, voffB); PG8_STAGE(PG8_SA(0, 0), a2, voffA);
            PG8_WAIT_V(8); PG8_WAIT_L(0); PG8_BAR; PG8_MMA(1, 0, At, B0); PG8_MMA(1, 1, At, B1); PG8_BAR; PG8_SCHED;
            PG8_LDB(B0, 1, 0); PG8_LDB(B1, 1, 1); PG8_SCHED; PG8_LDA(At, 1, 0); PG8_STAGE(PG8_SA(0, 1), a2 + hstep, voffA);
            PG8_WAIT_V(8); PG8_WAIT_L(0); PG8_BAR; PG8_MMA(0, 0, At, B0); PG8_MMA(0, 1, At, B1); PG8_BAR; PG8_SCHED;
            PG8_LDA(At, 1, 1); PG8_STAGE(PG8_SB(1, 0), b3, voffB); PG8_STAGE(PG8_SB(1, 1), b3 + hstep, voffB); PG8_STAGE(PG8_SA(1, 0), a3, voffA);
            PG8_WAIT_V(8); PG8_WAIT_L(0); PG8_BAR; PG8_MMA(1, 0, At, B0); PG8_MMA(1, 1, At, B1); PG8_BAR; PG8_SCHED;
            } else {
            PG8_LDB(B0, 0, 0); PG8_SCHED; PG8_LDA(At, 0, 0); PG8_STAGE(PG8_SA(1, 1), a1 + hstep, voffA);
            PG8_WAIT_L(8); PG8_BAR; PG8_WAIT_L(0); PG8_MMA(0, 0, At, B0); PG8_BAR; PG8_SCHED;
            PG8_LDB(B1, 0, 1); PG8_STAGE(PG8_SB(0, 0), b2, voffB);
            PG8_BAR; PG8_WAIT_L(0); PG8_MMA(0, 1, At, B1); PG8_BAR;
            PG8_LDA(At, 0, 1); PG8_STAGE(PG8_SA(0, 0), a2, voffA);
            PG8_BAR; PG8_WAIT_L(0); PG8_MMA(1, 0, At, B0); PG8_BAR; PG8_SCHED;
            PG8_STAGE(PG8_SB(0, 1), b2 + hstep, voffB);
            PG8_WAIT_V(6); PG8_BAR; PG8_MMA(1, 1, At, B1); PG8_BAR;
            PG8_LDB(B0, 1, 0); PG8_SCHED; PG8_LDA(At, 1, 0); PG8_STAGE(PG8_SA(0, 1), a2 + hstep, voffA);
            PG8_WAIT_L(8); PG8_BAR; PG8_WAIT_L(0); PG8_MMA(0, 0, At, B0); PG8_BAR; PG8_SCHED;
            PG8_LDB(B1, 1, 1); PG8_STAGE(PG8_SB(1, 0), b3, voffB);
            PG8_BAR; PG8_WAIT_L(0); PG8_MMA(0, 1, At, B1); PG8_BAR;
            PG8_LDA(At, 1, 1); PG8_STAGE(PG8_SA(1, 0), a3, voffA);
            PG8_BAR; PG8_WAIT_L(0); PG8_MMA(1, 0, At, B0); PG8_BAR; PG8_SCHED;
            PG8_STAGE(PG8_SB(1, 1), b3 + hstep, voffB);
            PG8_WAIT_V(6); PG8_BAR; PG8_MMA(1, 1, At, B1); PG8_BAR;
            }
        }
        if constexpr (ALIGN_EPI) { if (wr == 0) PG8_BAR; }
        if constexpr (!Epi::AFTER_DRAIN) { E(acc, cur, wr, wc, fr, fq); S.done(cur); }
        if (!has_next) break;
#pragma unroll
        for (int a = 0; a < 2; ++a)
#pragma unroll
            for (int b = 0; b < 2; ++b)
#pragma unroll
                for (int m = 0; m < 4; ++m)
#pragma unroll
                    for (int n = 0; n < 2; ++n) acc[a][b][m][n] = (f32x4){0.f, 0.f, 0.f, 0.f};
        cur = nxt; cA = nA; cB = nB; ++ui;
        if constexpr (ALIGN_EPI) { if (wr == 1) PG8_BAR; }
    }
    PG8_WAIT_V(0);
    if constexpr (!ALIGN_EPI) { if (wr == 0) PG8_BAR; }
    PG8_BAR;
    if constexpr (Epi::AFTER_DRAIN) { E.fused(acc, cur, wr, wc, fr, fq, lds, wid, lane); S.done(cur); }
#undef PG8_SA
#undef PG8_SB
#undef PG8_STAGE
#undef PG8_LDA
#undef PG8_LDB
#undef PG8_MMA
#undef PG8_WAIT_V
#undef PG8_WAIT_L
#undef PG8_BAR
#undef PG8_SCHED
}
}
namespace att {
typedef short bf16x8 __attribute__((ext_vector_type(8)));
typedef short s16x4 __attribute__((ext_vector_type(4)));
typedef float f32x16 __attribute__((ext_vector_type(16)));
typedef float f32x4 __attribute__((ext_vector_type(4)));
typedef unsigned u32x4 __attribute__((ext_vector_type(4)));
typedef unsigned short bf16_t;
constexpr int KVBLK = 64, LDK = 3072, NT = 2048 / KVBLK;
constexpr int SHM_V = KVBLK * 128 * 2, SHM_K = KVBLK * 128 * 2;
constexpr int WS_OFF = 131072;
constexpr float THRL = 11.5f;
#ifndef ATT_SDEPTH
#define ATT_SDEPTH 1
#endif
constexpr int SDEPTH = ATT_SDEPTH;
#define KSWZ(row, colB) ((row) * 256 + ((colB) ^ (((row) & 7) << 4)))
#define SBAR() __builtin_amdgcn_sched_barrier(0)
__device__ __forceinline__ int crow(int r, int hi) { return (r & 3) + 8 * (r >> 2) + 4 * hi; }
__device__ __forceinline__ unsigned cvtpk(float lo, float hi) { unsigned r; asm volatile("v_cvt_pk_bf16_f32 %0, %1, %2" : "=v"(r) : "v"(lo), "v"(hi)); return r; }

__device__ __forceinline__ void partialSM(f32x16& p0, f32x16& p1, float& m_reg, float& mn, float& alpha) {
  float pmax = p0[0];
#pragma unroll
  for (int r = 1; r < 16; ++r) pmax = fmaxf(pmax, p0[r]);
#pragma unroll
  for (int r = 0; r < 16; ++r) pmax = fmaxf(pmax, p1[r]);
  { auto rr = __builtin_amdgcn_permlane32_swap(__float_as_uint(pmax), __float_as_uint(pmax), false, false);
    pmax = fmaxf(__uint_as_float(rr[0]), __uint_as_float(rr[1])); }
  if (__builtin_expect(__all(pmax - m_reg <= THRL), 1)) { mn = m_reg; alpha = 1.f; }
  else { mn = fmaxf(m_reg, pmax); alpha = __builtin_amdgcn_exp2f(m_reg - mn); m_reg = mn; }
#pragma unroll
  for (int r = 0; r < 16; ++r) p0[r] = p0[r] - mn;
#pragma unroll
  for (int r = 0; r < 16; ++r) p1[r] = p1[r] - mn;
#pragma unroll
  for (int r = 0; r < 16; ++r) p0[r] = __builtin_amdgcn_exp2f(p0[r]);
}
__device__ __forceinline__ void finishSM(f32x16& p0, f32x16& p1, float alpha, float& l_reg, bf16x8& pa0, bf16x8& pa1, bf16x8& pa2, bf16x8& pa3) {
#pragma unroll
  for (int r = 0; r < 16; ++r) p1[r] = __builtin_amdgcn_exp2f(p1[r]);
  float ps = 0;
#pragma unroll
  for (int r = 0; r < 16; ++r) ps += p0[r];
#pragma unroll
  for (int r = 0; r < 16; ++r) ps += p1[r];
  { auto rr = __builtin_amdgcn_permlane32_swap(__float_as_uint(ps), __float_as_uint(ps), false, false);
    ps = __uint_as_float(rr[0]) + __uint_as_float(rr[1]); }
  l_reg = l_reg * alpha + ps;
#define PK4(P, BASE, OUT) do { unsigned a0 = cvtpk(P[BASE + 0], P[BASE + 1]), a1 = cvtpk(P[BASE + 2], P[BASE + 3]);   \
    unsigned b0 = cvtpk(P[BASE + 4], P[BASE + 5]), b1 = cvtpk(P[BASE + 6], P[BASE + 7]);                              \
    auto r0 = __builtin_amdgcn_permlane32_swap(a0, b0, false, false); auto r1 = __builtin_amdgcn_permlane32_swap(a1, b1, false, false); \
    u32x4 w = {r0[0], r1[0], r0[1], r1[1]}; OUT = *reinterpret_cast<bf16x8*>(&w); } while (0)
  PK4(p0, 0, pa0); PK4(p0, 8, pa1); PK4(p1, 0, pa2); PK4(p1, 8, pa3);
#undef PK4
}
__device__ __forceinline__ void qkt(f32x16& p0, f32x16& p1, const char* Ks, const bf16x8* qr, int r32, int hi, int cofs, float dq, float nsl) {
#pragma unroll
  for (int r = 0; r < 16; ++r) { const float cr = (float)((r & 3) + 8 * (r >> 2)); p0[r] = nsl * __builtin_fabsf(dq - cr); p1[r] = nsl * __builtin_fabsf(dq - (32.f + cr)); }
#pragma unroll
  for (int d0 = 0; d0 < 4; ++d0) { const int cb = cofs + d0 * 32 + hi * 16;
    bf16x8 b0 = *reinterpret_cast<const bf16x8*>(Ks + KSWZ(r32, cb));
    bf16x8 b1 = *reinterpret_cast<const bf16x8*>(Ks + KSWZ(32 + r32, cb));
    p0 = __builtin_amdgcn_mfma_f32_32x32x16_bf16(b0, qr[d0], p0, 0, 0, 0);
    p1 = __builtin_amdgcn_mfma_f32_32x32x16_bf16(b1, qr[d0], p1, 0, 0, 0); }
}
__device__ __forceinline__ int v_st(int k, int c) { const int kk = (k & ~0xC) | ((k & 4) << 1) | ((k & 8) >> 1); return ((kk >> 3) * 4 + (c >> 5)) * 512 + ((kk & 7) * 32 + (c & 31)) * 2; }
__device__ __forceinline__ int v_rd_base(int lane) { return ((lane & 3) << 3) | (((lane >> 2) & 3) << 6) | (((lane >> 4) & 1) << 5) | (((lane >> 5) & 1) << 8); }
constexpr int v_rd_off(int d0, int ks, int half) { return d0 * 512 + ks * 4096 + half * 2048; }
template <int OFF> __device__ __forceinline__ s16x4 tr_read(int vb) {
  s16x4 r; asm volatile("ds_read_b64_tr_b16 %0, %1 offset:%2" : "=&v"(r) : "v"(vb), "i"(OFF) : "memory"); return r;
}
template <int D0> __device__ __forceinline__ void pv_one(f32x16& od, int vb, bf16x8 pa0, bf16x8 pa1, bf16x8 pa2, bf16x8 pa3) {
  const s16x4 l0 = tr_read<v_rd_off(D0, 0, 0)>(vb), h0 = tr_read<v_rd_off(D0, 0, 1)>(vb), l1 = tr_read<v_rd_off(D0, 1, 0)>(vb), h1 = tr_read<v_rd_off(D0, 1, 1)>(vb);
  const s16x4 l2 = tr_read<v_rd_off(D0, 2, 0)>(vb), h2 = tr_read<v_rd_off(D0, 2, 1)>(vb), l3 = tr_read<v_rd_off(D0, 3, 0)>(vb), h3 = tr_read<v_rd_off(D0, 3, 1)>(vb);
  asm volatile("s_waitcnt lgkmcnt(0)" ::: "memory"); SBAR();
#define PK(L, H) (bf16x8){L[0], L[1], L[2], L[3], H[0], H[1], H[2], H[3]}
  od = __builtin_amdgcn_mfma_f32_32x32x16_bf16(pa0, PK(l0, h0), od, 0, 0, 0);
  od = __builtin_amdgcn_mfma_f32_32x32x16_bf16(pa1, PK(l1, h1), od, 0, 0, 0);
  od = __builtin_amdgcn_mfma_f32_32x32x16_bf16(pa2, PK(l2, h2), od, 0, 0, 0);
  od = __builtin_amdgcn_mfma_f32_32x32x16_bf16(pa3, PK(l3, h3), od, 0, 0, 0);
#undef PK
}
__device__ __forceinline__ void pv_d0(f32x16* o, int vb, bf16x8 pa0, bf16x8 pa1, bf16x8 pa2, bf16x8 pa3) {
  pv_one<0>(o[0], vb, pa0, pa1, pa2, pa3); pv_one<1>(o[1], vb, pa0, pa1, pa2, pa3); pv_one<2>(o[2], vb, pa0, pa1, pa2, pa3); pv_one<3>(o[3], vb, pa0, pa1, pa2, pa3);
}

__device__ __forceinline__ void attn_unit(const bf16_t* __restrict__ QKV, bf16_t* __restrict__ CAT, int b, int h, int qb, float lam, const float* __restrict__ head_g, char* lds) {
  const int tid = threadIdx.x, wid = tid >> 6, lane = tid & 63, r32 = lane & 31, hi = lane >> 5, cmap = wid >> 2, wq = wid & 3;
  char* V_lds = lds; char* K_lds = lds + 2 * SHM_V;
  float* ws = (float*)(lds + WS_OFF) + wid * 64; float* li_l = ws; float* al_l = ws + 32;
  float m_reg = -1e30f, l_reg = 0; f32x16 o[4] = {}; bf16x8 qr[4];
  const bf16_t* Qw = QKV + (size_t)(b * 2048 + qb * 128 + wq * 32 + r32) * LDK + h * 128 + cmap * 64 + hi * 8;
#pragma unroll
  for (int d0 = 0; d0 < 4; ++d0) qr[d0] = *reinterpret_cast<const bf16x8*>(Qw + d0 * 16);
  const bf16_t* Kh = QKV + (size_t)(b * 2048) * LDK + 1024 + h * 128;
  const bf16_t* Vh = QKV + (size_t)(b * 2048) * LDK + 2048 + h * 128;
  const float dqb = (float)(qb * 128 + wq * 32 + r32 - 4 * hi);
  const float nsl = -1.4426950408889634f * __builtin_amdgcn_exp2f(-(float)(h + 1));
  const int cofs = cmap * 128;
  const int sr = tid >> 4, sc = (tid & 15) * 8, vst0 = v_st(sr, sc), vst1 = v_st(32 + sr, sc);
  const int vb0 = (int)(uintptr_t)V_lds + v_rd_base(lane);
  struct { bf16x8 vs0, vs1, ks0, ks1; } sr_[SDEPTH];
#define SLOAD(i, k0) do { sr_[i].vs0 = *reinterpret_cast<const bf16x8*>(&Vh[(size_t)((k0) + sr) * LDK + sc]); sr_[i].vs1 = *reinterpret_cast<const bf16x8*>(&Vh[(size_t)((k0) + 32 + sr) * LDK + sc]); \
    sr_[i].ks0 = *reinterpret_cast<const bf16x8*>(&Kh[(size_t)((k0) + sr) * LDK + sc]); sr_[i].ks1 = *reinterpret_cast<const bf16x8*>(&Kh[(size_t)((k0) + 32 + sr) * LDK + sc]); } while (0)
#define SWRITE(bb, i) do { *(bf16x8*)(V_lds + (bb) * SHM_V + vst0) = sr_[i].vs0;          \
    *(bf16x8*)(V_lds + (bb) * SHM_V + vst1) = sr_[i].vs1; int kc = sc * 2;               \
    *(bf16x8*)(K_lds + (bb) * SHM_K + KSWZ(sr, kc)) = sr_[i].ks0;                       \
    *(bf16x8*)(K_lds + (bb) * SHM_K + KSWZ(32 + sr, kc)) = sr_[i].ks1; } while (0)
#define SWAIT() do { if constexpr (SDEPTH == 2) asm volatile("s_waitcnt vmcnt(4)" ::: "memory"); else asm volatile("s_waitcnt vmcnt(0)" ::: "memory"); } while (0)
#define RESC(a) do { if (__any((a) < 1.f)) { if (hi == 0) al_l[r32] = (a); asm volatile("s_waitcnt lgkmcnt(0)" ::: "memory"); \
    _Pragma("unroll") for (int d = 0; d < 4; ++d) _Pragma("unroll") for (int r = 0; r < 16; ++r) o[d][r] *= al_l[crow(r, hi)]; } } while (0)
  f32x16 pA0, pA1, pB0, pB1; float mnA, mnB, alA, alB; bf16x8 pa0, pa1, pa2, pa3;
  constexpr int SE = 0, SO = SDEPTH - 1;
  SLOAD(SE, 0); asm volatile("s_waitcnt vmcnt(0)" ::: "memory"); SWRITE(0, SE); __syncthreads();
  qkt(pA0, pA1, K_lds, qr, r32, hi, cofs, dqb, nsl); partialSM(pA0, pA1, m_reg, mnA, alA);
  SLOAD(SO, KVBLK); if constexpr (SDEPTH == 2) SLOAD(SE, 2 * KVBLK);
  SWAIT(); SWRITE(1, SO); __syncthreads();
  for (int j = 1; j + 1 < NT; j += 2) {
    SBAR(); qkt(pB0, pB1, K_lds + SHM_K, qr, r32, hi, cofs, dqb - (float)(j * KVBLK), nsl);
    finishSM(pA0, pA1, alA, l_reg, pa0, pa1, pa2, pa3); SBAR();
    SLOAD(SO, (j + SDEPTH) * KVBLK); SBAR();
    pv_d0(o, vb0, pa0, pa1, pa2, pa3); partialSM(pB0, pB1, m_reg, mnB, alB);
    __syncthreads(); SWAIT(); SWRITE(0, SE);
    RESC(alB); __syncthreads();
    SBAR(); qkt(pA0, pA1, K_lds, qr, r32, hi, cofs, dqb - (float)((j + 1) * KVBLK), nsl);
    finishSM(pB0, pB1, alB, l_reg, pa0, pa1, pa2, pa3); SBAR();
    if (SDEPTH == 1 || j + 3 < NT) SLOAD(SE, (j + 1 + SDEPTH) * KVBLK); SBAR();
    pv_d0(o, vb0 + SHM_V, pa0, pa1, pa2, pa3); partialSM(pA0, pA1, m_reg, mnA, alA);
    __syncthreads(); SWAIT(); SWRITE(1, SO);
    RESC(alA); __syncthreads();
  }
  SBAR(); qkt(pB0, pB1, K_lds + SHM_K, qr, r32, hi, cofs, dqb - (float)((NT - 1) * KVBLK), nsl);
  finishSM(pA0, pA1, alA, l_reg, pa0, pa1, pa2, pa3); SBAR();
  pv_d0(o, vb0, pa0, pa1, pa2, pa3); partialSM(pB0, pB1, m_reg, mnB, alB);
  __syncthreads(); RESC(alB);
  finishSM(pB0, pB1, alB, l_reg, pa0, pa1, pa2, pa3); SBAR();
  pv_d0(o, vb0 + SHM_V, pa0, pa1, pa2, pa3);
  if (hi == 0) li_l[r32] = l_reg; asm volatile("s_waitcnt lgkmcnt(0)" ::: "memory");
  float rli[16];
#pragma unroll
  for (int r = 0; r < 16; ++r) rli[r] = __builtin_amdgcn_rcpf(li_l[crow(r, hi)]);
  __syncthreads();
  float* OB = (float*)lds + cmap * 16384 + (wq * 32) * 128;
#pragma unroll
  for (int r = 0; r < 16; ++r) { const int orow = crow(r, hi);
#pragma unroll
    for (int d0 = 0; d0 < 4; ++d0) OB[orow * 128 + d0 * 32 + r32] = o[d0][r] * rli[r]; }
  __syncthreads();
  { const int row = tid >> 2, qtr = tid & 3;
    const f32x4* o1 = (const f32x4*)((const float*)lds + row * 128 + qtr * 32); const f32x4* o2 = o1 + 4096;
    f32x4 v[8]; float ssq = 0.f;
#pragma unroll
    for (int k = 0; k < 8; ++k) { v[k] = o1[k] - lam * o2[k]; ssq += (v[k][0] * v[k][0] + v[k][1] * v[k][1]) + (v[k][2] * v[k][2] + v[k][3] * v[k][3]); }
    ssq += __shfl_xor(ssq, 1); ssq += __shfl_xor(ssq, 2);
    const float rs = rsqrtf(ssq * (1.0f / 128.0f) + 1e-6f) * 0.8f;
    bf16_t* dst = CAT + (size_t)(b * 2048 + qb * 128 + row) * 2048 + h * 128 + qtr * 32;
    const f32x4* hg = (const f32x4*)(head_g + qtr * 32);
#pragma unroll
    for (int k = 0; k < 8; k += 2) { const f32x4 g0 = hg[k], g1 = hg[k + 1]; const f32x4 a = v[k] * rs * g0, c = v[k + 1] * rs * g1;
      u32x4 w; w.x = cvtpk(a[0], a[1]); w.y = cvtpk(a[2], a[3]); w.z = cvtpk(c[0], c[1]); w.w = cvtpk(c[2], c[3]);
      *(u32x4*)(dst + k * 4) = w; }
  }
  __syncthreads();
#undef SLOAD
#undef SWRITE
#undef SWAIT
#undef RESC
}
#undef SBAR
}
#define LAS __attribute__((address_space(3)))
typedef unsigned short bf16_t;
typedef short bf16x8 __attribute__((ext_vector_type(8)));
typedef float f32x4 __attribute__((ext_vector_type(4)));
typedef float f32x16 __attribute__((ext_vector_type(16)));
typedef unsigned u32x4 __attribute__((ext_vector_type(4)));
typedef unsigned u32x2 __attribute__((ext_vector_type(2)));
constexpr int DM = 2048, BATCH = 4, SEQ = 2048, MT = BATCH * SEQ, DFF = 5632, NGU = 2 * DFF, INC = 4096, SW = 1024;
constexpr int SG = 64, CT = 16, NCH = SEQ / CT, NROW = BATCH * NCH;
constexpr float EPS = 1e-6f;
constexpr int NWAVES = 8, LDS_BYTES = 136 * 1024;
constexpr size_t al256(size_t x) { return (x + 255) / 256 * 256; }
constexpr size_t WS_W1G = 0;
constexpr size_t WS_W1D = WS_W1G + (size_t)NGU * DM * 2;
constexpr size_t WS_WIN = WS_W1D + (size_t)DM * DFF * 2;
constexpr size_t WS_WOUT = WS_WIN + (size_t)INC * DM * 2;
constexpr size_t WS_WGLU = WS_WOUT + (size_t)DM * DM * 2;
constexpr size_t WS_XN = WS_WGLU + (size_t)SW * SW * 2;
constexpr size_t WS_HFF = WS_XN + (size_t)MT * DM * 2;
constexpr size_t WS_QKV = WS_HFF, WS_UG = WS_QKV + (size_t)MT * 3072 * 2, WS_HIN = WS_UG + (size_t)SG * NROW * 256 * 2;
constexpr size_t WS_Y = WS_HFF + (size_t)MT * DFF * 2;
constexpr size_t WS_SLOC = WS_Y, WS_GB = WS_SLOC + (size_t)SG * NROW * 256 * 4, WS_SPRE = WS_GB + (size_t)MT * SW * 2;
constexpr size_t WS_SSQ = WS_Y + (size_t)MT * DM * 4;
constexpr size_t WS_SSQ2 = WS_SSQ + (size_t)MT * 32 * 4;
constexpr size_t WS_EMAT = WS_SSQ2 + (size_t)MT * 16 * 4;
constexpr size_t WS_MFT = WS_EMAT + (size_t)SG * 8 * 16 * 1024;
constexpr size_t WS_ATAB = WS_MFT + (size_t)SG * 8 * 32 * 1024;
constexpr size_t WS_END = WS_ATAB + (size_t)SG * 2 * 64 * 2 * 4;
static_assert(WS_HIN + (size_t)SG * NROW * 256 * 2 <= WS_Y && WS_SPRE + (size_t)MT * SW * 2 <= WS_SSQ, "overlays");

__device__ __forceinline__ unsigned cvtpk(float lo, float hi) { unsigned r; asm volatile("v_cvt_pk_bf16_f32 %0, %1, %2" : "=v"(r) : "v"(lo), "v"(hi)); return r; }
__device__ __forceinline__ float wave_sum(float v) {
#pragma unroll
    for (int o = 1; o < 64; o <<= 1) v += __shfl_xor(v, o);
    return v;
}
__device__ __forceinline__ float bf2f_lo(unsigned w) { return __uint_as_float(w << 16); }
__device__ __forceinline__ float bf2f_hi(unsigned w) { return __uint_as_float(w & 0xffff0000u); }

struct Params { const float* in[31]; float* out; unsigned char* ws; int ph_lo, ph_hi; };

__device__ __forceinline__ void transpose_item(const float* __restrict__ W, int K, int N, bf16_t* __restrict__ WT, int k0, int n0, int rowbase, LAS float* scr, int lane) {
#pragma unroll 8
    for (int i = 0; i < 32; ++i) { const int kk = 2 * i + (lane >> 5); scr[kk * 33 + (lane & 31)] = W[(size_t)(k0 + kk) * N + n0 + (lane & 31)]; }
    asm volatile("s_waitcnt lgkmcnt(0)" ::: "memory");
    const int c = lane & 7;
#pragma unroll
    for (int j = 0; j < 4; ++j) { const int n = (lane >> 3) + 8 * j; const LAS float* s = scr + (8 * c) * 33 + n;
        u32x4 o; o.x = cvtpk(s[0 * 33], s[1 * 33]); o.y = cvtpk(s[2 * 33], s[3 * 33]); o.z = cvtpk(s[4 * 33], s[5 * 33]); o.w = cvtpk(s[6 * 33], s[7 * 33]);
        *(u32x4*)(WT + (size_t)(rowbase + n) * K + k0 + 8 * c) = o; }
    asm volatile("s_waitcnt lgkmcnt(0)" ::: "memory");
}
__device__ __forceinline__ void convert_ffn(const float* wg, const float* wu, const float* wd, unsigned char* ws, LAS float* scr, int gw, int ngw, int lane) {
    constexpr int IG = (DM / 64) * (DFF / 32), ID = (DFF / 64) * (DM / 32);
    bf16_t* G = (bf16_t*)(ws + WS_W1G); bf16_t* D = (bf16_t*)(ws + WS_W1D);
    for (int it = gw; it < 2 * IG + ID; it += ngw) {
        int r = it;
        if (r < 2 * IG) { const int up = r >= IG; if (up) r -= IG; const int nb = r % (DFF / 32), kb = r / (DFF / 32), n0 = nb * 32;
            transpose_item(up ? wu : wg, DM, DFF, G, kb * 64, n0, (n0 >> 7) * 256 + (n0 & 127) + up * 128, scr, lane); continue; }
        r -= 2 * IG; { const int nb = r % (DM / 32), kb = r / (DM / 32); transpose_item(wd, DFF, DM, D, kb * 64, nb * 32, nb * 32, scr, lane); }
    }
}
__device__ __forceinline__ void convert_plain(const float* w, int K, int N, bf16_t* WT, LAS float* scr, int gw, int ngw, int lane) {
    const int items = (K / 64) * (N / 32);
    for (int r = gw; r < items; r += ngw) { const int nb = r % (N / 32), kb = r / (N / 32); transpose_item(w, K, N, WT, kb * 64, nb * 32, nb * 32, scr, lane); }
}
__device__ __forceinline__ void prenorm_rows(const float* __restrict__ X, const float* __restrict__ g, bf16_t* __restrict__ XN, int gw, int ngw, int lane) {
    for (int row = gw; row < MT; row += ngw) {
        const f32x4* xr = (const f32x4*)(X + (size_t)row * DM) + lane; f32x4 v[8]; float s = 0.f;
#pragma unroll
        for (int j = 0; j < 8; ++j) { v[j] = xr[64 * j]; s += (v[j][0] * v[j][0] + v[j][1] * v[j][1]) + (v[j][2] * v[j][2] + v[j][3] * v[j][3]); }
        const float rs = rsqrtf(wave_sum(s) * (1.0f / DM) + EPS);
        u32x2* o8 = (u32x2*)(XN + (size_t)row * DM) + lane;
#pragma unroll
        for (int j = 0; j < 8; ++j) { const f32x4 gg = ((const f32x4*)g)[lane + 64 * j]; u32x2 w; w.x = cvtpk(v[j][0] * rs * gg[0], v[j][1] * rs * gg[1]); w.y = cvtpk(v[j][2] * rs * gg[2], v[j][3] * rs * gg[3]); o8[64 * j] = w; }
    }
}
__device__ __forceinline__ void resid_rows(const float* SRC, const float* __restrict__ Y, const float* __restrict__ SSQ, int npart, const float* __restrict__ gpost, float coef,
                                           float* OUT, const float* __restrict__ gpre, bf16_t* XN, int gw, int ngw, int lane) {
    for (int row = gw; row < MT; row += ngw) {
        float s = lane < npart ? SSQ[(size_t)row * npart + lane] : 0.f;
        const float rs = rsqrtf(wave_sum(s) * (1.0f / DM) + EPS) * coef;
        const f32x4* yr = (const f32x4*)(Y + (size_t)row * DM) + lane; const f32x4* xr = (const f32x4*)(SRC + (size_t)row * DM) + lane; f32x4* orow = (f32x4*)(OUT + (size_t)row * DM) + lane;
        f32x4 v[8]; float s1 = 0.f;
#pragma unroll
        for (int j = 0; j < 8; ++j) { const f32x4 gg = ((const f32x4*)gpost)[lane + 64 * j]; v[j] = xr[64 * j] + yr[64 * j] * rs * gg; orow[64 * j] = v[j];
            s1 += (v[j][0] * v[j][0] + v[j][1] * v[j][1]) + (v[j][2] * v[j][2] + v[j][3] * v[j][3]); }
        if (XN) {
            const float r1 = rsqrtf(wave_sum(s1) * (1.0f / DM) + EPS);
            u32x2* o8 = (u32x2*)(XN + (size_t)row * DM) + lane;
#pragma unroll
            for (int j = 0; j < 8; ++j) { const f32x4 gg = ((const f32x4*)gpre)[lane + 64 * j]; u32x2 w; w.x = cvtpk(v[j][0] * r1 * gg[0], v[j][1] * r1 * gg[1]); w.y = cvtpk(v[j][2] * r1 * gg[2], v[j][3] * r1 * gg[3]); o8[64 * j] = w; }
        }
    }
}
__device__ __forceinline__ void snorm_rows(const bf16_t* __restrict__ SPRE, const float* __restrict__ SSQ2, const float* __restrict__ og, bf16_t* __restrict__ CAT, int gw, int ngw, int lane) {
    for (int row = gw; row < MT; row += ngw) {
        float s = lane < 16 ? SSQ2[(size_t)row * 16 + lane] : 0.f;
        const float rs = rsqrtf(wave_sum(s) * (1.0f / SW) + EPS);
#pragma unroll
        for (int j = 0; j < 2; ++j) { const int c8 = lane + 64 * j; const u32x4 w = *((const u32x4*)(SPRE + (size_t)row * SW) + c8);
            const f32x4 g0 = ((const f32x4*)og)[2 * c8], g1 = ((const f32x4*)og)[2 * c8 + 1]; u32x4 o;
            o.x = cvtpk(bf2f_lo(w.x) * rs * g0[0], bf2f_hi(w.x) * rs * g0[1]); o.y = cvtpk(bf2f_lo(w.y) * rs * g0[2], bf2f_hi(w.y) * rs * g0[3]);
            o.z = cvtpk(bf2f_lo(w.z) * rs * g1[0], bf2f_hi(w.z) * rs * g1[1]); o.w = cvtpk(bf2f_lo(w.w) * rs * g1[2], bf2f_hi(w.w) * rs * g1[3]);
            *((u32x4*)(CAT + (size_t)row * DM + SW) + c8) = o; }
    }
}

__device__ __forceinline__ void s5_tables(const Params& p, int g, float* L) {
    const int t = threadIdx.x;
    float* APOW = L; float* FF = APOW + 2 * 64 * 17 * 2; float* BB = FF + 2 * 64 * 2; float* CC = BB + 2 * 64 * 16 * 2; float* KL = CC + 2 * 16 * 64 * 2;
    unsigned char* ws = p.ws;
    __syncthreads();
    if (t < 128) {
        const int dir = t >> 6, n = t & 63, idx = (dir * SG + g) * 64 + n;
        const float lr = p.in[13][idx], li = p.in[14][idx], dt = expf(p.in[15][dir * SG + g]);
        const float mag = expf(lr * dt), ar = mag * cosf(li * dt), ai = mag * sinf(li * dt);
        const float den = lr * lr + li * li, nr = ar - 1.0f;
        FF[(dir * 64 + n) * 2] = (nr * lr + ai * li) / den; FF[(dir * 64 + n) * 2 + 1] = (ai * lr - nr * li) / den;
        float pr = 1.f, pi = 0.f;
        for (int k = 0; k <= 16; ++k) { APOW[((dir * 64 + n) * 17 + k) * 2] = pr; APOW[((dir * 64 + n) * 17 + k) * 2 + 1] = pi; const float qr = pr * ar - pi * ai, qi = pr * ai + pi * ar; pr = qr; pi = qi; }
        float* AT = (float*)(ws + WS_ATAB) + ((g * 2 + dir) * 64 + n) * 2;
        AT[0] = APOW[((dir * 64 + n) * 17 + 16) * 2]; AT[1] = APOW[((dir * 64 + n) * 17 + 16) * 2 + 1];
    }
    __syncthreads();
    for (int e = t; e < 2048; e += 512) {
        { const int dir = e >> 10, n = (e >> 4) & 63, q = e & 15; const size_t bi = ((size_t)(dir * SG + g) * 64 + n) * 16 + q;
          const float br = p.in[16][bi], bim = p.in[17][bi], fr = FF[(dir * 64 + n) * 2], fi = FF[(dir * 64 + n) * 2 + 1];
          BB[((dir * 64 + n) * 16 + q) * 2] = fr * br - fi * bim; BB[((dir * 64 + n) * 16 + q) * 2 + 1] = fr * bim + fi * br; }
        { const int dir = e >> 10, pp = (e >> 6) & 15, n = e & 63; const size_t ci = ((size_t)(dir * SG + g) * 16 + pp) * 64 + n;
          CC[((dir * 16 + pp) * 64 + n) * 2] = p.in[18][ci]; CC[((dir * 16 + pp) * 64 + n) * 2 + 1] = p.in[19][ci]; }
    }
    __syncthreads();
    for (int e = t; e < 8192; e += 512) {
        const int q = e & 15, pp = (e >> 4) & 15, l = (e >> 8) & 15, dir = e >> 12; float s = 0.f;
        for (int n = 0; n < 64; ++n) {
            const float cr = CC[((dir * 16 + pp) * 64 + n) * 2], ci = CC[((dir * 16 + pp) * 64 + n) * 2 + 1];
            const float ar = APOW[((dir * 64 + n) * 17 + l) * 2], ai = APOW[((dir * 64 + n) * 17 + l) * 2 + 1];
            const float wr = cr * ar - ci * ai, wi = cr * ai + ci * ar;
            s += wr * BB[((dir * 64 + n) * 16 + q) * 2] - wi * BB[((dir * 64 + n) * 16 + q) * 2 + 1];
        }
        KL[e] = s;
    }
    __syncthreads();
    for (int ch = t; ch < 8192; ch += 512) {
        const int lane = ch & 63, ks = (ch >> 6) & 15, nt = ch >> 10, np = nt * 32 + (lane & 31), dir = np >> 7, ri = (np >> 6) & 1, n = np & 63, q0 = (lane >> 5) * 8;
        const int pw = dir == 0 ? 15 - ks : ks;
        const float ar = APOW[((dir * 64 + n) * 17 + pw) * 2], ai = APOW[((dir * 64 + n) * 17 + pw) * 2 + 1];
        float z[8];
#pragma unroll
        for (int j = 0; j < 8; ++j) { const float br = BB[((dir * 64 + n) * 16 + q0 + j) * 2], bi = BB[((dir * 64 + n) * 16 + q0 + j) * 2 + 1]; z[j] = ri ? (ar * bi + ai * br) : (ar * br - ai * bi); }
        u32x4 o; o.x = cvtpk(z[0], z[1]); o.y = cvtpk(z[2], z[3]); o.z = cvtpk(z[4], z[5]); o.w = cvtpk(z[6], z[7]);
        *(u32x4*)(ws + WS_EMAT + ((size_t)((g * 8 + nt) * 16 + ks)) * 1024 + lane * 16) = o;
    }
    for (int ch = t; ch < 16384; ch += 512) {
        const int lane = ch & 63, ks = (ch >> 6) & 31, nt = ch >> 11, no = nt * 32 + (lane & 31), tau = no >> 4, pp = no & 15;
        float z[8];
        if (ks < 16) { const int sg = ks, q0 = (lane >> 5) * 8;
#pragma unroll
            for (int j = 0; j < 8; ++j) { const int q = q0 + j; float v = 0.f;
                if (sg <= tau) v += KL[((0 * 16 + (tau - sg)) * 16 + pp) * 16 + q];
                if (sg >= tau) v += KL[((1 * 16 + (sg - tau)) * 16 + pp) * 16 + q];
                if (sg == tau && pp == q) v += p.in[20][g * 16 + pp];
                z[j] = v; }
        } else { const int np0 = (ks - 16) * 16 + (lane >> 5) * 8, dir = np0 >> 7, ri = (np0 >> 6) & 1, n0 = np0 & 63, pw = dir == 0 ? tau + 1 : 16 - tau;
#pragma unroll
            for (int j = 0; j < 8; ++j) { const int n = n0 + j; const float cr = CC[((dir * 16 + pp) * 64 + n) * 2], ci = CC[((dir * 16 + pp) * 64 + n) * 2 + 1];
                const float ar = APOW[((dir * 64 + n) * 17 + pw) * 2], ai = APOW[((dir * 64 + n) * 17 + pw) * 2 + 1];
                z[j] = ri ? -(cr * ai + ci * ar) : (cr * ar - ci * ai); }
        }
        u32x4 o; o.x = cvtpk(z[0], z[1]); o.y = cvtpk(z[2], z[3]); o.z = cvtpk(z[4], z[5]); o.w = cvtpk(z[6], z[7]);
        *(u32x4*)(ws + WS_MFT + ((size_t)((g * 8 + nt) * 32 + ks)) * 1024 + lane * 16) = o;
    }
    __syncthreads();
}
__device__ __forceinline__ int crow16(int r, int hi) { return (r & 3) + 8 * (r >> 2) + 4 * hi; }
__device__ __forceinline__ void s5_estate(unsigned char* ws, int gw, int ngw, int lane) {
    for (int task = gw; task < SG * 16 * 2; task += ngw) {
        const int nh = task & 1, rt = (task >> 1) & 15, g = task >> 5, r32 = lane & 31, hi = lane >> 5;
        const bf16_t* A = (const bf16_t*)(ws + WS_UG) + ((size_t)(g * NROW + rt * 32 + r32)) * 256 + hi * 8;
        const unsigned char* B = ws + WS_EMAT + (size_t)(g * 8 + nh * 4) * 16 * 1024 + lane * 16;
        f32x16 acc[4] = {};
#pragma unroll 4
        for (int ks = 0; ks < 16; ++ks) { const bf16x8 a = *(const bf16x8*)(A + ks * 16);
#pragma unroll
            for (int nt = 0; nt < 4; ++nt) { const bf16x8 b = *(const bf16x8*)(B + (size_t)(nt * 16 + ks) * 1024); acc[nt] = __builtin_amdgcn_mfma_f32_32x32x16_bf16(a, b, acc[nt], 0, 0, 0); } }
        float* S = (float*)(ws + WS_SLOC) + ((size_t)(g * NROW + rt * 32)) * 256 + nh * 128 + r32;
#pragma unroll
        for (int nt = 0; nt < 4; ++nt)
#pragma unroll
            for (int r = 0; r < 16; ++r) S[(size_t)crow16(r, hi) * 256 + nt * 32] = acc[nt][r];
    }
}
__device__ __forceinline__ void s5_scan(unsigned char* ws, int gw, int ngw, int lane) {
    for (int task = gw; task < BATCH * SG * 2; task += ngw) {
        const int dir = task & 1, g = (task >> 1) & 63, b = task >> 7;
        const float* AT = (const float*)(ws + WS_ATAB) + ((g * 2 + dir) * 64 + lane) * 2; const float ar = AT[0], ai = AT[1];
        const float* S = (const float*)(ws + WS_SLOC) + ((size_t)(g * NROW + b * NCH)) * 256 + dir * 128 + lane;
        bf16_t* H = (bf16_t*)(ws + WS_HIN) + ((size_t)(g * NROW + b * NCH)) * 256 + dir * 128 + lane;
        float hr = 0.f, hi = 0.f;
        for (int c0 = 0; c0 < NCH; c0 += 16) {
            float sr[16], si[16];
#pragma unroll
            for (int k = 0; k < 16; ++k) { const int c = dir == 0 ? c0 + k : NCH - 1 - (c0 + k); sr[k] = S[(size_t)c * 256]; si[k] = S[(size_t)c * 256 + 64]; }
#pragma unroll
            for (int k = 0; k < 16; ++k) { const int c = dir == 0 ? c0 + k : NCH - 1 - (c0 + k);
                H[(size_t)c * 256] = (bf16_t)(cvtpk(hr, 0.f) & 0xffffu); H[(size_t)c * 256 + 64] = (bf16_t)(cvtpk(hi, 0.f) & 0xffffu);
                const float nr = ar * hr - ai * hi + sr[k], ni = ar * hi + ai * hr + si[k]; hr = nr; hi = ni; }
        }
    }
}
__device__ __forceinline__ void s5_output(unsigned char* ws, int gw, int ngw, int lane) {
    for (int task = gw; task < SG * 16 * 2; task += ngw) {
        const int nh = task & 1, rt = (task >> 1) & 15, g = task >> 5, r32 = lane & 31, hi = lane >> 5;
        const bf16_t* A0 = (const bf16_t*)(ws + WS_UG) + ((size_t)(g * NROW + rt * 32 + r32)) * 256 + hi * 8;
        const bf16_t* A1 = (const bf16_t*)(ws + WS_HIN) + ((size_t)(g * NROW + rt * 32 + r32)) * 256 + hi * 8;
        const unsigned char* B = ws + WS_MFT + (size_t)(g * 8 + nh * 4) * 32 * 1024 + lane * 16;
        f32x16 acc[4] = {};
#pragma unroll 4
        for (int ks = 0; ks < 16; ++ks) { const bf16x8 a = *(const bf16x8*)(A0 + ks * 16);
#pragma unroll
            for (int nt = 0; nt < 4; ++nt) { const bf16x8 b = *(const bf16x8*)(B + (size_t)(nt * 32 + ks) * 1024); acc[nt] = __builtin_amdgcn_mfma_f32_32x32x16_bf16(a, b, acc[nt], 0, 0, 0); } }
#pragma unroll 4
        for (int ks = 0; ks < 16; ++ks) { const bf16x8 a = *(const bf16x8*)(A1 + ks * 16);
#pragma unroll
            for (int nt = 0; nt < 4; ++nt) { const bf16x8 b = *(const bf16x8*)(B + (size_t)(nt * 32 + 16 + ks) * 1024); acc[nt] = __builtin_amdgcn_mfma_f32_32x32x16_bf16(a, b, acc[nt], 0, 0, 0); } }
        bf16_t* GBp = (bf16_t*)(ws + WS_GB);
#pragma unroll
        for (int nt = 0; nt < 4; ++nt) { const int no = nh * 128 + nt * 32 + r32, tau = no >> 4, pp = no & 15;
#pragma unroll
            for (int r = 0; r < 16; ++r) { const int crw = rt * 32 + crow16(r, hi); const float y = acc[nt][r];
                const float z2 = 1.5957691216057308f * (y + 0.044715f * y * y * y);
                const float gl = y * __builtin_amdgcn_rcpf(1.0f + __builtin_amdgcn_exp2f(-1.4426950408889634f * z2));
                GBp[(size_t)(crw * 16 + tau) * SW + g * 16 + pp] = (bf16_t)(cvtpk(gl, 0.f) & 0xffffu); } }
    }
}
__global__ void __launch_bounds__(NWAVES * 64, 2) fwd_megakernel(Params p) {
    extern __shared__ __attribute__((aligned(16))) unsigned char lds[];
    cg::grid_group grid = cg::this_grid();
    const int tid = threadIdx.x, lane = tid & 63, wave = __builtin_amdgcn_readfirstlane(tid >> 6);
    const int G = gridDim.x, bx = blockIdx.x, vcu = (G % 8 == 0) ? (bx % 8) * (G / 8) + bx / 8 : bx;
    const int gw = vcu * NWAVES + wave, ngw = G * NWAVES;
    unsigned char* ws = p.ws;
    LAS unsigned char* ldsl = (LAS unsigned char*)lds;
    LAS float* scr = (LAS float*)(ldsl + wave * 8448);
    const int lo = p.ph_lo, hi = p.ph_hi;
#ifndef PH_MASK
#define PH_MASK 0x7fff
#endif
#define IN(k) (((PH_MASK >> (k)) & 1) && lo <= (k) && (k) < hi)
#define SEAM(k) do { if (IN(k) && IN((k) + 1)) grid.sync(); } while (0)
    bf16_t* XN = (bf16_t*)(ws + WS_XN); bf16_t* HFF = (bf16_t*)(ws + WS_HFF); float* Y = (float*)(ws + WS_Y); float* SSQ = (float*)(ws + WS_SSQ); float* SSQ2 = (float*)(ws + WS_SSQ2);
    bf16_t* QKV = (bf16_t*)(ws + WS_QKV); bf16_t* UG = (bf16_t*)(ws + WS_UG); bf16_t* GB = (bf16_t*)(ws + WS_GB); bf16_t* SPRE = (bf16_t*)(ws + WS_SPRE);

    if (IN(0)) {
        convert_ffn(p.in[2], p.in[3], p.in[4], ws, scr, gw, ngw, lane);
        convert_plain(p.in[7], DM, INC, (bf16_t*)(ws + WS_WIN), scr, gw, ngw, lane);
        convert_plain(p.in[24], DM, DM, (bf16_t*)(ws + WS_WOUT), scr, gw, ngw, lane);
        convert_plain(p.in[21], SW, SW, (bf16_t*)(ws + WS_WGLU), scr, gw, ngw, lane);
        prenorm_rows(p.in[0], p.in[1], XN, gw, ngw, lane);
        for (int g = G - 1 - bx; g < SG; g += G) s5_tables(p, g, (float*)lds);
    }
    SEAM(0);
#define FFN_GATEUP() do { pg8::Gemm g{XN, (const bf16_t*)(ws + WS_W1G), MT, NGU, DM}; pg8::StaticOrder S; S.init(MT, NGU, G, bx); \
            pg8::EpiSwiGLU E{HFF, DFF}; pg8::gemm_phase<pg8::EpiSwiGLU, pg8::StaticOrder, true, true>(ldsl, g, S, E); } while (0)
#define FFN_DOWN() do { pg8::Gemm g{HFF, (const bf16_t*)(ws + WS_W1D), MT, DM, DFF}; pg8::StaticOrder S; S.init(MT, DM, G, bx); \
            pg8::EpiYSsq E{Y, SSQ, 32}; pg8::gemm_phase<pg8::EpiYSsq, pg8::StaticOrder, true, true>(ldsl, g, S, E); } while (0)
    if (IN(1)) FFN_GATEUP();
    SEAM(1);
    if (IN(2)) FFN_DOWN();
    SEAM(2);
    if (IN(3)) { resid_rows(p.in[0], Y, SSQ, 32, p.in[5], 0.5f, p.out, p.in[6], XN, gw, ngw, lane);
                 convert_ffn(p.in[27], p.in[28], p.in[29], ws, scr, gw, ngw, lane); }
    SEAM(3);
    if (IN(4)) {
        pg8::Gemm g{XN, (const bf16_t*)(ws + WS_WIN), MT, INC, DM}; pg8::StaticOrder S; S.init(MT, INC, G, bx);
        pg8::EpiQKVU E{QKV, UG, 0.125f * 1.4426950408889634f};
        pg8::gemm_phase<pg8::EpiQKVU, pg8::StaticOrder, true, true>(ldsl, g, S, E);
    }
    SEAM(4);
    if (IN(5)) {
        float lam;
        { const float a = wave_sum(p.in[8][lane] * p.in[9][lane]), c = wave_sum(p.in[10][lane] * p.in[11][lane]); lam = expf(a) - expf(c) + 0.2f; }
        for (int u = vcu; u < BATCH * 8 * 16; u += G) att::attn_unit(QKV, XN, u >> 7, (u >> 4) & 7, u & 15, lam, p.in[12], (char*)lds);
        s5_estate(ws, gw, ngw, lane);
    }
    SEAM(5);
    if (IN(6)) s5_scan(ws, gw, ngw, lane);
    SEAM(6);
    if (IN(7)) s5_output(ws, gw, ngw, lane);
    SEAM(7);
    if (IN(8)) {
        pg8::Gemm g{GB, (const bf16_t*)(ws + WS_WGLU), MT, SW, SW}; pg8::StaticOrder S; S.init(MT, SW, G, bx);
        pg8::EpiGLU E{GB, SPRE, p.in[22], SSQ2};
        pg8::gemm_phase<pg8::EpiGLU, pg8::StaticOrder, true, true>(ldsl, g, S, E);
    }
    SEAM(8);
    if (IN(9)) snorm_rows(SPRE, SSQ2, p.in[23], XN, gw, ngw, lane);
    SEAM(9);
    if (IN(10)) {
        pg8::Gemm g{XN, (const bf16_t*)(ws + WS_WOUT), MT, DM, DM}; pg8::StaticOrder S; S.init(MT, DM, G, bx);
        pg8::EpiYSsq E{Y, SSQ, 32};
        pg8::gemm_phase<pg8::EpiYSsq, pg8::StaticOrder, true, true>(ldsl, g, S, E);
    }
    SEAM(10);
    if (IN(11)) resid_rows(p.out, Y, SSQ, 32, p.in[25], 1.0f, p.out, p.in[26], XN, gw, ngw, lane);
    SEAM(11);
    if (IN(12)) FFN_GATEUP();
    SEAM(12);
    if (IN(13)) FFN_DOWN();
    SEAM(13);
    if (IN(14)) resid_rows(p.out, Y, SSQ, 32, p.in[30], 0.5f, p.out, nullptr, nullptr, gw, ngw, lane);
#undef IN
#undef SEAM
}

extern "C" void kernel_launch(void* const* d_in, const int* in_sizes, int n_in, void* d_out, int out_size, void* d_ws, size_t ws_size, hipStream_t stream) {
    static int grid = 0;
    if (grid == 0) {
        if (n_in != 31 || in_sizes[0] != MT * DM || out_size != MT * DM || ws_size < WS_END) {
            fprintf(stderr, "kernel_launch: shape/workspace mismatch: n_in %d in0 %d out %d ws %zu (need %zu)\n", n_in, n_in > 0 ? in_sizes[0] : -1, out_size, ws_size, (size_t)WS_END); grid = -1; return; }
        int dev = 0, cus = 0, per_cu = 0;
        hipGetDevice(&dev); hipDeviceGetAttribute(&cus, hipDeviceAttributeMultiprocessorCount, dev);
        if (hipFuncSetAttribute((const void*)fwd_megakernel, hipFuncAttributeMaxDynamicSharedMemorySize, LDS_BYTES) != hipSuccess) { fprintf(stderr, "kernel_launch: hipFuncSetAttribute failed\n"); grid = -1; return; }
        if (hipOccupancyMaxActiveBlocksPerMultiprocessor(&per_cu, (const void*)fwd_megakernel, NWAVES * 64, LDS_BYTES) != hipSuccess || per_cu < 1) { fprintf(stderr, "kernel_launch: occupancy query says %d\n", per_cu); (void)hipGetLastError(); per_cu = 1; }
        grid = cus;
        fprintf(stderr, "kernel_launch: grid %d (cus %d x per_cu %d), ws %zu need %zu\n", grid, cus, per_cu, ws_size, (size_t)WS_END);
    }
    if (grid < 0) return;
    Params p{};
    for (int i = 0; i < 31; ++i) p.in[i] = (const float*)d_in[i];
    p.out = (float*)d_out; p.ws = (unsigned char*)d_ws;
#if MK_N_LAUNCHES == 1
    p.ph_lo = 0; p.ph_hi = 15;
    void* args[] = {&p};
    hipError_t e = hipLaunchCooperativeKernel((const void*)fwd_megakernel, dim3(grid), dim3(NWAVES * 64), args, LDS_BYTES, stream);
    if (e != hipSuccess) fprintf(stderr, "cooperative launch failed: %s (grid %d)\n", hipGetErrorString(e), grid);
#else
    for (int k = 0; k < 15; ++k) { p.ph_lo = k; p.ph_hi = k + 1; hipLaunchKernelGGL(fwd_megakernel, dim3(grid), dim3(NWAVES * 64), LDS_BYTES, stream, p); }
#endif
}
```

```cpp
#include <hip/hip_runtime.h>
#include <hip/hip_cooperative_groups.h>
#include <cstdio>
#include <cstdint>
namespace cg = cooperative_groups;
#ifndef MK_N_LAUNCHES
#define MK_N_LAUNCHES 1
#endif
namespace pg8 {
#define PG8_LAS __attribute__((address_space(3)))
typedef unsigned short bf16_t;
typedef short bf16x8 __attribute__((ext_vector_type(8)));
typedef float f32x4 __attribute__((ext_vector_type(4)));
typedef unsigned u32x4 __attribute__((ext_vector_type(4)));
constexpr int BM = 256, BK = 64, HALF = 128, HTB = HALF * BK * 2  , STAGE_BYTES = 8 * HTB, NXCD = 8, WGM = 8;

__host__ __device__ __forceinline__ int lds_byte(int r, int c) { const int st = (r >> 4) * 2 + (c >> 5), rr = r & 15, cc = c & 31, ob = rr * 64 + cc * 2; return st * 1024 + (ob ^ (((ob >> 9) & 1) << 5)); }
__host__ __device__ __forceinline__ void stage_rc(int b, int& R, int& C) { const int st = b / 1024, sb = b % 1024, swz = sb ^ (((sb >> 9) & 1) << 5); R = (st >> 1) * 16 + swz / 64; C = (st & 1) * 32 + (swz % 64) / 2; }
__host__ __device__ __forceinline__ int perm32(int rho) { const int n = rho >> 4, i = rho & 15; return 8 * (i >> 2) + 4 * n + (i & 3); }

struct Unit { int pm, pn; };
struct Gemm { const bf16_t* A; const bf16_t* Bt; int M, N, K; };

struct StaticOrder {
    int nM, nN, nwg, G, c;
    __host__ __device__ void init(int M, int N, int G_, int c_) { nM = M / BM; nN = N / BM; nwg = nM * nN; G = G_; c = c_; }
    __host__ __device__ bool next(int i, Unit& u) const {
        const long L = (long)i * G + c; if (L >= nwg) return false;
        int wgid = (int)L; { const int q = nwg / NXCD, r = nwg % NXCD, xcd = wgid % NXCD, off = wgid / NXCD; wgid = (xcd < r ? xcd * (q + 1) : r * (q + 1) + (xcd - r) * q) + off; }
        const int nig = WGM * nN, gid = wgid / nig, fm = gid * WGM, gsz = (nM - fm) < WGM ? (nM - fm) : WGM;
        u.pm = fm + ((wgid % nig) % gsz); u.pn = (wgid % nig) / gsz; return true;
    }
    __device__ __forceinline__ void a_ready(const Unit&) const {}
    __device__ __forceinline__ void done(const Unit&) const {}
};

__device__ __forceinline__ unsigned cvt_pk_bf16(float lo, float hi) { unsigned r; asm volatile("v_cvt_pk_bf16_f32 %0, %1, %2" : "=v"(r) : "v"(lo), "v"(hi)); return r; }
typedef unsigned u32x2 __attribute__((ext_vector_type(2)));
__device__ __forceinline__ float bf_lo(unsigned w) { return __uint_as_float(w << 16); }
__device__ __forceinline__ float bf_hi(unsigned w) { return __uint_as_float(w & 0xffff0000u); }
__device__ __forceinline__ float sigmoid_f(float z) { return __builtin_amdgcn_rcpf(1.0f + __builtin_amdgcn_exp2f(-1.4426950408889634f * z)); }
__device__ __forceinline__ float silu_f(float z) { return z * sigmoid_f(z); }

struct EpiSwiGLU {
    static constexpr bool PERM = true, AFTER_DRAIN = false;
    bf16_t* O; int ldc;
    __device__ __forceinline__ void operator()(const f32x4 (&acc)[2][2][4][2], const Unit& u, int wr, int wc, int fr, int fq) const {
        const int row0 = u.pm * BM + wr * 64 + fr, col0 = u.pn * HALF + wc * 32 + 8 * fq;
#pragma unroll
        for (int ai = 0; ai < 2; ++ai)
#pragma unroll
            for (int m = 0; m < 4; ++m) {
                bf16_t* rowp = O + (size_t)(row0 + ai * HALF + m * 16) * ldc + col0;
                const f32x4 g0 = acc[ai][0][m][0], g1 = acc[ai][0][m][1], u0 = acc[ai][1][m][0], u1 = acc[ai][1][m][1];
                u32x4 w;
                w.x = cvt_pk_bf16(silu_f(g0[0]) * u0[0], silu_f(g0[1]) * u0[1]); w.y = cvt_pk_bf16(silu_f(g0[2]) * u0[2], silu_f(g0[3]) * u0[3]);
                w.z = cvt_pk_bf16(silu_f(g1[0]) * u1[0], silu_f(g1[1]) * u1[1]); w.w = cvt_pk_bf16(silu_f(g1[2]) * u1[2], silu_f(g1[3]) * u1[3]);
                *(u32x4*)rowp = w;
            }
    }
};
struct EpiQKVU {
    static constexpr bool PERM = true, AFTER_DRAIN = false;
    bf16_t* QKV; bf16_t* UG; float qscale;
    __device__ __forceinline__ void operator()(const f32x4 (&acc)[2][2][4][2], const Unit& u, int wr, int wc, int fr, int fq) const {
        const int row0 = u.pm * BM + wr * 64 + fr, colt = u.pn * BM;
        const float sc = colt < 1024 ? qscale : 1.0f;
#pragma unroll
        for (int ai = 0; ai < 2; ++ai)
#pragma unroll
            for (int m = 0; m < 4; ++m) {
                const int row = row0 + ai * HALF + m * 16;
#pragma unroll
                for (int bj = 0; bj < 2; ++bj) {
                    const int col = colt + bj * HALF + wc * 32 + 8 * fq;
                    const f32x4 v0 = acc[ai][bj][m][0] * sc, v1 = acc[ai][bj][m][1] * sc;
                    u32x4 w; w.x = cvt_pk_bf16(v0[0], v0[1]); w.y = cvt_pk_bf16(v0[2], v0[3]); w.z = cvt_pk_bf16(v1[0], v1[1]); w.w = cvt_pk_bf16(v1[2], v1[3]);
                    bf16_t* dst;
                    if (colt < 3072) dst = QKV + (size_t)row * 3072 + col;
                    else { const int cc = col - 3072; dst = UG + ((size_t)((cc >> 4) * 512 + (row >> 4)) * 256 + (row & 15) * 16 + (cc & 15)); }
                    *(u32x4*)dst = w;
                }
            }
    }
};
struct EpiYSsq {
    static constexpr bool PERM = false, AFTER_DRAIN = false;
    float* Y; float* SSQ; int npart;
    __device__ __forceinline__ void operator()(const f32x4 (&acc)[2][2][4][2], const Unit& u, int wr, int wc, int fr, int fq) const {
        const int row0 = u.pm * BM + wr * 64 + fr, col0 = u.pn * BM + wc * 32 + 4 * fq;
#pragma unroll
        for (int ai = 0; ai < 2; ++ai)
#pragma unroll
            for (int m = 0; m < 4; ++m) {
                const int row = row0 + ai * HALF + m * 16; float s = 0.f;
#pragma unroll
                for (int bj = 0; bj < 2; ++bj)
#pragma unroll
                    for (int n = 0; n < 2; ++n) { const f32x4 v = acc[ai][bj][m][n]; s += (v[0] * v[0] + v[1] * v[1]) + (v[2] * v[2] + v[3] * v[3]);
                        *(f32x4*)(Y + (size_t)row * 2048 + col0 + bj * HALF + n * 16) = v; }
                s += __shfl_xor(s, 16); s += __shfl_xor(s, 32);
                if (fq == 0) SSQ[(size_t)row * npart + u.pn * 4 + wc] = s;
            }
    }
};
struct EpiGLU {
    static constexpr bool PERM = true, AFTER_DRAIN = false;
    const bf16_t* GB; bf16_t* SPRE; const float* bias; float* SSQ2;
    __device__ __forceinline__ void operator()(const f32x4 (&acc)[2][2][4][2], const Unit& u, int wr, int wc, int fr, int fq) const {
        const int row0 = u.pm * BM + wr * 64 + fr, colb = u.pn * BM + wc * 32 + 8 * fq;
#pragma unroll
        for (int ai = 0; ai < 2; ++ai)
#pragma unroll
            for (int m = 0; m < 4; ++m) {
                const int row = row0 + ai * HALF + m * 16; float s = 0.f;
#pragma unroll
                for (int bj = 0; bj < 2; ++bj) {
                    const int col = colb + bj * HALF;
                    const u32x4 gw = *(const u32x4*)(GB + (size_t)row * 1024 + col);
                    const f32x4 b0 = *(const f32x4*)(bias + col), b1 = *(const f32x4*)(bias + col + 4);
                    const f32x4 z0 = acc[ai][bj][m][0] + b0, z1 = acc[ai][bj][m][1] + b1;
                    float o[8];
                    o[0] = bf_lo(gw.x) * sigmoid_f(z0[0]); o[1] = bf_hi(gw.x) * sigmoid_f(z0[1]); o[2] = bf_lo(gw.y) * sigmoid_f(z0[2]); o[3] = bf_hi(gw.y) * sigmoid_f(z0[3]);
                    o[4] = bf_lo(gw.z) * sigmoid_f(z1[0]); o[5] = bf_hi(gw.z) * sigmoid_f(z1[1]); o[6] = bf_lo(gw.w) * sigmoid_f(z1[2]); o[7] = bf_hi(gw.w) * sigmoid_f(z1[3]);
#pragma unroll
                    for (int k = 0; k < 8; ++k) s += o[k] * o[k];
                    u32x4 w; w.x = cvt_pk_bf16(o[0], o[1]); w.y = cvt_pk_bf16(o[2], o[3]); w.z = cvt_pk_bf16(o[4], o[5]); w.w = cvt_pk_bf16(o[6], o[7]);
                    *(u32x4*)(SPRE + (size_t)row * 1024 + col) = w;
                }
                s += __shfl_xor(s, 16); s += __shfl_xor(s, 32);
                if (fq == 0) SSQ2[(size_t)row * 16 + u.pn * 4 + wc] = s;
            }
    }
};
template <class Epi, class Sched, bool ALIGN_EPI = false, bool SP2 = false>
__device__ __forceinline__ void gemm_phase(PG8_LAS unsigned char* lds, const Gemm g, const Sched& S, const Epi& E) {
    const int tid = threadIdx.x, wid = __builtin_amdgcn_readfirstlane(tid >> 6), lane = tid & 63, wr = wid >> 2, wc = wid & 3, fr = lane & 15, fq = lane >> 4;
    const int K = g.K, nt = K / BK;
    unsigned voffA[2], voffB[2];
#pragma unroll
    for (int i = 0; i < 2; ++i) { int R, C; stage_rc(tid * 16 + i * 8192, R, C); const int Rb = Epi::PERM ? ((R & ~31) + perm32(R & 31)) : R;
        voffA[i] = (unsigned)(R * K + C) * 2u; voffB[i] = (unsigned)(Rb * K + C) * 2u; }
    const size_t kstep = (size_t)(BK * 2);
    const size_t hstep = (size_t)HALF * K * 2;
    const size_t tstep = 2 * hstep;
    const unsigned ldsw = (unsigned)wid * 1024u;
    const int aoff = lds_byte(wr * 64 + fr, fq * 8), boff = lds_byte(wc * 32 + fr, fq * 8);
#define PG8_SA(b, h) (((b) * 2 + (h)) * HTB)
#define PG8_SB(b, h) ((4 + (b) * 2 + (h)) * HTB)
#define PG8_STAGE(bufoff, gbase, voff) do { _Pragma("unroll") for (int _i = 0; _i < 2; ++_i) \
        __builtin_amdgcn_global_load_lds((const unsigned*)((const char*)(gbase) + (voff)[_i]), (PG8_LAS unsigned*)(lds + (bufoff) + ldsw + _i * 8192), 16, 0, 0); } while (0)
#define PG8_LDA(dst, b, h) do { _Pragma("unroll") for (int m = 0; m < 4; ++m) _Pragma("unroll") for (int k = 0; k < 2; ++k) dst[m][k] = *(const PG8_LAS bf16x8*)(lds + PG8_SA(b, h) + aoff + m * 2048 + k * 1024); } while (0)
#define PG8_LDB(dst, b, h) do { _Pragma("unroll") for (int n = 0; n < 2; ++n) _Pragma("unroll") for (int k = 0; k < 2; ++k) dst[n][k] = *(const PG8_LAS bf16x8*)(lds + PG8_SB(b, h) + boff + n * 2048 + k * 1024); } while (0)
#define PG8_MMA(ai, bj, At, Bt) do { __builtin_amdgcn_s_setprio(1); _Pragma("unroll") for (int m = 0; m < 4; ++m) _Pragma("unroll") for (int n = 0; n < 2; ++n) _Pragma("unroll") for (int k = 0; k < 2; ++k) \
        acc[ai][bj][m][n] = __builtin_amdgcn_mfma_f32_16x16x32_bf16(Bt[n][k], At[m][k], acc[ai][bj][m][n], 0, 0, 0); __builtin_amdgcn_s_setprio(0); } while (0)
#define PG8_WAIT_V(n) asm volatile("s_waitcnt vmcnt(" #n ")" ::: "memory")
#define PG8_WAIT_L(n) asm volatile("s_waitcnt lgkmcnt(" #n ")" ::: "memory")
#define PG8_BAR __builtin_amdgcn_s_barrier()
#define PG8_SCHED __builtin_amdgcn_sched_barrier(0)
    Unit cur, nxt; int ui = 0;
    if (!S.next(0, cur)) return;
    f32x4 acc[2][2][4][2];
#pragma unroll
    for (int a = 0; a < 2; ++a)
#pragma unroll
        for (int b = 0; b < 2; ++b)
#pragma unroll
            for (int m = 0; m < 4; ++m)
#pragma unroll
                for (int n = 0; n < 2; ++n) acc[a][b][m][n] = (f32x4){0.f, 0.f, 0.f, 0.f};
    bf16x8 At[4][2], B0[2][2], B1[2][2];
    const char* cA = (const char*)g.A + (size_t)cur.pm * tstep; const char* cB = (const char*)g.Bt + (size_t)cur.pn * tstep;
    S.a_ready(cur);
    if constexpr (SP2) {
        PG8_STAGE(PG8_SB(0, 0), cB, voffB); PG8_STAGE(PG8_SB(0, 1), cB + hstep, voffB); PG8_STAGE(PG8_SA(0, 0), cA, voffA); PG8_STAGE(PG8_SA(0, 1), cA + hstep, voffA);
        if (wr == 1) PG8_BAR;
        PG8_WAIT_V(2); PG8_BAR;
        PG8_STAGE(PG8_SB(1, 0), cB + kstep, voffB); PG8_STAGE(PG8_SA(1, 0), cA + kstep, voffA); PG8_STAGE(PG8_SB(1, 1), cB + hstep + kstep, voffB);
        PG8_WAIT_V(6); PG8_BAR;
    } else {
        PG8_STAGE(PG8_SB(0, 0), cB, voffB); PG8_STAGE(PG8_SA(0, 0), cA, voffA); PG8_STAGE(PG8_SB(0, 1), cB + hstep, voffB); PG8_STAGE(PG8_SA(0, 1), cA + hstep, voffA);
        if (wr == 1) PG8_BAR;
        PG8_WAIT_V(4); PG8_BAR;
        PG8_STAGE(PG8_SB(1, 0), cB + kstep, voffB); PG8_STAGE(PG8_SA(1, 0), cA + kstep, voffA); PG8_STAGE(PG8_SB(1, 1), cB + hstep + kstep, voffB);
        PG8_WAIT_V(6); PG8_BAR;
    }
    for (;;) {
        const bool has_next = S.next(ui + 1, nxt);
        const char* nA = has_next ? (const char*)g.A + (size_t)nxt.pm * tstep : cA; const char* nB = has_next ? (const char*)g.Bt + (size_t)nxt.pn * tstep : cB;
        for (int t = 0; t < nt; t += 2) {
            const bool last = (t == nt - 2);
            const char* a1 = cA + (size_t)(t + 1) * kstep;
            const char* a2 = last ? nA : cA + (size_t)(t + 2) * kstep; const char* b2 = last ? nB : cB + (size_t)(t + 2) * kstep;
            const char* a3 = a2 + kstep; const char* b3 = b2 + kstep;
            if (last && has_next) S.a_ready(nxt);
            if constexpr (SP2) {
            PG8_LDB(B0, 0, 0); PG8_LDB(B1, 0, 1); PG8_SCHED; PG8_LDA(At, 0, 0); PG8_STAGE(PG8_SA(1, 1), a1 + hstep, voffA);
            PG8_WAIT_V(8); PG8_WAIT_L(0); PG8_BAR; PG8_MMA(0, 0, At, B0); PG8_MMA(0, 1, At, B1); PG8_BAR; PG8_SCHED;
            PG8_LDA(At, 0, 1); PG8_STAGE(PG8_SB(0, 0), b2, voffB); PG8_STAGE(PG8_SB(0, 1), b2 + hstep, voffB); PG8_STAGE(PG8_SA(0, 0), a2, voffA);
            PG8_WAIT_V(8); PG8_WAIT_L(0); PG8_BAR; PG8_MMA(1, 0, At, B0); PG8_MMA(1, 1, At, B1); PG8_BAR; PG8_SCHED;
            PG8_LDB(B0, 1, 0); PG8_LDB(B1, 1, 1); PG8_SCHED; PG8_LDA(At, 1, 0); PG8_STAGE(PG8_SA(0, 1), a2 + hstep, voffA);
            PG8_WAIT_V(8); PG8_WAIT_L(0); PG8_BAR; PG8_MMA(0, 0, At, B0); PG8_MMA(0, 1, At, B1); PG8_BAR; PG8_SCHED;
            PG8_LDA(At, 1, 1); PG8_STAGE(PG8_SB(1, 0), b3, voffB); PG8_STAGE(PG8_SB(1, 1), b3 + hstep, voffB); PG8_STAGE(PG8_SA(1, 0), a3, voffA);
            PG8_WAIT_V(8); PG8_WAIT_L(0); PG8_BAR; PG8_MMA(1, 0, At, B0); PG8_MMA(1, 1, At, B1); PG8_BAR; PG8_SCHED;
            } else {
            PG8_LDB(B0, 0, 0); PG8_SCHED; PG8_LDA(At, 0, 0); PG8_STAGE(PG8_SA(1, 1), a1 + hstep, voffA);
            PG8_WAIT_L(8); PG8_BAR; PG8_WAIT_L(0); PG8_MMA(0, 0, At, B0); PG8_BAR; PG8_SCHED;
            PG8_LDB(B1, 0, 1); PG8_STAGE(PG8_SB(0, 0), b2, voffB);
            PG8_BAR; PG8_WAIT_L(0); PG8_MMA(0, 1, At, B1); PG8_BAR;
            PG8_LDA(At, 0, 1); PG8_STAGE(PG8_SA(0, 0), a2, voffA);
            PG8_BAR; PG8_WAIT_L(0); PG8_MMA(1, 0, At, B0); PG8_BAR; PG8_SCHED;
            PG8_STAGE(PG8_SB(0, 1), b2 + hstep, voffB);
            PG8_WAIT_V(6); PG8_BAR; PG8_MMA(1, 1, At, B1); PG8_BAR;
            PG8_LDB(B0, 1, 0); PG8_SCHED; PG8_LDA(At, 1, 0); PG8_STAGE(PG8_SA(0, 1), a2 + hstep, voffA);
            PG8_WAIT_L(8); PG8_BAR; PG8_WAIT_L(0); PG8_MMA(0, 0, At, B0); PG8_BAR; PG8_SCHED;
            PG8_LDB(B1, 1, 1); PG8_STAGE(PG8_SB(1, 0), b3, voffB);
            PG8_BAR; PG8_WAIT_L(0); PG8_MMA(0, 1, At, B1); PG8_BAR;
            PG8_LDA(At, 1, 1); PG8_STAGE(PG8_SA(1, 0), a3, voffA);
            PG8_BAR; PG8_WAIT_L(0); PG8_MMA(1, 0, At, B0); PG8_BAR; PG8_SCHED;
            PG8_STAGE(PG8_SB(1, 1), b3 + hstep, voffB);
            PG8_WAIT_V(6); PG8_BAR; PG8_MMA(1, 1, At, B1); PG8_BAR;
            }
        }
        if constexpr (ALIGN_EPI) { if (wr == 0) PG8_BAR; }
        if constexpr (!Epi::AFTER_DRAIN) { E(acc, cur, wr, wc, fr, fq); S.done(cur); }
        if (!has_next) break;
#pragma unroll
        for (int a = 0; a < 2; ++a)
#pragma unroll
            for (int b = 0; b < 2; ++b)
#pragma unroll
                for (int m = 0; m < 4; ++m)
#pragma unroll
                    for (int n = 0; n < 2; ++n) acc[a][b][m][n] = (f32x4){0.f, 0.f, 0.f, 0.f};
        cur = nxt; cA = nA; cB = nB; ++ui;
        if constexpr (ALIGN_EPI) { if (wr == 1) PG8_BAR; }
    }
    PG8_WAIT_V(0);
    if constexpr (!ALIGN_EPI) { if (wr == 0) PG8_BAR; }
    PG8_BAR;
    if constexpr (Epi::AFTER_DRAIN) { E.fused(acc, cur, wr, wc, fr, fq, lds, wid, lane); S.done(cur); }
#undef PG8_SA
#undef PG8_SB
#undef PG8_STAGE
#undef PG8_LDA
#undef PG8_LDB
#undef PG8_MMA
#undef PG8_WAIT_V
#undef PG8_WAIT_L
#undef PG8_BAR
#undef PG8_SCHED
}
}
namespace att {
typedef short bf16x8 __attribute__((ext_vector_type(8)));
typedef short s16x4 __attribute__((ext_vector_type(4)));
typedef float f32x16 __attribute__((ext_vector_type(16)));
typedef float f32x4 __attribute__((ext_vector_type(4)));
typedef unsigned u32x4 __attribute__((ext_vector_type(4)));
typedef unsigned short bf16_t;
constexpr int KVBLK = 64, LDK = 3072, NT = 2048 / KVBLK;
constexpr int SHM_V = KVBLK * 128 * 2, SHM_K = KVBLK * 128 * 2;
constexpr int WS_OFF = 131072;
constexpr float THRL = 11.5f;
#ifndef ATT_SDEPTH
#define ATT_SDEPTH 1
#endif
constexpr int SDEPTH = ATT_SDEPTH;
#define KSWZ(row, colB) ((row) * 256 + ((colB) ^ (((row) & 7) << 4)))
#define SBAR() __builtin_amdgcn_sched_barrier(0)
__device__ __forceinline__ int crow(int r, int hi) { return (r & 3) + 8 * (r >> 2) + 4 * hi; }
__device__ __forceinline__ unsigned cvtpk(float lo, float hi) { unsigned r; asm volatile("v_cvt_pk_bf16_f32 %0, %1, %2" : "=v"(r) : "v"(lo), "v"(hi)); return r; }

__device__ __forceinline__ void partialSM(f32x16& p0, f32x16& p1, float& m_reg, float& mn, float& alpha) {
  float pmax = p0[0];
#pragma unroll
  for (int r = 1; r < 16; ++r) pmax = fmaxf(pmax, p0[r]);
#pragma unroll
  for (int r = 0; r < 16; ++r) pmax = fmaxf(pmax, p1[r]);
  { auto rr = __builtin_amdgcn_permlane32_swap(__float_as_uint(pmax), __float_as_uint(pmax), false, false);
    pmax = fmaxf(__uint_as_float(rr[0]), __uint_as_float(rr[1])); }
  if (__builtin_expect(__all(pmax - m_reg <= THRL), 1)) { mn = m_reg; alpha = 1.f; }
  else { mn = fmaxf(m_reg, pmax); alpha = __builtin_amdgcn_exp2f(m_reg - mn); m_reg = mn; }
#pragma unroll
  for (int r = 0; r < 16; ++r) p0[r] = p0[r] - mn;
#pragma unroll
  for (int r = 0; r < 16; ++r) p1[r] = p1[r] - mn;
#pragma unroll
  for (int r = 0; r < 16; ++r) p0[r] = __builtin_amdgcn_exp2f(p0[r]);
}
__device__ __forceinline__ void finishSM(f32x16& p0, f32x16& p1, float alpha, float& l_reg, bf16x8& pa0, bf16x8& pa1, bf16x8& pa2, bf16x8& pa3) {
#pragma unroll
  for (int r = 0; r < 16; ++r) p1[r] = __builtin_amdgcn_exp2f(p1[r]);
  float ps = 0;
#pragma unroll
  for (int r = 0; r < 16; ++r) ps += p0[r];
#pragma unroll
  for (int r = 0; r < 16; ++r) ps += p1[r];
  { auto rr = __builtin_amdgcn_permlane32_swap(__float_as_uint(ps), __float_as_uint(ps), false, false);
    ps = __uint_as_float(rr[0]) + __uint_as_float(rr[1]); }
  l_reg = l_reg * alpha + ps;
#define PK4(P, BASE, OUT) do { unsigned a0 = cvtpk(P[BASE + 0], P[BASE + 1]), a1 = cvtpk(P[BASE + 2], P[BASE + 3]);   \
    unsigned b0 = cvtpk(P[BASE + 4], P[BASE + 5]), b1 = cvtpk(P[BASE + 6], P[BASE + 7]);                              \
    auto r0 = __builtin_amdgcn_permlane32_swap(a0, b0, false, false); auto r1 = __builtin_amdgcn_permlane32_swap(a1, b1, false, false); \
    u32x4 w = {r0[0], r1[0], r0[1], r1[1]}; OUT = *reinterpret_cast<bf16x8*>(&w); } while (0)
  PK4(p0, 0, pa0); PK4(p0, 8, pa1); PK4(p1, 0, pa2); PK4(p1, 8, pa3);
#undef PK4
}
__device__ __forceinline__ void qkt(f32x16& p0, f32x16& p1, const char* Ks, const bf16x8* qr, int r32, int hi, int cofs, float dq, float nsl) {
#pragma unroll
  for (int r = 0; r < 16; ++r) { const float cr = (float)((r & 3) + 8 * (r >> 2)); p0[r] = nsl * __builtin_fabsf(dq - cr); p1[r] = nsl * __builtin_fabsf(dq - (32.f + cr)); }
#pragma unroll
  for (int d0 = 0; d0 < 4; ++d0) { const int cb = cofs + d0 * 32 + hi * 16;
    bf16x8 b0 = *reinterpret_cast<const bf16x8*>(Ks + KSWZ(r32, cb));
    bf16x8 b1 = *reinterpret_cast<const bf16x8*>(Ks + KSWZ(32 + r32, cb));
    p0 = __builtin_amdgcn_mfma_f32_32x32x16_bf16(b0, qr[d0], p0, 0, 0, 0);
    p1 = __builtin_amdgcn_mfma_f32_32x32x16_bf16(b1, qr[d0], p1, 0, 0, 0); }
}
__device__ __forceinline__ int v_st(int k, int c) { const int kk = (k & ~0xC) | ((k & 4) << 1) | ((k & 8) >> 1); return ((kk >> 3) * 4 + (c >> 5)) * 512 + ((kk & 7) * 32 + (c & 31)) * 2; }
__device__ __forceinline__ int v_rd_base(int lane) { return ((lane & 3) << 3) | (((lane >> 2) & 3) << 6) | (((lane >> 4) & 1) << 5) | (((lane >> 5) & 1) << 8); }
constexpr int v_rd_off(int d0, int ks, int half) { return d0 * 512 + ks * 4096 + half * 2048; }
template <int OFF> __device__ __forceinline__ s16x4 tr_read(int vb) {
  s16x4 r; asm volatile("ds_read_b64_tr_b16 %0, %1 offset:%2" : "=&v"(r) : "v"(vb), "i"(OFF) : "memory"); return r;
}
template <int D0> __device__ __forceinline__ void pv_one(f32x16& od, int vb, bf16x8 pa0, bf16x8 pa1, bf16x8 pa2, bf16x8 pa3) {
  const s16x4 l0 = tr_read<v_rd_off(D0, 0, 0)>(vb), h0 = tr_read<v_rd_off(D0, 0, 1)>(vb), l1 = tr_read<v_rd_off(D0, 1, 0)>(vb), h1 = tr_read<v_rd_off(D0, 1, 1)>(vb);
  const s16x4 l2 = tr_read<v_rd_off(D0, 2, 0)>(vb), h2 = tr_read<v_rd_off(D0, 2, 1)>(vb), l3 = tr_read<v_rd_off(D0, 3, 0)>(vb), h3 = tr_read<v_rd_off(D0, 3, 1)>(vb);
  asm volatile("s_waitcnt lgkmcnt(0)" ::: "memory"); SBAR();
#define PK(L, H) (bf16x8){L[0], L[1], L[2], L[3], H[0], H[1], H[2], H[3]}
  od = __builtin_amdgcn_mfma_f32_32x32x16_bf16(pa0, PK(l0, h0), od, 0, 0, 0);
  od = __builtin_amdgcn_mfma_f32_32x32x16_bf16(pa1, PK(l1, h1), od, 0, 0, 0);
  od = __builtin_amdgcn_mfma_f32_32x32x16_bf16(pa2, PK(l2, h2), od, 0, 0, 0);
  od = __builtin_amdgcn_mfma_f32_32x32x16_bf16(pa3, PK(l3, h3), od, 0, 0, 0);
#undef PK
}
__device__ __forceinline__ void pv_d0(f32x16* o, int vb, bf16x8 pa0, bf16x8 pa1, bf16x8 pa2, bf16x8 pa3) {
  pv_one<0>(o[0], vb, pa0, pa1, pa2, pa3); pv_one<1>(o[1], vb, pa0, pa1, pa2, pa3); pv_one<2>(o[2], vb, pa0, pa1, pa2, pa3); pv_one<3>(o[3], vb, pa0, pa1, pa2, pa3);
}

__device__ __forceinline__ void attn_unit(const bf16_t* __restrict__ QKV, bf16_t* __restrict__ CAT, int b, int h, int qb, float lam, const float* __restrict__ head_g, char* lds) {
  const int tid = threadIdx.x, wid = tid >> 6, lane = tid & 63, r32 = lane & 31, hi = lane >> 5, cmap = wid >> 2, wq = wid & 3;
  char* V_lds = lds; char* K_lds = lds + 2 * SHM_V;
  float* ws = (float*)(lds + WS_OFF) + wid * 64; float* li_l = ws; float* al_l = ws + 32;
  float m_reg = -1e30f, l_reg = 0; f32x16 o[4] = {}; bf16x8 qr[4];
  const bf16_t* Qw = QKV + (size_t)(b * 2048 + qb * 128 + wq * 32 + r32) * LDK + h * 128 + cmap * 64 + hi * 8;
#pragma unroll
  for (int d0 = 0; d0 < 4; ++d0) qr[d0] = *reinterpret_cast<const bf16x8*>(Qw + d0 * 16);
  const bf16_t* Kh = QKV + (size_t)(b * 2048) * LDK + 1024 + h * 128;
  const bf16_t* Vh = QKV + (size_t)(b * 2048) * LDK + 2048 + h * 128;
  const float dqb = (float)(qb * 128 + wq * 32 + r32 - 4 * hi);
  const float nsl = -1.4426950408889634f * __builtin_amdgcn_exp2f(-(float)(h + 1));
  const int cofs = cmap * 128;
  const int sr = tid >> 4, sc = (tid & 15) * 8, vst0 = v_st(sr, sc), vst1 = v_st(32 + sr, sc);
  const int vb0 = (int)(uintptr_t)V_lds + v_rd_base(lane);
  struct { bf16x8 vs0, vs1, ks0, ks1; } sr_[SDEPTH];
#define SLOAD(i, k0) do { sr_[i].vs0 = *reinterpret_cast<const bf16x8*>(&Vh[(size_t)((k0) + sr) * LDK + sc]); sr_[i].vs1 = *reinterpret_cast<const bf16x8*>(&Vh[(size_t)((k0) + 32 + sr) * LDK + sc]); \
    sr_[i].ks0 = *reinterpret_cast<const bf16x8*>(&Kh[(size_t)((k0) + sr) * LDK + sc]); sr_[i].ks1 = *reinterpret_cast<const bf16x8*>(&Kh[(size_t)((k0) + 32 + sr) * LDK + sc]); } while (0)
#define SWRITE(bb, i) do { *(bf16x8*)(V_lds + (bb) * SHM_V + vst0) = sr_[i].vs0;          \
    *(bf16x8*)(V_lds + (bb) * SHM_V + vst1) = sr_[i].vs1; int kc = sc * 2;               \
    *(bf16x8*)(K_lds + (bb) * SHM_K + KSWZ(sr, kc)) = sr_[i].ks0;                       \
    *(bf16x8*)(K_lds + (bb) * SHM_K + KSWZ(32 + sr, kc)) = sr_[i].ks1; } while (0)
#define SWAIT() do { if constexpr (SDEPTH == 2) asm volatile("s_waitcnt vmcnt(4)" ::: "memory"); else asm volatile("s_waitcnt vmcnt(0)" ::: "memory"); } while (0)
#define RESC(a) do { if (__any((a) < 1.f)) { if (hi == 0) al_l[r32] = (a); asm volatile("s_waitcnt lgkmcnt(0)" ::: "memory"); \
    _Pragma("unroll") for (int d = 0; d < 4; ++d) _Pragma("unroll") for (int r = 0; r < 16; ++r) o[d][r] *= al_l[crow(r, hi)]; } } while (0)
  f32x16 pA0, pA1, pB0, pB1; float mnA, mnB, alA, alB; bf16x8 pa0, pa1, pa2, pa3;
  constexpr int SE = 0, SO = SDEPTH - 1;
  SLOAD(SE, 0); asm volatile("s_waitcnt vmcnt(0)" ::: "memory"); SWRITE(0, SE); __syncthreads();
  qkt(pA0, pA1, K_lds, qr, r32, hi, cofs, dqb, nsl); partialSM(pA0, pA1, m_reg, mnA, alA);
  SLOAD(SO, KVBLK); if constexpr (SDEPTH == 2) SLOAD(SE, 2 * KVBLK);
  SWAIT(); SWRITE(1, SO); __syncthreads();
  for (int j = 1; j + 1 < NT; j += 2) {
    SBAR(); qkt(pB0, pB1, K_lds + SHM_K, qr, r32, hi, cofs, dqb - (float)(j * KVBLK), nsl);
    finishSM(pA0, pA1, alA, l_reg, pa0, pa1, pa2, pa3); SBAR();
    SLOAD(SO, (j + SDEPTH) * KVBLK); SBAR();
    pv_d0(o, vb0, pa0, pa1, pa2, pa3); partialSM(pB0, pB1, m_reg, mnB, alB);
    __syncthreads(); SWAIT(); SWRITE(0, SE);
    RESC(alB); __syncthreads();
    SBAR(); qkt(pA0, pA1, K_lds, qr, r32, hi, cofs, dqb - (float)((j + 1) * KVBLK), nsl);
    finishSM(pB0, pB1, alB, l_reg, pa0, pa1, pa2, pa3); SBAR();
    if (SDEPTH == 1 || j + 3 < NT) SLOAD(SE, (j + 1 + SDEPTH) * KVBLK); SBAR();
    pv_d0(o, vb0 + SHM_V, pa0, pa1, pa2, pa3); partialSM(pA0, pA1, m_reg, mnA, alA);
    __syncthreads(); SWAIT(); SWRITE(1, SO);
    RESC(alA); __syncthreads();
  }
  SBAR(); qkt(pB0, pB1, K_lds + SHM_K, qr, r32, hi, cofs, dqb - (float)((NT - 1) * KVBLK), nsl);
  finishSM(pA0, pA1, alA, l_reg, pa0, pa1, pa2, pa3); SBAR();
  pv_d0(o, vb0, pa0, pa1, pa2, pa3); partialSM(pB0, pB1, m_reg, mnB, alB);
  __syncthreads(); RESC(alB);
  finishSM(pB0, pB1, alB, l_reg, pa0, pa1, pa2, pa3); SBAR();
  pv_d0(o, vb0 + SHM_V, pa0, pa1, pa2, pa3);
  if (hi == 0) li_l[r32] = l_reg; asm volatile("s_waitcnt lgkmcnt(0)" ::: "memory");
  float rli[16];
#pragma unroll
  for (int r = 0; r < 16; ++r) rli[r] = __builtin_amdgcn_rcpf(li_l[crow(r, hi)]);
  __syncthreads();
  float* OB = (float*)lds + cmap * 16384 + (wq * 32) * 128;
#pragma unroll
  for (int r = 0; r < 16; ++r) { const int orow = crow(r, hi);
#pragma unroll
    for (int d0 = 0; d0 < 4; ++d0) OB[orow * 128 + d0 * 32 + r32] = o[d0][r] * rli[r]; }
  __syncthreads();
  { const int row = tid >> 2, qtr = tid & 3;
    const f32x4* o1 = (const f32x4*)((const float*)lds + row * 128 + qtr * 32); const f32x4* o2 = o1 + 4096;
    f32x4 v[8]; float ssq = 0.f;
#pragma unroll
    for (int k = 0; k < 8; ++k) { v[k] = o1[k] - lam * o2[k]; ssq += (v[k][0] * v[k][0] + v[k][1] * v[k][1]) + (v[k][2] * v[k][2] + v[k][3] * v[k][3]); }
    ssq += __shfl_xor(ssq, 1); ssq += __shfl_xor(ssq, 2);
    const float rs = rsqrtf(ssq * (1.0f / 128.0f) + 1e-6f) * 0.8f;
    bf16_t* dst = CAT + (size_t)(b * 2048 + qb * 128 + row) * 2048 + h * 128 + qtr * 32;
    const f32x4* hg = (const f32x4*)(head_g + qtr * 32);
#pragma unroll
    for (int k = 0; k < 8; k += 2) { const f32x4 g0 = hg[k], g1 = hg[k + 1]; const f32x4 a = v[k] * rs * g0, c = v[k + 1] * rs * g1;
      u32x4 w; w.x = cvtpk(a[0], a[1]); w.y = cvtpk(a[2], a[3]); w.z = cvtpk(c[0], c[1]); w.w = cvtpk(c[2], c[3]);
      *(u32x4*)(dst + k * 4) = w; }
  }
  __syncthreads();
#undef SLOAD
#undef SWRITE
#undef SWAIT
#undef RESC
}
#undef SBAR
}
#define LAS __attribute__((address_space(3)))
typedef unsigned short bf16_t;
typedef short bf16x8 __attribute__((ext_vector_type(8)));
typedef float f32x4 __attribute__((ext_vector_type(4)));
typedef float f32x16 __attribute__((ext_vector_type(16)));
typedef unsigned u32x4 __attribute__((ext_vector_type(4)));
typedef unsigned u32x2 __attribute__((ext_vector_type(2)));
constexpr int DM = 2048, BATCH = 4, SEQ = 2048, MT = BATCH * SEQ, DFF = 5632, NGU = 2 * DFF, INC = 4096, SW = 1024;
constexpr int SG = 64, CT = 16, NCH = SEQ / CT, NROW = BATCH * NCH;
constexpr float EPS = 1e-6f;
constexpr int NWAVES = 8, LDS_BYTES = 136 * 1024;
constexpr size_t al256(size_t x) { return (x + 255) / 256 * 256; }
constexpr size_t WS_W1G = 0;
constexpr size_t WS_W1D = WS_W1G + (size_t)NGU * DM * 2;
constexpr size_t WS_WIN = WS_W1D + (size_t)DM * DFF * 2;
constexpr size_t WS_WOUT = WS_WIN + (size_t)INC * DM * 2;
constexpr size_t WS_WGLU = WS_WOUT + (size_t)DM * DM * 2;
constexpr size_t WS_XN = WS_WGLU + (size_t)SW * SW * 2;
constexpr size_t WS_HFF = WS_XN + (size_t)MT * DM * 2;
constexpr size_t WS_QKV = WS_HFF, WS_UG = WS_QKV + (size_t)MT * 3072 * 2, WS_HIN = WS_UG + (size_t)SG * NROW * 256 * 2;
constexpr size_t WS_Y = WS_HFF + (size_t)MT * DFF * 2;
constexpr size_t WS_SLOC = WS_Y, WS_GB = WS_SLOC + (size_t)SG * NROW * 256 * 4, WS_SPRE = WS_GB + (size_t)MT * SW * 2;
constexpr size_t WS_SSQ = WS_Y + (size_t)MT * DM * 4;
constexpr size_t WS_SSQ2 = WS_SSQ + (size_t)MT * 32 * 4;
constexpr size_t WS_EMAT = WS_SSQ2 + (size_t)MT * 16 * 4;
constexpr size_t WS_MFT = WS_EMAT + (size_t)SG * 8 * 16 * 1024;
constexpr size_t WS_ATAB = WS_MFT + (size_t)SG * 8 * 32 * 1024;
constexpr size_t WS_CTL = WS_ATAB + (size_t)SG * 2 * 64 * 2 * 4;
constexpr size_t CTL_BYTES = 16384;
constexpr size_t WS_END = WS_CTL + CTL_BYTES;
constexpr int LDS_BARST = 133120;
static_assert(WS_HIN + (size_t)SG * NROW * 256 * 2 <= WS_Y && WS_SPRE + (size_t)MT * SW * 2 <= WS_SSQ, "overlays");

__device__ __forceinline__ unsigned cvtpk(float lo, float hi) { unsigned r; asm volatile("v_cvt_pk_bf16_f32 %0, %1, %2" : "=v"(r) : "v"(lo), "v"(hi)); return r; }
__device__ __forceinline__ float wave_sum(float v) {
#pragma unroll
    for (int o = 1; o < 64; o <<= 1) v += __shfl_xor(v, o);
    return v;
}
__device__ __forceinline__ float bf2f_lo(unsigned w) { return __uint_as_float(w << 16); }
__device__ __forceinline__ float bf2f_hi(unsigned w) { return __uint_as_float(w & 0xffff0000u); }

struct Params { const float* in[31]; float* out; unsigned char* ws; int ph_lo, ph_hi; };

__device__ __forceinline__ void transpose_item(const float* __restrict__ W, int K, int N, bf16_t* __restrict__ WT, int k0, int n0, int rowbase, LAS float* scr, int lane) {
#pragma unroll 8
    for (int i = 0; i < 32; ++i) { const int kk = 2 * i + (lane >> 5); scr[kk * 33 + (lane & 31)] = W[(size_t)(k0 + kk) * N + n0 + (lane & 31)]; }
    asm volatile("s_waitcnt lgkmcnt(0)" ::: "memory");
    const int c = lane & 7;
#pragma unroll
    for (int j = 0; j < 4; ++j) { const int n = (lane >> 3) + 8 * j; const LAS float* s = scr + (8 * c) * 33 + n;
        u32x4 o; o.x = cvtpk(s[0 * 33], s[1 * 33]); o.y = cvtpk(s[2 * 33], s[3 * 33]); o.z = cvtpk(s[4 * 33], s[5 * 33]); o.w = cvtpk(s[6 * 33], s[7 * 33]);
        *(u32x4*)(WT + (size_t)(rowbase + n) * K + k0 + 8 * c) = o; }
    asm volatile("s_waitcnt lgkmcnt(0)" ::: "memory");
}
__device__ __forceinline__ void convert_ffn(const float* wg, const float* wu, const float* wd, unsigned char* ws, LAS float* scr, int gw, int ngw, int lane) {
    constexpr int IG = (DM / 64) * (DFF / 32), ID = (DFF / 64) * (DM / 32);
    bf16_t* G = (bf16_t*)(ws + WS_W1G); bf16_t* D = (bf16_t*)(ws + WS_W1D);
    for (int it = gw; it < 2 * IG + ID; it += ngw) {
        int r = it;
        if (r < 2 * IG) { const int up = r >= IG; if (up) r -= IG; const int nb = r % (DFF / 32), kb = r / (DFF / 32), n0 = nb * 32;
            transpose_item(up ? wu : wg, DM, DFF, G, kb * 64, n0, (n0 >> 7) * 256 + (n0 & 127) + up * 128, scr, lane); continue; }
        r -= 2 * IG; { const int nb = r % (DM / 32), kb = r / (DM / 32); transpose_item(wd, DFF, DM, D, kb * 64, nb * 32, nb * 32, scr, lane); }
    }
}
__device__ __forceinline__ void convert_plain(const float* w, int K, int N, bf16_t* WT, LAS float* scr, int gw, int ngw, int lane) {
    const int items = (K / 64) * (N / 32);
    for (int r = gw; r < items; r += ngw) { const int nb = r % (N / 32), kb = r / (N / 32); transpose_item(w, K, N, WT, kb * 64, nb * 32, nb * 32, scr, lane); }
}
__device__ __forceinline__ void prenorm_rows(const float* __restrict__ X, const float* __restrict__ g, bf16_t* __restrict__ XN, int gw, int ngw, int lane) {
    for (int row = gw; row < MT; row += ngw) {
        const f32x4* xr = (const f32x4*)(X + (size_t)row * DM) + lane; f32x4 v[8]; float s = 0.f;
#pragma unroll
        for (int j = 0; j < 8; ++j) { v[j] = xr[64 * j]; s += (v[j][0] * v[j][0] + v[j][1] * v[j][1]) + (v[j][2] * v[j][2] + v[j][3] * v[j][3]); }
        const float rs = rsqrtf(wave_sum(s) * (1.0f / DM) + EPS);
        u32x2* o8 = (u32x2*)(XN + (size_t)row * DM) + lane;
#pragma unroll
        for (int j = 0; j < 8; ++j) { const f32x4 gg = ((const f32x4*)g)[lane + 64 * j]; u32x2 w; w.x = cvtpk(v[j][0] * rs * gg[0], v[j][1] * rs * gg[1]); w.y = cvtpk(v[j][2] * rs * gg[2], v[j][3] * rs * gg[3]); o8[64 * j] = w; }
    }
}
__device__ __forceinline__ void resid_rows(const float* SRC, const float* __restrict__ Y, const float* __restrict__ SSQ, int npart, const float* __restrict__ gpost, float coef,
                                           float* OUT, const float* __restrict__ gpre, bf16_t* XN, int gw, int ngw, int lane) {
    for (int row = gw; row < MT; row += ngw) {
        float s = lane < npart ? SSQ[(size_t)row * npart + lane] : 0.f;
        const float rs = rsqrtf(wave_sum(s) * (1.0f / DM) + EPS) * coef;
        const f32x4* yr = (const f32x4*)(Y + (size_t)row * DM) + lane; const f32x4* xr = (const f32x4*)(SRC + (size_t)row * DM) + lane; f32x4* orow = (f32x4*)(OUT + (size_t)row * DM) + lane;
        f32x4 v[8]; float s1 = 0.f;
#pragma unroll
        for (int j = 0; j < 8; ++j) { const f32x4 gg = ((const f32x4*)gpost)[lane + 64 * j]; v[j] = xr[64 * j] + yr[64 * j] * rs * gg; orow[64 * j] = v[j];
            s1 += (v[j][0] * v[j][0] + v[j][1] * v[j][1]) + (v[j][2] * v[j][2] + v[j][3] * v[j][3]); }
        if (XN) {
            const float r1 = rsqrtf(wave_sum(s1) * (1.0f / DM) + EPS);
            u32x2* o8 = (u32x2*)(XN + (size_t)row * DM) + lane;
#pragma unroll
            for (int j = 0; j < 8; ++j) { const f32x4 gg = ((const f32x4*)gpre)[lane + 64 * j]; u32x2 w; w.x = cvtpk(v[j][0] * r1 * gg[0], v[j][1] * r1 * gg[1]); w.y = cvtpk(v[j][2] * r1 * gg[2], v[j][3] * r1 * gg[3]); o8[64 * j] = w; }
        }
    }
}
__device__ __forceinline__ void snorm_rows(const bf16_t* __restrict__ SPRE, const float* __restrict__ SSQ2, const float* __restrict__ og, bf16_t* __restrict__ CAT, int gw, int ngw, int lane) {
    for (int row = gw; row < MT; row += ngw) {
        float s = lane < 16 ? SSQ2[(size_t)row * 16 + lane] : 0.f;
        const float rs = rsqrtf(wave_sum(s) * (1.0f / SW) + EPS);
#pragma unroll
        for (int j = 0; j < 2; ++j) { const int c8 = lane + 64 * j; const u32x4 w = *((const u32x4*)(SPRE + (size_t)row * SW) + c8);
            const f32x4 g0 = ((const f32x4*)og)[2 * c8], g1 = ((const f32x4*)og)[2 * c8 + 1]; u32x4 o;
            o.x = cvtpk(bf2f_lo(w.x) * rs * g0[0], bf2f_hi(w.x) * rs * g0[1]); o.y = cvtpk(bf2f_lo(w.y) * rs * g0[2], bf2f_hi(w.y) * rs * g0[3]);
            o.z = cvtpk(bf2f_lo(w.z) * rs * g1[0], bf2f_hi(w.z) * rs * g1[1]); o.w = cvtpk(bf2f_lo(w.w) * rs * g1[2], bf2f_hi(w.w) * rs * g1[3]);
            *((u32x4*)(CAT + (size_t)row * DM + SW) + c8) = o; }
    }
}

__device__ __forceinline__ void s5_tables(const Params& p, int g, float* L) {
    const int t = threadIdx.x;
    float* APOW = L; float* FF = APOW + 2 * 64 * 17 * 2; float* BB = FF + 2 * 64 * 2; float* CC = BB + 2 * 64 * 16 * 2; float* KL = CC + 2 * 16 * 64 * 2;
    unsigned char* ws = p.ws;
    __syncthreads();
    if (t < 128) {
        const int dir = t >> 6, n = t & 63, idx = (dir * SG + g) * 64 + n;
        const float lr = p.in[13][idx], li = p.in[14][idx], dt = expf(p.in[15][dir * SG + g]);
        const float mag = expf(lr * dt), ar = mag * cosf(li * dt), ai = mag * sinf(li * dt);
        const float den = lr * lr + li * li, nr = ar - 1.0f;
        FF[(dir * 64 + n) * 2] = (nr * lr + ai * li) / den; FF[(dir * 64 + n) * 2 + 1] = (ai * lr - nr * li) / den;
        float pr = 1.f, pi = 0.f;
        for (int k = 0; k <= 16; ++k) { APOW[((dir * 64 + n) * 17 + k) * 2] = pr; APOW[((dir * 64 + n) * 17 + k) * 2 + 1] = pi; const float qr = pr * ar - pi * ai, qi = pr * ai + pi * ar; pr = qr; pi = qi; }
        float* AT = (float*)(ws + WS_ATAB) + ((g * 2 + dir) * 64 + n) * 2;
        AT[0] = APOW[((dir * 64 + n) * 17 + 16) * 2]; AT[1] = APOW[((dir * 64 + n) * 17 + 16) * 2 + 1];
    }
    __syncthreads();
    for (int e = t; e < 2048; e += 512) {
        { const int dir = e >> 10, n = (e >> 4) & 63, q = e & 15; const size_t bi = ((size_t)(dir * SG + g) * 64 + n) * 16 + q;
          const float br = p.in[16][bi], bim = p.in[17][bi], fr = FF[(dir * 64 + n) * 2], fi = FF[(dir * 64 + n) * 2 + 1];
          BB[((dir * 64 + n) * 16 + q) * 2] = fr * br - fi * bim; BB[((dir * 64 + n) * 16 + q) * 2 + 1] = fr * bim + fi * br; }
        { const int dir = e >> 10, pp = (e >> 6) & 15, n = e & 63; const size_t ci = ((size_t)(dir * SG + g) * 16 + pp) * 64 + n;
          CC[((dir * 16 + pp) * 64 + n) * 2] = p.in[18][ci]; CC[((dir * 16 + pp) * 64 + n) * 2 + 1] = p.in[19][ci]; }
    }
    __syncthreads();
    for (int e = t; e < 8192; e += 512) {
        const int q = e & 15, pp = (e >> 4) & 15, l = (e >> 8) & 15, dir = e >> 12; float s = 0.f;
        for (int n = 0; n < 64; ++n) {
            const float cr = CC[((dir * 16 + pp) * 64 + n) * 2], ci = CC[((dir * 16 + pp) * 64 + n) * 2 + 1];
            const float ar = APOW[((dir * 64 + n) * 17 + l) * 2], ai = APOW[((dir * 64 + n) * 17 + l) * 2 + 1];
            const float wr = cr * ar - ci * ai, wi = cr * ai + ci * ar;
            s += wr * BB[((dir * 64 + n) * 16 + q) * 2] - wi * BB[((dir * 64 + n) * 16 + q) * 2 + 1];
        }
        KL[e] = s;
    }
    __syncthreads();
    for (int ch = t; ch < 8192; ch += 512) {
        const int lane = ch & 63, ks = (ch >> 6) & 15, nt = ch >> 10, np = nt * 32 + (lane & 31), dir = np >> 7, ri = (np >> 6) & 1, n = np & 63, q0 = (lane >> 5) * 8;
        const int pw = dir == 0 ? 15 - ks : ks;
        const float ar = APOW[((dir * 64 + n) * 17 + pw) * 2], ai = APOW[((dir * 64 + n) * 17 + pw) * 2 + 1];
        float z[8];
#pragma unroll
        for (int j = 0; j < 8; ++j) { const float br = BB[((dir * 64 + n) * 16 + q0 + j) * 2], bi = BB[((dir * 64 + n) * 16 + q0 + j) * 2 + 1]; z[j] = ri ? (ar * bi + ai * br) : (ar * br - ai * bi); }
        u32x4 o; o.x = cvtpk(z[0], z[1]); o.y = cvtpk(z[2], z[3]); o.z = cvtpk(z[4], z[5]); o.w = cvtpk(z[6], z[7]);
        *(u32x4*)(ws + WS_EMAT + ((size_t)((g * 8 + nt) * 16 + ks)) * 1024 + lane * 16) = o;
    }
    for (int ch = t; ch < 16384; ch += 512) {
        const int lane = ch & 63, ks = (ch >> 6) & 31, nt = ch >> 11, no = nt * 32 + (lane & 31), tau = no >> 4, pp = no & 15;
        float z[8];
        if (ks < 16) { const int sg = ks, q0 = (lane >> 5) * 8;
#pragma unroll
            for (int j = 0; j < 8; ++j) { const int q = q0 + j; float v = 0.f;
                if (sg <= tau) v += KL[((0 * 16 + (tau - sg)) * 16 + pp) * 16 + q];
                if (sg >= tau) v += KL[((1 * 16 + (sg - tau)) * 16 + pp) * 16 + q];
                if (sg == tau && pp == q) v += p.in[20][g * 16 + pp];
                z[j] = v; }
        } else { const int np0 = (ks - 16) * 16 + (lane >> 5) * 8, dir = np0 >> 7, ri = (np0 >> 6) & 1, n0 = np0 & 63, pw = dir == 0 ? tau + 1 : 16 - tau;
#pragma unroll
            for (int j = 0; j < 8; ++j) { const int n = n0 + j; const float cr = CC[((dir * 16 + pp) * 64 + n) * 2], ci = CC[((dir * 16 + pp) * 64 + n) * 2 + 1];
                const float ar = APOW[((dir * 64 + n) * 17 + pw) * 2], ai = APOW[((dir * 64 + n) * 17 + pw) * 2 + 1];
                z[j] = ri ? -(cr * ai + ci * ar) : (cr * ar - ci * ai); }
        }
        u32x4 o; o.x = cvtpk(z[0], z[1]); o.y = cvtpk(z[2], z[3]); o.z = cvtpk(z[4], z[5]); o.w = cvtpk(z[6], z[7]);
        *(u32x4*)(ws + WS_MFT + ((size_t)((g * 8 + nt) * 32 + ks)) * 1024 + lane * 16) = o;
    }
    __syncthreads();
}
__device__ __forceinline__ int crow16(int r, int hi) { return (r & 3) + 8 * (r >> 2) + 4 * hi; }
__device__ __forceinline__ void s5_estate(unsigned char* ws, int gw, int ngw, int lane) {
    for (int task = gw; task < SG * 16 * 2; task += ngw) {
        const int nh = task & 1, rt = (task >> 1) & 15, g = task >> 5, r32 = lane & 31, hi = lane >> 5;
        const bf16_t* A = (const bf16_t*)(ws + WS_UG) + ((size_t)(g * NROW + rt * 32 + r32)) * 256 + hi * 8;
        const unsigned char* B = ws + WS_EMAT + (size_t)(g * 8 + nh * 4) * 16 * 1024 + lane * 16;
        f32x16 acc[4] = {};
#pragma unroll 4
        for (int ks = 0; ks < 16; ++ks) { const bf16x8 a = *(const bf16x8*)(A + ks * 16);
#pragma unroll
            for (int nt = 0; nt < 4; ++nt) { const bf16x8 b = *(const bf16x8*)(B + (size_t)(nt * 16 + ks) * 1024); acc[nt] = __builtin_amdgcn_mfma_f32_32x32x16_bf16(a, b, acc[nt], 0, 0, 0); } }
        float* S = (float*)(ws + WS_SLOC) + ((size_t)(g * NROW + rt * 32)) * 256 + nh * 128 + r32;
#pragma unroll
        for (int nt = 0; nt < 4; ++nt)
#pragma unroll
            for (int r = 0; r < 16; ++r) S[(size_t)crow16(r, hi) * 256 + nt * 32] = acc[nt][r];
    }
}
__device__ __forceinline__ void s5_scan(unsigned char* ws, int gw, int ngw, int lane) {
    for (int task = gw; task < BATCH * SG * 2; task += ngw) {
        const int dir = task & 1, g = (task >> 1) & 63, b = task >> 7;
        const float* AT = (const float*)(ws + WS_ATAB) + ((g * 2 + dir) * 64 + lane) * 2; const float ar = AT[0], ai = AT[1];
        const float* S = (const float*)(ws + WS_SLOC) + ((size_t)(g * NROW + b * NCH)) * 256 + dir * 128 + lane;
        bf16_t* H = (bf16_t*)(ws + WS_HIN) + ((size_t)(g * NROW + b * NCH)) * 256 + dir * 128 + lane;
        float hr = 0.f, hi = 0.f;
        for (int c0 = 0; c0 < NCH; c0 += 16) {
            float sr[16], si[16];
#pragma unroll
            for (int k = 0; k < 16; ++k) { const int c = dir == 0 ? c0 + k : NCH - 1 - (c0 + k); sr[k] = S[(size_t)c * 256]; si[k] = S[(size_t)c * 256 + 64]; }
#pragma unroll
            for (int k = 0; k < 16; ++k) { const int c = dir == 0 ? c0 + k : NCH - 1 - (c0 + k);
                H[(size_t)c * 256] = (bf16_t)(cvtpk(hr, 0.f) & 0xffffu); H[(size_t)c * 256 + 64] = (bf16_t)(cvtpk(hi, 0.f) & 0xffffu);
                const float nr = ar * hr - ai * hi + sr[k], ni = ar * hi + ai * hr + si[k]; hr = nr; hi = ni; }
        }
    }
}
__device__ __forceinline__ void s5_output(unsigned char* ws, int gw, int ngw, int lane) {
    for (int task = gw; task < SG * 16 * 2; task += ngw) {
        const int nh = task & 1, rt = (task >> 1) & 15, g = task >> 5, r32 = lane & 31, hi = lane >> 5;
        const bf16_t* A0 = (const bf16_t*)(ws + WS_UG) + ((size_t)(g * NROW + rt * 32 + r32)) * 256 + hi * 8;
        const bf16_t* A1 = (const bf16_t*)(ws + WS_HIN) + ((size_t)(g * NROW + rt * 32 + r32)) * 256 + hi * 8;
        const unsigned char* B = ws + WS_MFT + (size_t)(g * 8 + nh * 4) * 32 * 1024 + lane * 16;
        f32x16 acc[4] = {};
#pragma unroll 4
        for (int ks = 0; ks < 16; ++ks) { const bf16x8 a = *(const bf16x8*)(A0 + ks * 16);
#pragma unroll
            for (int nt = 0; nt < 4; ++nt) { const bf16x8 b = *(const bf16x8*)(B + (size_t)(nt * 32 + ks) * 1024); acc[nt] = __builtin_amdgcn_mfma_f32_32x32x16_bf16(a, b, acc[nt], 0, 0, 0); } }
#pragma unroll 4
        for (int ks = 0; ks < 16; ++ks) { const bf16x8 a = *(const bf16x8*)(A1 + ks * 16);
#pragma unroll
            for (int nt = 0; nt < 4; ++nt) { const bf16x8 b = *(const bf16x8*)(B + (size_t)(nt * 32 + 16 + ks) * 1024); acc[nt] = __builtin_amdgcn_mfma_f32_32x32x16_bf16(a, b, acc[nt], 0, 0, 0); } }
        bf16_t* GBp = (bf16_t*)(ws + WS_GB);
#pragma unroll
        for (int nt = 0; nt < 4; ++nt) { const int no = nh * 128 + nt * 32 + r32, tau = no >> 4, pp = no & 15;
#pragma unroll
            for (int r = 0; r < 16; ++r) { const int crw = rt * 32 + crow16(r, hi); const float y = acc[nt][r];
                const float z2 = 1.5957691216057308f * (y + 0.044715f * y * y * y);
                const float gl = y * __builtin_amdgcn_rcpf(1.0f + __builtin_amdgcn_exp2f(-1.4426950408889634f * z2));
                GBp[(size_t)(crw * 16 + tau) * SW + g * 16 + pp] = (bf16_t)(cvtpk(gl, 0.f) & 0xffffu); } }
    }
}
#define XB_TMO      128
#define XB_XCNT(j)  (256  + 64 * (j))
#define XB_XSUB(j)  (1280 + 64 * (j))
#define XB_XGEN(j)  (2304 + 64 * (j))
#define XB_TOP      3328
#define XB_TOPGEN   3392
#define XCD_BAR_WORDS 3456
#define XB_SPIN_CAP (1u << 18)

__device__ __forceinline__ unsigned xb_ld(unsigned* p)              { return __hip_atomic_load(p, __ATOMIC_RELAXED, __HIP_MEMORY_SCOPE_AGENT); }
__device__ __forceinline__ unsigned xb_add(unsigned* p, unsigned v) { return __hip_atomic_fetch_add(p, v, __ATOMIC_RELAXED, __HIP_MEMORY_SCOPE_AGENT); }
__device__ __forceinline__ unsigned xb_xcc_id() { return (unsigned)__builtin_amdgcn_s_getreg((3 << 11) | 20) & 0xFu; }
#define XB_SPIN(cond, bar) do { unsigned _sp = 0; while (cond) { __builtin_amdgcn_s_sleep(1); \
    if ((++_sp & 255u) == 0u) { if (xb_ld(&(bar)[XB_TMO])) break; if (_sp > XB_SPIN_CAP) { atomicAdd(&(bar)[XB_TMO], 1u); break; } } } } while (0)

struct XcdBarrier {
    unsigned* bar; unsigned x;
    volatile LAS unsigned* st;
};

__device__ __forceinline__ XcdBarrier xcd_barrier_post(unsigned* bar, volatile LAS unsigned* st) {
    XcdBarrier b; b.bar = bar; b.x = xb_xcc_id(); b.st = st;
    if (threadIdx.x == 0) (void)xb_add(&bar[XB_XCNT(b.x)], 1u);
    return b;
}
__device__ __forceinline__ void xcd_barrier_complete(unsigned* bar, unsigned x, unsigned& nloc, unsigned& nx) {
    const unsigned G = gridDim.x * gridDim.y * gridDim.z;
    unsigned sum, cnt, mine, sp = 0u;
    for (;;) {
        sum = 0u; cnt = 0u; mine = 0u;
#pragma unroll
        for (unsigned j = 0; j < 16; ++j) { const unsigned c = xb_ld(&bar[XB_XCNT(j)]); sum += c; cnt += (c > 0u) ? 1u : 0u; mine = (j == x) ? c : mine; }
        if (sum == G) break;
        __builtin_amdgcn_s_sleep(1);
        if ((++sp & 255u) == 0u) { if (xb_ld(&bar[XB_TMO])) break; if (sp > XB_SPIN_CAP) { atomicAdd(&bar[XB_TMO], 1u); break; } }
    }
    nloc = mine > 0u ? mine : 1u; nx = cnt > 0u ? cnt : 1u;
}

__device__ __forceinline__ void xcd_barrier(const XcdBarrier& b) {
    asm volatile("s_waitcnt vmcnt(0)" ::: "memory");
    __syncthreads();
    if (threadIdx.x == 0) {
        unsigned* bar = b.bar;
        __builtin_amdgcn_s_waitcnt(0);
        unsigned nloc = b.st[0], nx = b.st[1];
        if (nloc == 0u) { xcd_barrier_complete(bar, b.x, nloc, nx); b.st[0] = nloc; b.st[1] = nx; }
        const unsigned old = xb_add(&bar[XB_XSUB(b.x)], 1u);
        const unsigned gen = old / nloc;
        if (old + 1u == (gen + 1u) * nloc) {
            __builtin_amdgcn_fence(__ATOMIC_RELEASE, "agent");
            asm volatile("s_waitcnt vmcnt(0)" ::: "memory");
            const unsigned og = xb_add(&bar[XB_TOP], 1u);
            const unsigned tg = og / nx;
            if (og + 1u == (tg + 1u) * nx) xb_add(&bar[XB_TOPGEN], 1u);
            else XB_SPIN(xb_ld(&bar[XB_TOPGEN]) == tg, bar);
            __builtin_amdgcn_fence(__ATOMIC_ACQUIRE, "agent");
            xb_add(&bar[XB_XGEN(b.x)], 1u);
            asm volatile("s_waitcnt vmcnt(0)" ::: "memory");
        } else {
            XB_SPIN(xb_ld(&bar[XB_XGEN(b.x)]) == gen, bar);
            __builtin_amdgcn_fence(__ATOMIC_ACQUIRE, "agent");
            asm volatile("s_waitcnt vmcnt(0)" ::: "memory");
        }
    }
    __syncthreads();
}

__global__ void __launch_bounds__(NWAVES * 64, 2) fwd_megakernel(Params p) {
    extern __shared__ __attribute__((aligned(16))) unsigned char lds[];
    cg::grid_group grid = cg::this_grid();
    const int tid = threadIdx.x, lane = tid & 63, wave = __builtin_amdgcn_readfirstlane(tid >> 6);
    const int G = gridDim.x, bx = blockIdx.x, vcu = (G % 8 == 0) ? (bx % 8) * (G / 8) + bx / 8 : bx;
    const int gw = vcu * NWAVES + wave, ngw = G * NWAVES;
    unsigned char* ws = p.ws;
    LAS unsigned char* ldsl = (LAS unsigned char*)lds;
    LAS float* scr = (LAS float*)(ldsl + wave * 8448);
    const int lo = p.ph_lo, hi = p.ph_hi;
    if (tid < 2) ((volatile LAS unsigned*)(ldsl + LDS_BARST))[tid] = 0u;
    __syncthreads();
    XcdBarrier bar = xcd_barrier_post((unsigned*)(ws + WS_CTL), (volatile LAS unsigned*)(ldsl + LDS_BARST));
    if (hi > 1000) grid.sync();
#ifndef PH_MASK
#define PH_MASK 0x7fff
#endif
#define IN(k) (((PH_MASK >> (k)) & 1) && lo <= (k) && (k) < hi)
#ifndef SYNC_REP
#define SYNC_REP 1
#endif
#define SEAM(k) do { if (IN(k) && IN((k) + 1)) { for (int _r = 0; _r < SYNC_REP; ++_r) xcd_barrier(bar); } } while (0)
    bf16_t* XN = (bf16_t*)(ws + WS_XN); bf16_t* HFF = (bf16_t*)(ws + WS_HFF); float* Y = (float*)(ws + WS_Y); float* SSQ = (float*)(ws + WS_SSQ); float* SSQ2 = (float*)(ws + WS_SSQ2);
    bf16_t* QKV = (bf16_t*)(ws + WS_QKV); bf16_t* UG = (bf16_t*)(ws + WS_UG); bf16_t* GB = (bf16_t*)(ws + WS_GB); bf16_t* SPRE = (bf16_t*)(ws + WS_SPRE);

    if (IN(0)) {
        convert_ffn(p.in[2], p.in[3], p.in[4], ws, scr, gw, ngw, lane);
        convert_plain(p.in[7], DM, INC, (bf16_t*)(ws + WS_WIN), scr, gw, ngw, lane);
        convert_plain(p.in[24], DM, DM, (bf16_t*)(ws + WS_WOUT), scr, gw, ngw, lane);
        convert_plain(p.in[21], SW, SW, (bf16_t*)(ws + WS_WGLU), scr, gw, ngw, lane);
        prenorm_rows(p.in[0], p.in[1], XN, gw, ngw, lane);
        for (int g = G - 1 - bx; g < SG; g += G) s5_tables(p, g, (float*)lds);
    }
    SEAM(0);
#define FFN_GATEUP() do { pg8::Gemm g{XN, (const bf16_t*)(ws + WS_W1G), MT, NGU, DM}; pg8::StaticOrder S; S.init(MT, NGU, G, bx); \
            pg8::EpiSwiGLU E{HFF, DFF}; pg8::gemm_phase<pg8::EpiSwiGLU, pg8::StaticOrder, true, true>(ldsl, g, S, E); } while (0)
#define FFN_DOWN() do { pg8::Gemm g{HFF, (const bf16_t*)(ws + WS_W1D), MT, DM, DFF}; pg8::StaticOrder S; S.init(MT, DM, G, bx); \
            pg8::EpiYSsq E{Y, SSQ, 32}; pg8::gemm_phase<pg8::EpiYSsq, pg8::StaticOrder, true, true>(ldsl, g, S, E); } while (0)
    if (IN(1)) FFN_GATEUP();
    SEAM(1);
    if (IN(2)) FFN_DOWN();
    SEAM(2);
    if (IN(3)) { resid_rows(p.in[0], Y, SSQ, 32, p.in[5], 0.5f, p.out, p.in[6], XN, gw, ngw, lane);
                 convert_ffn(p.in[27], p.in[28], p.in[29], ws, scr, gw, ngw, lane); }
    SEAM(3);
    if (IN(4)) {
        pg8::Gemm g{XN, (const bf16_t*)(ws + WS_WIN), MT, INC, DM}; pg8::StaticOrder S; S.init(MT, INC, G, bx);
        pg8::EpiQKVU E{QKV, UG, 0.125f * 1.4426950408889634f};
        pg8::gemm_phase<pg8::EpiQKVU, pg8::StaticOrder, true, true>(ldsl, g, S, E);
    }
    SEAM(4);
    if (IN(5)) {
        float lam;
        { const float a = wave_sum(p.in[8][lane] * p.in[9][lane]), c = wave_sum(p.in[10][lane] * p.in[11][lane]); lam = expf(a) - expf(c) + 0.2f; }
        for (int u = vcu; u < BATCH * 8 * 16; u += G) att::attn_unit(QKV, XN, u >> 7, (u >> 4) & 7, u & 15, lam, p.in[12], (char*)lds);
        s5_estate(ws, gw, ngw, lane);
    }
    SEAM(5);
    if (IN(6)) s5_scan(ws, gw, ngw, lane);
    SEAM(6);
    if (IN(7)) s5_output(ws, gw, ngw, lane);
    SEAM(7);
    if (IN(8)) {
        pg8::Gemm g{GB, (const bf16_t*)(ws + WS_WGLU), MT, SW, SW}; pg8::StaticOrder S; S.init(MT, SW, G, bx);
        pg8::EpiGLU E{GB, SPRE, p.in[22], SSQ2};
        pg8::gemm_phase<pg8::EpiGLU, pg8::StaticOrder, true, true>(ldsl, g, S, E);
    }
    SEAM(8);
    if (IN(9)) snorm_rows(SPRE, SSQ2, p.in[23], XN, gw, ngw, lane);
    SEAM(9);
    if (IN(10)) {
        pg8::Gemm g{XN, (const bf16_t*)(ws + WS_WOUT), MT, DM, DM}; pg8::StaticOrder S; S.init(MT, DM, G, bx);
        pg8::EpiYSsq E{Y, SSQ, 32};
        pg8::gemm_phase<pg8::EpiYSsq, pg8::StaticOrder, true, true>(ldsl, g, S, E);
    }
    SEAM(10);
    if (IN(11)) resid_rows(p.out, Y, SSQ, 32, p.in[25], 1.0f, p.out, p.in[26], XN, gw, ngw, lane);
    SEAM(11);
    if (IN(12)) FFN_GATEUP();
    SEAM(12);
    if (IN(13)) FFN_DOWN();
    SEAM(13);
    if (IN(14)) resid_rows(p.out, Y, SSQ, 32, p.in[30], 0.5f, p.out, nullptr, nullptr, gw, ngw, lane);
#undef IN
#undef SEAM
}

extern "C" void kernel_launch(void* const* d_in, const int* in_sizes, int n_in, void* d_out, int out_size, void* d_ws, size_t ws_size, hipStream_t stream) {
    static int grid = 0;
    if (grid == 0) {
        if (n_in != 31 || in_sizes[0] != MT * DM || out_size != MT * DM || ws_size < WS_END) {
            fprintf(stderr, "kernel_launch: shape/workspace mismatch: n_in %d in0 %d out %d ws %zu (need %zu)\n", n_in, n_in > 0 ? in_sizes[0] : -1, out_size, ws_size, (size_t)WS_END); grid = -1; return; }
        int dev = 0, cus = 0, per_cu = 0;
        hipGetDevice(&dev); hipDeviceGetAttribute(&cus, hipDeviceAttributeMultiprocessorCount, dev);
        if (hipFuncSetAttribute((const void*)fwd_megakernel, hipFuncAttributeMaxDynamicSharedMemorySize, LDS_BYTES) != hipSuccess) { fprintf(stderr, "kernel_launch: hipFuncSetAttribute failed\n"); grid = -1; return; }
        if (hipOccupancyMaxActiveBlocksPerMultiprocessor(&per_cu, (const void*)fwd_megakernel, NWAVES * 64, LDS_BYTES) != hipSuccess || per_cu < 1) { fprintf(stderr, "kernel_launch: occupancy query says %d\n", per_cu); (void)hipGetLastError(); per_cu = 1; }
        grid = cus;
        fprintf(stderr, "kernel_launch: grid %d (cus %d x per_cu %d), ws %zu need %zu\n", grid, cus, per_cu, ws_size, (size_t)WS_END);
    }
    if (grid < 0) return;
    if (hipMemsetAsync((char*)d_ws + WS_CTL, 0, CTL_BYTES, stream) != hipSuccess) { fprintf(stderr, "kernel_launch: memset failed\n"); return; }
    Params p{};
    for (int i = 0; i < 31; ++i) p.in[i] = (const float*)d_in[i];
    p.out = (float*)d_out; p.ws = (unsigned char*)d_ws;
#if MK_N_LAUNCHES == 1
    p.ph_lo = 0; p.ph_hi = 15;
    void* args[] = {&p};
    hipError_t e = hipLaunchCooperativeKernel((const void*)fwd_megakernel, dim3(grid), dim3(NWAVES * 64), args, LDS_BYTES, stream);
    if (e != hipSuccess) fprintf(stderr, "cooperative launch failed: %s (grid %d)\n", hipGetErrorString(e), grid);
#else
    for (int k = 0; k < 15; ++k) { p.ph_lo = k; p.ph_hi = k + 1; hipLaunchKernelGGL(fwd_megakernel, dim3(grid), dim3(NWAVES * 64), LDS_BYTES, stream, p); }
#endif
}
```

```cpp
#include <hip/hip_runtime.h>
#include <hip/hip_cooperative_groups.h>
#include <cstdio>
#include <cstdint>
namespace cg = cooperative_groups;
#ifndef MK_N_LAUNCHES
#define MK_N_LAUNCHES 1
#endif
namespace pg8 {
#define PG8_LAS __attribute__((address_space(3)))
typedef unsigned short bf16_t;
typedef short bf16x8 __attribute__((ext_vector_type(8)));
typedef float f32x4 __attribute__((ext_vector_type(4)));
typedef unsigned u32x4 __attribute__((ext_vector_type(4)));
constexpr int BM = 256, BK = 64, HALF = 128, HTB = HALF * BK * 2  , STAGE_BYTES = 8 * HTB, NXCD = 8, WGM = 8;

__host__ __device__ __forceinline__ int lds_byte(int r, int c) { const int st = (r >> 4) * 2 + (c >> 5), rr = r & 15, cc = c & 31, ob = rr * 64 + cc * 2; return st * 1024 + (ob ^ (((ob >> 9) & 1) << 5)); }
__host__ __device__ __forceinline__ void stage_rc(int b, int& R, int& C) { const int st = b / 1024, sb = b % 1024, swz = sb ^ (((sb >> 9) & 1) << 5); R = (st >> 1) * 16 + swz / 64; C = (st & 1) * 32 + (swz % 64) / 2; }
__host__ __device__ __forceinline__ int perm32(int rho) { const int n = rho >> 4, i = rho & 15; return 8 * (i >> 2) + 4 * n + (i & 3); }

struct Unit { int pm, pn; };
struct Gemm { const bf16_t* A; const bf16_t* Bt; int M, N, K; };

struct StaticOrder {
    int nM, nN, nwg, G, c;
    __host__ __device__ void init(int M, int N, int G_, int c_) { nM = M / BM; nN = N / BM; nwg = nM * nN; G = G_; c = c_; }
    __host__ __device__ bool next(int i, Unit& u) const {
        const long L = (long)i * G + c; if (L >= nwg) return false;
        int wgid = (int)L; { const int q = nwg / NXCD, r = nwg % NXCD, xcd = wgid % NXCD, off = wgid / NXCD; wgid = (xcd < r ? xcd * (q + 1) : r * (q + 1) + (xcd - r) * q) + off; }
        const int nig = WGM * nN, gid = wgid / nig, fm = gid * WGM, gsz = (nM - fm) < WGM ? (nM - fm) : WGM;
        u.pm = fm + ((wgid % nig) % gsz); u.pn = (wgid % nig) / gsz; return true;
    }
    __device__ __forceinline__ void a_ready(const Unit&) const {}
    __device__ __forceinline__ void done(const Unit&) const {}
};

__device__ __forceinline__ unsigned cvt_pk_bf16(float lo, float hi) { unsigned r; asm volatile("v_cvt_pk_bf16_f32 %0, %1, %2" : "=v"(r) : "v"(lo), "v"(hi)); return r; }
typedef unsigned u32x2 __attribute__((ext_vector_type(2)));
__device__ __forceinline__ float bf_lo(unsigned w) { return __uint_as_float(w << 16); }
__device__ __forceinline__ float bf_hi(unsigned w) { return __uint_as_float(w & 0xffff0000u); }
__device__ __forceinline__ float sigmoid_f(float z) { return __builtin_amdgcn_rcpf(1.0f + __builtin_amdgcn_exp2f(-1.4426950408889634f * z)); }
__device__ __forceinline__ float silu_f(float z) { return z * sigmoid_f(z); }

struct EpiSwiGLU {
    static constexpr bool PERM = true, AFTER_DRAIN = false;
    bf16_t* O; int ldc;
    __device__ __forceinline__ void operator()(const f32x4 (&acc)[2][2][4][2], const Unit& u, int wr, int wc, int fr, int fq) const {
        const int row0 = u.pm * BM + wr * 64 + fr, col0 = u.pn * HALF + wc * 32 + 8 * fq;
#pragma unroll
        for (int ai = 0; ai < 2; ++ai)
#pragma unroll
            for (int m = 0; m < 4; ++m) {
                bf16_t* rowp = O + (size_t)(row0 + ai * HALF + m * 16) * ldc + col0;
                const f32x4 g0 = acc[ai][0][m][0], g1 = acc[ai][0][m][1], u0 = acc[ai][1][m][0], u1 = acc[ai][1][m][1];
                u32x4 w;
                w.x = cvt_pk_bf16(silu_f(g0[0]) * u0[0], silu_f(g0[1]) * u0[1]); w.y = cvt_pk_bf16(silu_f(g0[2]) * u0[2], silu_f(g0[3]) * u0[3]);
                w.z = cvt_pk_bf16(silu_f(g1[0]) * u1[0], silu_f(g1[1]) * u1[1]); w.w = cvt_pk_bf16(silu_f(g1[2]) * u1[2], silu_f(g1[3]) * u1[3]);
                *(u32x4*)rowp = w;
            }
    }
};
struct EpiQKVU {
    static constexpr bool PERM = true, AFTER_DRAIN = false;
    bf16_t* QKV; bf16_t* UG; float qscale;
    __device__ __forceinline__ void operator()(const f32x4 (&acc)[2][2][4][2], const Unit& u, int wr, int wc, int fr, int fq) const {
        const int row0 = u.pm * BM + wr * 64 + fr, colt = u.pn * BM;
        const float sc = colt < 1024 ? qscale : 1.0f;
#pragma unroll
        for (int ai = 0; ai < 2; ++ai)
#pragma unroll
            for (int m = 0; m < 4; ++m) {
                const int row = row0 + ai * HALF + m * 16;
#pragma unroll
                for (int bj = 0; bj < 2; ++bj) {
                    const int col = colt + bj * HALF + wc * 32 + 8 * fq;
                    const f32x4 v0 = acc[ai][bj][m][0] * sc, v1 = acc[ai][bj][m][1] * sc;
                    u32x4 w; w.x = cvt_pk_bf16(v0[0], v0[1]); w.y = cvt_pk_bf16(v0[2], v0[3]); w.z = cvt_pk_bf16(v1[0], v1[1]); w.w = cvt_pk_bf16(v1[2], v1[3]);
                    bf16_t* dst;
                    if (colt < 3072) dst = QKV + (size_t)row * 3072 + col;
                    else { const int cc = col - 3072; dst = UG + ((size_t)((cc >> 4) * 512 + (row >> 4)) * 256 + (row & 15) * 16 + (cc & 15)); }
                    *(u32x4*)dst = w;
                }
            }
    }
};
struct EpiYSsq {
    static constexpr bool PERM = true, AFTER_DRAIN = false;
    bf16_t* Y; float* SSQ; int npart;
    __device__ __forceinline__ void operator()(const f32x4 (&acc)[2][2][4][2], const Unit& u, int wr, int wc, int fr, int fq) const {
        const int row0 = u.pm * BM + wr * 64 + fr, col0 = u.pn * BM + wc * 32 + 8 * fq;
#pragma unroll
        for (int ai = 0; ai < 2; ++ai)
#pragma unroll
            for (int m = 0; m < 4; ++m) {
                const int row = row0 + ai * HALF + m * 16; float s = 0.f;
#pragma unroll
                for (int bj = 0; bj < 2; ++bj) { const f32x4 v0 = acc[ai][bj][m][0], v1 = acc[ai][bj][m][1];
                    s += (v0[0] * v0[0] + v0[1] * v0[1]) + (v0[2] * v0[2] + v0[3] * v0[3]) + (v1[0] * v1[0] + v1[1] * v1[1]) + (v1[2] * v1[2] + v1[3] * v1[3]);
                    u32x4 w; w.x = cvt_pk_bf16(v0[0], v0[1]); w.y = cvt_pk_bf16(v0[2], v0[3]); w.z = cvt_pk_bf16(v1[0], v1[1]); w.w = cvt_pk_bf16(v1[2], v1[3]);
                    *(u32x4*)(Y + (size_t)row * 2048 + col0 + bj * HALF) = w; }
                s += __shfl_xor(s, 16); s += __shfl_xor(s, 32);
                if (fq == 0) SSQ[(size_t)row * npart + u.pn * 4 + wc] = s;
            }
    }
};
struct EpiGLU {
    static constexpr bool PERM = true, AFTER_DRAIN = false;
    const bf16_t* GB; bf16_t* SPRE; const float* bias; float* SSQ2;
    __device__ __forceinline__ void operator()(const f32x4 (&acc)[2][2][4][2], const Unit& u, int wr, int wc, int fr, int fq) const {
        const int row0 = u.pm * BM + wr * 64 + fr, colb = u.pn * BM + wc * 32 + 8 * fq;
#pragma unroll
        for (int ai = 0; ai < 2; ++ai)
#pragma unroll
            for (int m = 0; m < 4; ++m) {
                const int row = row0 + ai * HALF + m * 16; float s = 0.f;
#pragma unroll
                for (int bj = 0; bj < 2; ++bj) {
                    const int col = colb + bj * HALF;
                    const u32x4 gw = *(const u32x4*)(GB + (size_t)row * 1024 + col);
                    const f32x4 b0 = *(const f32x4*)(bias + col), b1 = *(const f32x4*)(bias + col + 4);
                    const f32x4 z0 = acc[ai][bj][m][0] + b0, z1 = acc[ai][bj][m][1] + b1;
                    float o[8];
                    o[0] = bf_lo(gw.x) * sigmoid_f(z0[0]); o[1] = bf_hi(gw.x) * sigmoid_f(z0[1]); o[2] = bf_lo(gw.y) * sigmoid_f(z0[2]); o[3] = bf_hi(gw.y) * sigmoid_f(z0[3]);
                    o[4] = bf_lo(gw.z) * sigmoid_f(z1[0]); o[5] = bf_hi(gw.z) * sigmoid_f(z1[1]); o[6] = bf_lo(gw.w) * sigmoid_f(z1[2]); o[7] = bf_hi(gw.w) * sigmoid_f(z1[3]);
#pragma unroll
                    for (int k = 0; k < 8; ++k) s += o[k] * o[k];
                    u32x4 w; w.x = cvt_pk_bf16(o[0], o[1]); w.y = cvt_pk_bf16(o[2], o[3]); w.z = cvt_pk_bf16(o[4], o[5]); w.w = cvt_pk_bf16(o[6], o[7]);
                    *(u32x4*)(SPRE + (size_t)row * 1024 + col) = w;
                }
                s += __shfl_xor(s, 16); s += __shfl_xor(s, 32);
                if (fq == 0) SSQ2[(size_t)row * 16 + u.pn * 4 + wc] = s;
            }
    }
};
template <class Epi, class Sched, bool ALIGN_EPI = false, bool SP2 = false>
__device__ __forceinline__ void gemm_phase(PG8_LAS unsigned char* lds, const Gemm g, const Sched& S, const Epi& E) {
    const int tid = threadIdx.x, wid = __builtin_amdgcn_readfirstlane(tid >> 6), lane = tid & 63, wr = wid >> 2, wc = wid & 3, fr = lane & 15, fq = lane >> 4;
    const int K = g.K, nt = K / BK;
    unsigned voffA[2], voffB[2];
#pragma unroll
    for (int i = 0; i < 2; ++i) { int R, C; stage_rc(tid * 16 + i * 8192, R, C); const int Rb = Epi::PERM ? ((R & ~31) + perm32(R & 31)) : R;
        voffA[i] = (unsigned)(R * K + C) * 2u; voffB[i] = (unsigned)(Rb * K + C) * 2u; }
    const size_t kstep = (size_t)(BK * 2);
    const size_t hstep = (size_t)HALF * K * 2;
    const size_t tstep = 2 * hstep;
    const unsigned ldsw = (unsigned)wid * 1024u;
    const int aoff = lds_byte(wr * 64 + fr, fq * 8), boff = lds_byte(wc * 32 + fr, fq * 8);
#define PG8_SA(b, h) (((b) * 2 + (h)) * HTB)
#define PG8_SB(b, h) ((4 + (b) * 2 + (h)) * HTB)
#define PG8_STAGE(bufoff, gbase, voff) do { _Pragma("unroll") for (int _i = 0; _i < 2; ++_i) \
        __builtin_amdgcn_global_load_lds((const unsigned*)((const char*)(gbase) + (voff)[_i]), (PG8_LAS unsigned*)(lds + (bufoff) + ldsw + _i * 8192), 16, 0, 0); } while (0)
#define PG8_LDA(dst, b, h) do { _Pragma("unroll") for (int m = 0; m < 4; ++m) _Pragma("unroll") for (int k = 0; k < 2; ++k) dst[m][k] = *(const PG8_LAS bf16x8*)(lds + PG8_SA(b, h) + aoff + m * 2048 + k * 1024); } while (0)
#define PG8_LDB(dst, b, h) do { _Pragma("unroll") for (int n = 0; n < 2; ++n) _Pragma("unroll") for (int k = 0; k < 2; ++k) dst[n][k] = *(const PG8_LAS bf16x8*)(lds + PG8_SB(b, h) + boff + n * 2048 + k * 1024); } while (0)
#define PG8_MMA(ai, bj, At, Bt) do { __builtin_amdgcn_s_setprio(1); _Pragma("unroll") for (int m = 0; m < 4; ++m) _Pragma("unroll") for (int n = 0; n < 2; ++n) _Pragma("unroll") for (int k = 0; k < 2; ++k) \
        acc[ai][bj][m][n] = __builtin_amdgcn_mfma_f32_16x16x32_bf16(Bt[n][k], At[m][k], acc[ai][bj][m][n], 0, 0, 0); __builtin_amdgcn_s_setprio(0); } while (0)
#define PG8_WAIT_V(n) asm volatile("s_waitcnt vmcnt(" #n ")" ::: "memory")
#define PG8_WAIT_L(n) asm volatile("s_waitcnt lgkmcnt(" #n ")" ::: "memory")
#define PG8_BAR __builtin_amdgcn_s_barrier()
#define PG8_SCHED __builtin_amdgcn_sched_barrier(0)
    Unit cur, nxt; int ui = 0;
    if (!S.next(0, cur)) return;
    f32x4 acc[2][2][4][2];
#pragma unroll
    for (int a = 0; a < 2; ++a)
#pragma unroll
        for (int b = 0; b < 2; ++b)
#pragma unroll
            for (int m = 0; m < 4; ++m)
#pragma unroll
                for (int n = 0; n < 2; ++n) acc[a][b][m][n] = (f32x4){0.f, 0.f, 0.f, 0.f};
    bf16x8 At[4][2], B0[2][2], B1[2][2];
    const char* cA = (const char*)g.A + (size_t)cur.pm * tstep; const char* cB = (const char*)g.Bt + (size_t)cur.pn * tstep;
    S.a_ready(cur);
    if constexpr (SP2) {
        PG8_STAGE(PG8_SB(0, 0), cB, voffB); PG8_STAGE(PG8_SB(0, 1), cB + hstep, voffB); PG8_STAGE(PG8_SA(0, 0), cA, voffA); PG8_STAGE(PG8_SA(0, 1), cA + hstep, voffA);
        if (wr == 1) PG8_BAR;
        PG8_WAIT_V(2); PG8_BAR;
        PG8_STAGE(PG8_SB(1, 0), cB + kstep, voffB); PG8_STAGE(PG8_SA(1, 0), cA + kstep, voffA); PG8_STAGE(PG8_SB(1, 1), cB + hstep + kstep, voffB);
        PG8_WAIT_V(6); PG8_BAR;
    } else {
        PG8_STAGE(PG8_SB(0, 0), cB, voffB); PG8_STAGE(PG8_SA(0, 0), cA, voffA); PG8_STAGE(PG8_SB(0, 1), cB + hstep, voffB); PG8_STAGE(PG8_SA(0, 1), cA + hstep, voffA);
        if (wr == 1) PG8_BAR;
        PG8_WAIT_V(4); PG8_BAR;
        PG8_STAGE(PG8_SB(1, 0), cB + kstep, voffB); PG8_STAGE(PG8_SA(1, 0), cA + kstep, voffA); PG8_STAGE(PG8_SB(1, 1), cB + hstep + kstep, voffB);
        PG8_WAIT_V(6); PG8_BAR;
    }
    for (;;) {
        const bool has_next = S.next(ui + 1, nxt);
        const char* nA = has_next ? (const char*)g.A + (size_t)nxt.pm * tstep : cA; const char* nB = has_next ? (const char*)g.Bt + (size_t)nxt.pn * tstep : cB;
        for (int t = 0; t < nt; t += 2) {
            const bool last = (t == nt - 2);
            const char* a1 = cA + (size_t)(t + 1) * kstep;
            const char* a2 = last ? nA : cA + (size_t)(t + 2) * kstep; const char* b2 = last ? nB : cB + (size_t)(t + 2) * kstep;
            const char* a3 = a2 + kstep; const char* b3 = b2 + kstep;
            if (last && has_next) S.a_ready(nxt);
            if constexpr (SP2) {
            PG8_LDB(B0, 0, 0); PG8_LDB(B1, 0, 1); PG8_SCHED; PG8_LDA(At, 0, 0); PG8_STAGE(PG8_SA(1, 1), a1 + hstep, voffA);
            PG8_WAIT_V(8); PG8_WAIT_L(0); PG8_BAR; PG8_MMA(0, 0, At, B0); PG8_MMA(0, 1, At, B1); PG8_BAR; PG8_SCHED;
            PG8_LDA(At, 0, 1); PG8_STAGE(PG8_SB(0, 0), b2, voffB); PG8_STAGE(PG8_SB(0, 1), b2 + hstep, voffB); PG8_STAGE(PG8_SA(0, 0), a2, voffA);
            PG8_WAIT_V(8); PG8_WAIT_L(0); PG8_BAR; PG8_MMA(1, 0, At, B0); PG8_MMA(1, 1, At, B1); PG8_BAR; PG8_SCHED;
            PG8_LDB(B0, 1, 0); PG8_LDB(B1, 1, 1); PG8_SCHED; PG8_LDA(At, 1, 0); PG8_STAGE(PG8_SA(0, 1), a2 + hstep, voffA);
            PG8_WAIT_V(8); PG8_WAIT_L(0); PG8_BAR; PG8_MMA(0, 0, At, B0); PG8_MMA(0, 1, At, B1); PG8_BAR; PG8_SCHED;
            PG8_LDA(At, 1, 1); PG8_STAGE(PG8_SB(1, 0), b3, voffB); PG8_STAGE(PG8_SB(1, 1), b3 + hstep, voffB); PG8_STAGE(PG8_SA(1, 0), a3, voffA);
            PG8_WAIT_V(8); PG8_WAIT_L(0); PG8_BAR; PG8_MMA(1, 0, At, B0); PG8_MMA(1, 1, At, B1); PG8_BAR; PG8_SCHED;
            } else {
            PG8_LDB(B0, 0, 0); PG8_SCHED; PG8_LDA(At, 0, 0); PG8_STAGE(PG8_SA(1, 1), a1 + hstep, voffA);
            PG8_WAIT_L(8); PG8_BAR; PG8_WAIT_L(0); PG8_MMA(0, 0, At, B0); PG8_BAR; PG8_SCHED;
            PG8_LDB(B1, 0, 1); PG8_STAGE(PG8_SB(0, 0), b2, voffB);
            PG8_BAR; PG8_WAIT_L(0); PG8_MMA(0, 1, At, B1); PG8_BAR;
            PG8_LDA(At, 0, 1); PG8_STAGE(PG8_SA(0, 0), a2, voffA);
            PG8_BAR; PG8_WAIT_L(0); PG8_MMA(1, 0, At, B0); PG8_BAR; PG8_SCHED;
            PG8_STAGE(PG8_SB(0, 1), b2 + hstep, voffB);
            PG8_WAIT_V(6); PG8_BAR; PG8_MMA(1, 1, At, B1); PG8_BAR;
            PG8_LDB(B0, 1, 0); PG8_SCHED; PG8_LDA(At, 1, 0); PG8_STAGE(PG8_SA(0, 1), a2 + hstep, voffA);
            PG8_WAIT_L(8); PG8_BAR; PG8_WAIT_L(0); PG8_MMA(0, 0, At, B0); PG8_BAR; PG8_SCHED;
            PG8_LDB(B1, 1, 1); PG8_STAGE(PG8_SB(1, 0), b3, voffB);
            PG8_BAR; PG8_WAIT_L(0); PG8_MMA(0, 1, At, B1); PG8_BAR;
            PG8_LDA(At, 1, 1); PG8_STAGE(PG8_SA(1, 0), a3, voffA);
            PG8_BAR; PG8_WAIT_L(0); PG8_MMA(1, 0, At, B0); PG8_BAR; PG8_SCHED;
            PG8_STAGE(PG8_SB(1, 1), b3 + hstep, voffB);
            PG8_WAIT_V(6); PG8_BAR; PG8_MMA(1, 1, At, B1); PG8_BAR;
            }
        }
        if constexpr (ALIGN_EPI) { if (wr == 0) PG8_BAR; }
        if constexpr (!Epi::AFTER_DRAIN) { E(acc, cur, wr, wc, fr, fq); S.done(cur); }
        if (!has_next) break;
#pragma unroll
        for (int a = 0; a < 2; ++a)
#pragma unroll
            for (int b = 0; b < 2; ++b)
#pragma unroll
                for (int m = 0; m < 4; ++m)
#pragma unroll
                    for (int n = 0; n < 2; ++n) acc[a][b][m][n] = (f32x4){0.f, 0.f, 0.f, 0.f};
        cur = nxt; cA = nA; cB = nB; ++ui;
        if constexpr (ALIGN_EPI) { if (wr == 1) PG8_BAR; }
    }
    PG8_WAIT_V(0);
    if constexpr (!ALIGN_EPI) { if (wr == 0) PG8_BAR; }
    PG8_BAR;
    if constexpr (Epi::AFTER_DRAIN) { E.fused(acc, cur, wr, wc, fr, fq, lds, wid, lane); S.done(cur); }
#undef PG8_SA
#undef PG8_SB
#undef PG8_STAGE
#undef PG8_LDA
#undef PG8_LDB
#undef PG8_MMA
#undef PG8_WAIT_V
#undef PG8_WAIT_L
#undef PG8_BAR
#undef PG8_SCHED
}
}
namespace att {
typedef short bf16x8 __attribute__((ext_vector_type(8)));
typedef short s16x4 __attribute__((ext_vector_type(4)));
typedef float f32x16 __attribute__((ext_vector_type(16)));
typedef float f32x4 __attribute__((ext_vector_type(4)));
typedef unsigned u32x4 __attribute__((ext_vector_type(4)));
typedef unsigned short bf16_t;
constexpr int KVBLK = 64, LDK = 3072, NT = 2048 / KVBLK;
constexpr int SHM_V = KVBLK * 128 * 2, SHM_K = KVBLK * 128 * 2;
constexpr int WS_OFF = 131072;
constexpr float THRL = 11.5f;
#ifndef ATT_SDEPTH
#define ATT_SDEPTH 1
#endif
constexpr int SDEPTH = ATT_SDEPTH;
#define KSWZ(row, colB) ((row) * 256 + ((colB) ^ (((row) & 7) << 4)))
#define SBAR() __builtin_amdgcn_sched_barrier(0)
__device__ __forceinline__ int crow(int r, int hi) { return (r & 3) + 8 * (r >> 2) + 4 * hi; }
__device__ __forceinline__ unsigned cvtpk(float lo, float hi) { unsigned r; asm volatile("v_cvt_pk_bf16_f32 %0, %1, %2" : "=v"(r) : "v"(lo), "v"(hi)); return r; }

__device__ __forceinline__ void partialSM(f32x16& p0, f32x16& p1, float& m_reg, float& mn, float& alpha) {
  float pmax = p0[0];
#pragma unroll
  for (int r = 1; r < 16; ++r) pmax = fmaxf(pmax, p0[r]);
#pragma unroll
  for (int r = 0; r < 16; ++r) pmax = fmaxf(pmax, p1[r]);
  { auto rr = __builtin_amdgcn_permlane32_swap(__float_as_uint(pmax), __float_as_uint(pmax), false, false);
    pmax = fmaxf(__uint_as_float(rr[0]), __uint_as_float(rr[1])); }
  if (__builtin_expect(__all(pmax - m_reg <= THRL), 1)) { mn = m_reg; alpha = 1.f; }
  else { mn = fmaxf(m_reg, pmax); alpha = __builtin_amdgcn_exp2f(m_reg - mn); m_reg = mn; }
#pragma unroll
  for (int r = 0; r < 16; ++r) p0[r] = p0[r] - mn;
#pragma unroll
  for (int r = 0; r < 16; ++r) p1[r] = p1[r] - mn;
#pragma unroll
  for (int r = 0; r < 16; ++r) p0[r] = __builtin_amdgcn_exp2f(p0[r]);
}
__device__ __forceinline__ void finishSM(f32x16& p0, f32x16& p1, float alpha, float& l_reg, bf16x8& pa0, bf16x8& pa1, bf16x8& pa2, bf16x8& pa3) {
#pragma unroll
  for (int r = 0; r < 16; ++r) p1[r] = __builtin_amdgcn_exp2f(p1[r]);
  float ps = 0;
#pragma unroll
  for (int r = 0; r < 16; ++r) ps += p0[r];
#pragma unroll
  for (int r = 0; r < 16; ++r) ps += p1[r];
  { auto rr = __builtin_amdgcn_permlane32_swap(__float_as_uint(ps), __float_as_uint(ps), false, false);
    ps = __uint_as_float(rr[0]) + __uint_as_float(rr[1]); }
  l_reg = l_reg * alpha + ps;
#define PK4(P, BASE, OUT) do { unsigned a0 = cvtpk(P[BASE + 0], P[BASE + 1]), a1 = cvtpk(P[BASE + 2], P[BASE + 3]);   \
    unsigned b0 = cvtpk(P[BASE + 4], P[BASE + 5]), b1 = cvtpk(P[BASE + 6], P[BASE + 7]);                              \
    auto r0 = __builtin_amdgcn_permlane32_swap(a0, b0, false, false); auto r1 = __builtin_amdgcn_permlane32_swap(a1, b1, false, false); \
    u32x4 w = {r0[0], r1[0], r0[1], r1[1]}; OUT = *reinterpret_cast<bf16x8*>(&w); } while (0)
  PK4(p0, 0, pa0); PK4(p0, 8, pa1); PK4(p1, 0, pa2); PK4(p1, 8, pa3);
#undef PK4
}
__device__ __forceinline__ void qkt(f32x16& p0, f32x16& p1, const char* Ks, const char* qr, int r32, int hi, int cofs, float dq, float nsl) {
#pragma unroll
  for (int r = 0; r < 16; ++r) { const float cr = (float)((r & 3) + 8 * (r >> 2)); p0[r] = nsl * __builtin_fabsf(dq - cr); p1[r] = nsl * __builtin_fabsf(dq - (32.f + cr)); }
#pragma unroll
  for (int d0 = 0; d0 < 4; ++d0) { const int cb = cofs + d0 * 32 + hi * 16;
    bf16x8 b0 = *reinterpret_cast<const bf16x8*>(Ks + KSWZ(r32, cb));
    bf16x8 b1 = *reinterpret_cast<const bf16x8*>(Ks + KSWZ(32 + r32, cb));
    const bf16x8 qf = *reinterpret_cast<const bf16x8*>(qr + d0 * 1024);
    p0 = __builtin_amdgcn_mfma_f32_32x32x16_bf16(b0, qf, p0, 0, 0, 0);
    p1 = __builtin_amdgcn_mfma_f32_32x32x16_bf16(b1, qf, p1, 0, 0, 0); }
}
__device__ __forceinline__ int v_st(int k, int c) { const int kk = (k & ~0xC) | ((k & 4) << 1) | ((k & 8) >> 1); return ((kk >> 3) * 4 + (c >> 5)) * 512 + ((kk & 7) * 32 + (c & 31)) * 2; }
__device__ __forceinline__ int v_rd_base(int lane) { return ((lane & 3) << 3) | (((lane >> 2) & 3) << 6) | (((lane >> 4) & 1) << 5) | (((lane >> 5) & 1) << 8); }
constexpr int v_rd_off(int d0, int ks, int half) { return d0 * 512 + ks * 4096 + half * 2048; }
template <int OFF> __device__ __forceinline__ s16x4 tr_read(int vb) {
  s16x4 r; asm volatile("ds_read_b64_tr_b16 %0, %1 offset:%2" : "=&v"(r) : "v"(vb), "i"(OFF) : "memory"); return r;
}
template <int D0> __device__ __forceinline__ void pv_one(f32x16& od, int vb, bf16x8 pa0, bf16x8 pa1, bf16x8 pa2, bf16x8 pa3) {
  const s16x4 l0 = tr_read<v_rd_off(D0, 0, 0)>(vb), h0 = tr_read<v_rd_off(D0, 0, 1)>(vb), l1 = tr_read<v_rd_off(D0, 1, 0)>(vb), h1 = tr_read<v_rd_off(D0, 1, 1)>(vb);
  const s16x4 l2 = tr_read<v_rd_off(D0, 2, 0)>(vb), h2 = tr_read<v_rd_off(D0, 2, 1)>(vb), l3 = tr_read<v_rd_off(D0, 3, 0)>(vb), h3 = tr_read<v_rd_off(D0, 3, 1)>(vb);
  asm volatile("s_waitcnt lgkmcnt(0)" ::: "memory"); SBAR();
#define PK(L, H) (bf16x8){L[0], L[1], L[2], L[3], H[0], H[1], H[2], H[3]}
  od = __builtin_amdgcn_mfma_f32_32x32x16_bf16(pa0, PK(l0, h0), od, 0, 0, 0);
  od = __builtin_amdgcn_mfma_f32_32x32x16_bf16(pa1, PK(l1, h1), od, 0, 0, 0);
  od = __builtin_amdgcn_mfma_f32_32x32x16_bf16(pa2, PK(l2, h2), od, 0, 0, 0);
  od = __builtin_amdgcn_mfma_f32_32x32x16_bf16(pa3, PK(l3, h3), od, 0, 0, 0);
#undef PK
}
__device__ __forceinline__ void pv_d0(f32x16* o, int vb, bf16x8 pa0, bf16x8 pa1, bf16x8 pa2, bf16x8 pa3) {
  pv_one<0>(o[0], vb, pa0, pa1, pa2, pa3); pv_one<1>(o[1], vb, pa0, pa1, pa2, pa3); pv_one<2>(o[2], vb, pa0, pa1, pa2, pa3); pv_one<3>(o[3], vb, pa0, pa1, pa2, pa3);
}

__device__ __forceinline__ void attn_unit(const bf16_t* __restrict__ QKV, bf16_t* __restrict__ CAT, int b, int h, int qb, float lam, const float* __restrict__ head_g, char* lds) {
  const int tid = threadIdx.x, wid = tid >> 6, lane = tid & 63, r32 = lane & 31, hi = lane >> 5, cmap = wid >> 2, wq = wid & 3;
  char* V_lds = lds; char* K_lds = lds + 2 * SHM_V;
  float* ws = (float*)(lds + WS_OFF) + wid * 64; float* li_l = ws; float* al_l = ws + 32;
  float m_reg = -1e30f, l_reg = 0; f32x16 o[4] = {};
  char* qr = lds + 65536 + wid * 4096 + lane * 16;
  const bf16_t* Qw = QKV + (size_t)(b * 2048 + qb * 128 + wq * 32 + r32) * LDK + h * 128 + cmap * 64 + hi * 8;
#pragma unroll
  for (int d0 = 0; d0 < 4; ++d0) *reinterpret_cast<bf16x8*>(qr + d0 * 1024) = *reinterpret_cast<const bf16x8*>(Qw + d0 * 16);
  const bf16_t* Kh = QKV + (size_t)(b * 2048) * LDK + 1024 + h * 128;
  const bf16_t* Vh = QKV + (size_t)(b * 2048) * LDK + 2048 + h * 128;
  const float dqb = (float)(qb * 128 + wq * 32 + r32 - 4 * hi);
  const float nsl = -1.4426950408889634f * __builtin_amdgcn_exp2f(-(float)(h + 1));
  const int cofs = cmap * 128;
  const int sr = tid >> 4, sc = (tid & 15) * 8, vst0 = v_st(sr, sc), vst1 = v_st(32 + sr, sc);
  const int vb0 = (int)(uintptr_t)V_lds + v_rd_base(lane);
  struct { bf16x8 vs0, vs1, ks0, ks1; } sr_[SDEPTH];
#define SLOAD(i, k0) do { sr_[i].vs0 = *reinterpret_cast<const bf16x8*>(&Vh[(size_t)((k0) + sr) * LDK + sc]); sr_[i].vs1 = *reinterpret_cast<const bf16x8*>(&Vh[(size_t)((k0) + 32 + sr) * LDK + sc]); \
    sr_[i].ks0 = *reinterpret_cast<const bf16x8*>(&Kh[(size_t)((k0) + sr) * LDK + sc]); sr_[i].ks1 = *reinterpret_cast<const bf16x8*>(&Kh[(size_t)((k0) + 32 + sr) * LDK + sc]); } while (0)
#define SWRITE(bb, i) do { *(bf16x8*)(V_lds + (bb) * SHM_V + vst0) = sr_[i].vs0;          \
    *(bf16x8*)(V_lds + (bb) * SHM_V + vst1) = sr_[i].vs1; int kc = sc * 2;               \
    *(bf16x8*)(K_lds + (bb) * SHM_K + KSWZ(sr, kc)) = sr_[i].ks0;                       \
    *(bf16x8*)(K_lds + (bb) * SHM_K + KSWZ(32 + sr, kc)) = sr_[i].ks1; } while (0)
#define SWAIT() do { if constexpr (SDEPTH == 2) asm volatile("s_waitcnt vmcnt(4)" ::: "memory"); else asm volatile("s_waitcnt vmcnt(0)" ::: "memory"); } while (0)
#define RESC(a) do { if (__any((a) < 1.f)) { if (hi == 0) al_l[r32] = (a); asm volatile("s_waitcnt lgkmcnt(0)" ::: "memory"); \
    _Pragma("unroll") for (int d = 0; d < 4; ++d) _Pragma("unroll") for (int r = 0; r < 16; ++r) o[d][r] *= al_l[crow(r, hi)]; } } while (0)
  f32x16 pA0, pA1, pB0, pB1; float mnA, mnB, alA, alB; bf16x8 pa0, pa1, pa2, pa3;
  constexpr int SE = 0, SO = SDEPTH - 1;
  SLOAD(SE, 0); asm volatile("s_waitcnt vmcnt(0)" ::: "memory"); SWRITE(0, SE); __syncthreads();
  qkt(pA0, pA1, K_lds, qr, r32, hi, cofs, dqb, nsl); partialSM(pA0, pA1, m_reg, mnA, alA);
  SLOAD(SO, KVBLK); if constexpr (SDEPTH == 2) SLOAD(SE, 2 * KVBLK);
  SWAIT(); SWRITE(1, SO); __syncthreads();
  for (int j = 1; j + 1 < NT; j += 2) {
    SBAR(); qkt(pB0, pB1, K_lds + SHM_K, qr, r32, hi, cofs, dqb - (float)(j * KVBLK), nsl);
    finishSM(pA0, pA1, alA, l_reg, pa0, pa1, pa2, pa3); SBAR();
    SLOAD(SO, (j + SDEPTH) * KVBLK); SBAR();
    pv_d0(o, vb0, pa0, pa1, pa2, pa3); partialSM(pB0, pB1, m_reg, mnB, alB);
    __syncthreads(); SWAIT(); SWRITE(0, SE);
    RESC(alB); __syncthreads();
    SBAR(); qkt(pA0, pA1, K_lds, qr, r32, hi, cofs, dqb - (float)((j + 1) * KVBLK), nsl);
    finishSM(pB0, pB1, alB, l_reg, pa0, pa1, pa2, pa3); SBAR();
    if (SDEPTH == 1 || j + 3 < NT) SLOAD(SE, (j + 1 + SDEPTH) * KVBLK); SBAR();
    pv_d0(o, vb0 + SHM_V, pa0, pa1, pa2, pa3); partialSM(pA0, pA1, m_reg, mnA, alA);
    __syncthreads(); SWAIT(); SWRITE(1, SO);
    RESC(alA); __syncthreads();
  }
  SBAR(); qkt(pB0, pB1, K_lds + SHM_K, qr, r32, hi, cofs, dqb - (float)((NT - 1) * KVBLK), nsl);
  finishSM(pA0, pA1, alA, l_reg, pa0, pa1, pa2, pa3); SBAR();
  pv_d0(o, vb0, pa0, pa1, pa2, pa3); partialSM(pB0, pB1, m_reg, mnB, alB);
  __syncthreads(); RESC(alB);
  finishSM(pB0, pB1, alB, l_reg, pa0, pa1, pa2, pa3); SBAR();
  pv_d0(o, vb0 + SHM_V, pa0, pa1, pa2, pa3);
  if (hi == 0) li_l[r32] = l_reg; asm volatile("s_waitcnt lgkmcnt(0)" ::: "memory");
  float rli[16];
#pragma unroll
  for (int r = 0; r < 16; ++r) rli[r] = __builtin_amdgcn_rcpf(li_l[crow(r, hi)]);
  __syncthreads();
  float* OB = (float*)lds + cmap * 16384 + (wq * 32) * 128;
#pragma unroll
  for (int r = 0; r < 16; ++r) { const int orow = crow(r, hi);
#pragma unroll
    for (int d0 = 0; d0 < 4; ++d0) OB[orow * 128 + d0 * 32 + r32] = o[d0][r] * rli[r]; }
  __syncthreads();
  { const int row = tid >> 2, qtr = tid & 3;
    const f32x4* o1 = (const f32x4*)((const float*)lds + row * 128 + qtr * 32); const f32x4* o2 = o1 + 4096;
    f32x4 v[8]; float ssq = 0.f;
#pragma unroll
    for (int k = 0; k < 8; ++k) { v[k] = o1[k] - lam * o2[k]; ssq += (v[k][0] * v[k][0] + v[k][1] * v[k][1]) + (v[k][2] * v[k][2] + v[k][3] * v[k][3]); }
    ssq += __shfl_xor(ssq, 1); ssq += __shfl_xor(ssq, 2);
    const float rs = rsqrtf(ssq * (1.0f / 128.0f) + 1e-6f) * 0.8f;
    bf16_t* dst = CAT + (size_t)(b * 2048 + qb * 128 + row) * 2048 + h * 128 + qtr * 32;
    const f32x4* hg = (const f32x4*)(head_g + qtr * 32);
#pragma unroll
    for (int k = 0; k < 8; k += 2) { const f32x4 g0 = hg[k], g1 = hg[k + 1]; const f32x4 a = v[k] * rs * g0, c = v[k + 1] * rs * g1;
      u32x4 w; w.x = cvtpk(a[0], a[1]); w.y = cvtpk(a[2], a[3]); w.z = cvtpk(c[0], c[1]); w.w = cvtpk(c[2], c[3]);
      *(u32x4*)(dst + k * 4) = w; }
  }
  __syncthreads();
#undef SLOAD
#undef SWRITE
#undef SWAIT
#undef RESC
}
#undef SBAR
}
#define LAS __attribute__((address_space(3)))
typedef unsigned short bf16_t;
typedef short bf16x8 __attribute__((ext_vector_type(8)));
typedef float f32x4 __attribute__((ext_vector_type(4)));
typedef float f32x16 __attribute__((ext_vector_type(16)));
typedef unsigned u32x4 __attribute__((ext_vector_type(4)));
typedef unsigned u32x2 __attribute__((ext_vector_type(2)));
constexpr int DM = 2048, BATCH = 4, SEQ = 2048, MT = BATCH * SEQ, DFF = 5632, NGU = 2 * DFF, INC = 4096, SW = 1024;
constexpr int SG = 64, CT = 16, NCH = SEQ / CT, NROW = BATCH * NCH;
constexpr float EPS = 1e-6f;
constexpr int NWAVES = 8, LDS_BYTES = 136 * 1024;
constexpr size_t al256(size_t x) { return (x + 255) / 256 * 256; }
constexpr size_t WS_W1G = 0;
constexpr size_t WS_W1D = WS_W1G + (size_t)NGU * DM * 2;
constexpr size_t WS_WIN = WS_W1D + (size_t)DM * DFF * 2;
constexpr size_t WS_WOUT = WS_WIN + (size_t)INC * DM * 2;
constexpr size_t WS_WGLU = WS_WOUT + (size_t)DM * DM * 2;
constexpr size_t WS_XN = WS_WGLU + (size_t)SW * SW * 2;
constexpr size_t WS_HFF = WS_XN + (size_t)MT * DM * 2;
constexpr size_t WS_QKV = WS_HFF, WS_UG = WS_QKV + (size_t)MT * 3072 * 2, WS_HIN = WS_UG + (size_t)SG * NROW * 256 * 2;
constexpr size_t WS_Y = WS_HFF + (size_t)MT * DFF * 2;
constexpr size_t WS_SLOC = WS_Y, WS_GB = WS_SLOC + (size_t)SG * NROW * 256 * 4, WS_SPRE = WS_GB + (size_t)MT * SW * 2;
constexpr size_t WS_SSQ = WS_Y + (size_t)MT * DM * 4;
constexpr size_t WS_SSQ2 = WS_SSQ + (size_t)MT * 32 * 4;
constexpr size_t WS_EMAT = WS_SSQ2 + (size_t)MT * 16 * 4;
constexpr size_t WS_MFT = WS_EMAT + (size_t)SG * 8 * 16 * 1024;
constexpr size_t WS_ATAB = WS_MFT + (size_t)SG * 8 * 32 * 1024;
constexpr size_t WS_CTL = WS_ATAB + (size_t)SG * 2 * 64 * 2 * 4;
constexpr size_t CTL_BYTES = 16384;
constexpr size_t WS_END = WS_CTL + CTL_BYTES;
constexpr int LDS_BARST = 133120;
static_assert(WS_HIN + (size_t)SG * NROW * 256 * 2 <= WS_Y && WS_SPRE + (size_t)MT * SW * 2 <= WS_SSQ, "overlays");

__device__ __forceinline__ unsigned cvtpk(float lo, float hi) { unsigned r; asm volatile("v_cvt_pk_bf16_f32 %0, %1, %2" : "=v"(r) : "v"(lo), "v"(hi)); return r; }
__device__ __forceinline__ float wave_sum(float v) {
#pragma unroll
    for (int o = 1; o < 64; o <<= 1) v += __shfl_xor(v, o);
    return v;
}
__device__ __forceinline__ float bf2f_lo(unsigned w) { return __uint_as_float(w << 16); }
__device__ __forceinline__ float bf2f_hi(unsigned w) { return __uint_as_float(w & 0xffff0000u); }

struct Params { const float* in[31]; float* out; unsigned char* ws; int ph_lo, ph_hi; };

__device__ __forceinline__ void transpose_item(const float* __restrict__ W, int K, int N, bf16_t* __restrict__ WT, int k0, int n0, int rowbase, LAS float* scr, int lane) {
#pragma unroll 8
    for (int i = 0; i < 32; ++i) { const int kk = 2 * i + (lane >> 5); scr[kk * 33 + (lane & 31)] = W[(size_t)(k0 + kk) * N + n0 + (lane & 31)]; }
    asm volatile("s_waitcnt lgkmcnt(0)" ::: "memory");
    const int c = lane & 7;
#pragma unroll
    for (int j = 0; j < 4; ++j) { const int n = (lane >> 3) + 8 * j; const LAS float* s = scr + (8 * c) * 33 + n;
        u32x4 o; o.x = cvtpk(s[0 * 33], s[1 * 33]); o.y = cvtpk(s[2 * 33], s[3 * 33]); o.z = cvtpk(s[4 * 33], s[5 * 33]); o.w = cvtpk(s[6 * 33], s[7 * 33]);
        *(u32x4*)(WT + (size_t)(rowbase + n) * K + k0 + 8 * c) = o; }
    asm volatile("s_waitcnt lgkmcnt(0)" ::: "memory");
}
__device__ __forceinline__ void convert_gateup(const float* wg, const float* wu, unsigned char* ws, LAS float* scr, int gw, int ngw, int lane) {
    constexpr int IG = (DM / 64) * (DFF / 32);
    bf16_t* G = (bf16_t*)(ws + WS_W1G);
    for (int it = gw; it < 2 * IG; it += ngw) {
        int r = it; const int up = r >= IG; if (up) r -= IG; const int nb = r % (DFF / 32), kb = r / (DFF / 32), n0 = nb * 32;
        transpose_item(up ? wu : wg, DM, DFF, G, kb * 64, n0, (n0 >> 7) * 256 + (n0 & 127) + up * 128, scr, lane);
    }
}
__device__ __forceinline__ void convert_plain(const float* w, int K, int N, bf16_t* WT, LAS float* scr, int gw, int ngw, int lane) {
    const int items = (K / 64) * (N / 32);
    for (int r = gw; r < items; r += ngw) { const int nb = r % (N / 32), kb = r / (N / 32); transpose_item(w, K, N, WT, kb * 64, nb * 32, nb * 32, scr, lane); }
}
__device__ __forceinline__ void prenorm_rows(const float* __restrict__ X, const float* __restrict__ g, bf16_t* __restrict__ XN, int gw, int ngw, int lane) {
    for (int row = gw; row < MT; row += ngw) {
        const f32x4* xr = (const f32x4*)(X + (size_t)row * DM) + lane; f32x4 v[8]; float s = 0.f;
#pragma unroll
        for (int j = 0; j < 8; ++j) { v[j] = xr[64 * j]; s += (v[j][0] * v[j][0] + v[j][1] * v[j][1]) + (v[j][2] * v[j][2] + v[j][3] * v[j][3]); }
        const float rs = rsqrtf(wave_sum(s) * (1.0f / DM) + EPS);
        u32x2* o8 = (u32x2*)(XN + (size_t)row * DM) + lane;
#pragma unroll
        for (int j = 0; j < 8; ++j) { const f32x4 gg = ((const f32x4*)g)[lane + 64 * j]; u32x2 w; w.x = cvtpk(v[j][0] * rs * gg[0], v[j][1] * rs * gg[1]); w.y = cvtpk(v[j][2] * rs * gg[2], v[j][3] * rs * gg[3]); o8[64 * j] = w; }
    }
}
__device__ __forceinline__ void resid_rows(const float* SRC, const bf16_t* __restrict__ Y, const float* __restrict__ SSQ, int npart, const float* __restrict__ gpost, float coef,
                                           float* OUT, const float* __restrict__ gpre, bf16_t* XN, int gw, int ngw, int lane) {
    for (int row = gw; row < MT; row += ngw) {
        float s = lane < npart ? SSQ[(size_t)row * npart + lane] : 0.f;
        const float rs = rsqrtf(wave_sum(s) * (1.0f / DM) + EPS) * coef;
        const u32x2* yr = (const u32x2*)(Y + (size_t)row * DM) + lane; const f32x4* xr = (const f32x4*)(SRC + (size_t)row * DM) + lane; f32x4* orow = (f32x4*)(OUT + (size_t)row * DM) + lane;
        f32x4 v[8]; float s1 = 0.f;
#pragma unroll
        for (int j = 0; j < 8; ++j) { const f32x4 gg = ((const f32x4*)gpost)[lane + 64 * j]; const u32x2 yw = yr[64 * j]; const f32x4 yv = {bf2f_lo(yw.x), bf2f_hi(yw.x), bf2f_lo(yw.y), bf2f_hi(yw.y)}; v[j] = xr[64 * j] + yv * rs * gg; orow[64 * j] = v[j];
            s1 += (v[j][0] * v[j][0] + v[j][1] * v[j][1]) + (v[j][2] * v[j][2] + v[j][3] * v[j][3]); }
        if (XN) {
            const float r1 = rsqrtf(wave_sum(s1) * (1.0f / DM) + EPS);
            u32x2* o8 = (u32x2*)(XN + (size_t)row * DM) + lane;
#pragma unroll
            for (int j = 0; j < 8; ++j) { const f32x4 gg = ((const f32x4*)gpre)[lane + 64 * j]; u32x2 w; w.x = cvtpk(v[j][0] * r1 * gg[0], v[j][1] * r1 * gg[1]); w.y = cvtpk(v[j][2] * r1 * gg[2], v[j][3] * r1 * gg[3]); o8[64 * j] = w; }
        }
    }
}
__device__ __forceinline__ void snorm_rows(const bf16_t* __restrict__ SPRE, const float* __restrict__ SSQ2, const float* __restrict__ og, bf16_t* __restrict__ CAT, int gw, int ngw, int lane) {
    for (int row = gw; row < MT; row += ngw) {
        float s = lane < 16 ? SSQ2[(size_t)row * 16 + lane] : 0.f;
        const float rs = rsqrtf(wave_sum(s) * (1.0f / SW) + EPS);
#pragma unroll
        for (int j = 0; j < 2; ++j) { const int c8 = lane + 64 * j; const u32x4 w = *((const u32x4*)(SPRE + (size_t)row * SW) + c8);
            const f32x4 g0 = ((const f32x4*)og)[2 * c8], g1 = ((const f32x4*)og)[2 * c8 + 1]; u32x4 o;
            o.x = cvtpk(bf2f_lo(w.x) * rs * g0[0], bf2f_hi(w.x) * rs * g0[1]); o.y = cvtpk(bf2f_lo(w.y) * rs * g0[2], bf2f_hi(w.y) * rs * g0[3]);
            o.z = cvtpk(bf2f_lo(w.z) * rs * g1[0], bf2f_hi(w.z) * rs * g1[1]); o.w = cvtpk(bf2f_lo(w.w) * rs * g1[2], bf2f_hi(w.w) * rs * g1[3]);
            *((u32x4*)(CAT + (size_t)row * DM + SW) + c8) = o; }
    }
}

__device__ __forceinline__ void s5_tables(const Params& p, int g, float* L) {
    const int t = threadIdx.x;
    float* APOW = L; float* FF = APOW + 2 * 64 * 17 * 2; float* BB = FF + 2 * 64 * 2; float* CC = BB + 2 * 64 * 16 * 2; float* KL = CC + 2 * 16 * 64 * 2;
    unsigned char* ws = p.ws;
    __syncthreads();
    if (t < 128) {
        const int dir = t >> 6, n = t & 63, idx = (dir * SG + g) * 64 + n;
        const float lr = p.in[13][idx], li = p.in[14][idx], dt = expf(p.in[15][dir * SG + g]);
        const float mag = expf(lr * dt), ar = mag * cosf(li * dt), ai = mag * sinf(li * dt);
        const float den = lr * lr + li * li, nr = ar - 1.0f;
        FF[(dir * 64 + n) * 2] = (nr * lr + ai * li) / den; FF[(dir * 64 + n) * 2 + 1] = (ai * lr - nr * li) / den;
        float pr = 1.f, pi = 0.f;
        for (int k = 0; k <= 16; ++k) { APOW[((dir * 64 + n) * 17 + k) * 2] = pr; APOW[((dir * 64 + n) * 17 + k) * 2 + 1] = pi; const float qr = pr * ar - pi * ai, qi = pr * ai + pi * ar; pr = qr; pi = qi; }
        float* AT = (float*)(ws + WS_ATAB) + ((g * 2 + dir) * 64 + n) * 2;
        AT[0] = APOW[((dir * 64 + n) * 17 + 16) * 2]; AT[1] = APOW[((dir * 64 + n) * 17 + 16) * 2 + 1];
    }
    __syncthreads();
    for (int e = t; e < 2048; e += 512) {
        { const int dir = e >> 10, n = (e >> 4) & 63, q = e & 15; const size_t bi = ((size_t)(dir * SG + g) * 64 + n) * 16 + q;
          const float br = p.in[16][bi], bim = p.in[17][bi], fr = FF[(dir * 64 + n) * 2], fi = FF[(dir * 64 + n) * 2 + 1];
          BB[((dir * 64 + n) * 16 + q) * 2] = fr * br - fi * bim; BB[((dir * 64 + n) * 16 + q) * 2 + 1] = fr * bim + fi * br; }
        { const int dir = e >> 10, pp = (e >> 6) & 15, n = e & 63; const size_t ci = ((size_t)(dir * SG + g) * 16 + pp) * 64 + n;
          CC[((dir * 16 + pp) * 64 + n) * 2] = p.in[18][ci]; CC[((dir * 16 + pp) * 64 + n) * 2 + 1] = p.in[19][ci]; }
    }
    __syncthreads();
    for (int e = t; e < 8192; e += 512) {
        const int q = e & 15, pp = (e >> 4) & 15, l = (e >> 8) & 15, dir = e >> 12; float s = 0.f;
        for (int n = 0; n < 64; ++n) {
            const float cr = CC[((dir * 16 + pp) * 64 + n) * 2], ci = CC[((dir * 16 + pp) * 64 + n) * 2 + 1];
            const float ar = APOW[((dir * 64 + n) * 17 + l) * 2], ai = APOW[((dir * 64 + n) * 17 + l) * 2 + 1];
            const float wr = cr * ar - ci * ai, wi = cr * ai + ci * ar;
            s += wr * BB[((dir * 64 + n) * 16 + q) * 2] - wi * BB[((dir * 64 + n) * 16 + q) * 2 + 1];
        }
        KL[e] = s;
    }
    __syncthreads();
    for (int ch = t; ch < 8192; ch += 512) {
        const int lane = ch & 63, ks = (ch >> 6) & 15, nt = ch >> 10, np = nt * 32 + (lane & 31), dir = np >> 7, ri = (np >> 6) & 1, n = np & 63, q0 = (lane >> 5) * 8;
        const int pw = dir == 0 ? 15 - ks : ks;
        const float ar = APOW[((dir * 64 + n) * 17 + pw) * 2], ai = APOW[((dir * 64 + n) * 17 + pw) * 2 + 1];
        float z[8];
#pragma unroll
        for (int j = 0; j < 8; ++j) { const float br = BB[((dir * 64 + n) * 16 + q0 + j) * 2], bi = BB[((dir * 64 + n) * 16 + q0 + j) * 2 + 1]; z[j] = ri ? (ar * bi + ai * br) : (ar * br - ai * bi); }
        u32x4 o; o.x = cvtpk(z[0], z[1]); o.y = cvtpk(z[2], z[3]); o.z = cvtpk(z[4], z[5]); o.w = cvtpk(z[6], z[7]);
        *(u32x4*)(ws + WS_EMAT + ((size_t)((g * 8 + nt) * 16 + ks)) * 1024 + lane * 16) = o;
    }
    for (int ch = t; ch < 16384; ch += 512) {
        const int lane = ch & 63, ks = (ch >> 6) & 31, nt = ch >> 11, no = nt * 32 + (lane & 31), tau = no >> 4, pp = no & 15;
        float z[8];
        if (ks < 16) { const int sg = ks, q0 = (lane >> 5) * 8;
#pragma unroll
            for (int j = 0; j < 8; ++j) { const int q = q0 + j; float v = 0.f;
                if (sg <= tau) v += KL[((0 * 16 + (tau - sg)) * 16 + pp) * 16 + q];
                if (sg >= tau) v += KL[((1 * 16 + (sg - tau)) * 16 + pp) * 16 + q];
                if (sg == tau && pp == q) v += p.in[20][g * 16 + pp];
                z[j] = v; }
        } else { const int np0 = (ks - 16) * 16 + (lane >> 5) * 8, dir = np0 >> 7, ri = (np0 >> 6) & 1, n0 = np0 & 63, pw = dir == 0 ? tau + 1 : 16 - tau;
#pragma unroll
            for (int j = 0; j < 8; ++j) { const int n = n0 + j; const float cr = CC[((dir * 16 + pp) * 64 + n) * 2], ci = CC[((dir * 16 + pp) * 64 + n) * 2 + 1];
                const float ar = APOW[((dir * 64 + n) * 17 + pw) * 2], ai = APOW[((dir * 64 + n) * 17 + pw) * 2 + 1];
                z[j] = ri ? -(cr * ai + ci * ar) : (cr * ar - ci * ai); }
        }
        u32x4 o; o.x = cvtpk(z[0], z[1]); o.y = cvtpk(z[2], z[3]); o.z = cvtpk(z[4], z[5]); o.w = cvtpk(z[6], z[7]);
        *(u32x4*)(ws + WS_MFT + ((size_t)((g * 8 + nt) * 32 + ks)) * 1024 + lane * 16) = o;
    }
    __syncthreads();
}
__device__ __forceinline__ int crow16(int r, int hi) { return (r & 3) + 8 * (r >> 2) + 4 * hi; }
__device__ __forceinline__ void s5_estate(unsigned char* ws, int gw, int ngw, int lane) {
    for (int task = gw; task < SG * 16 * 2; task += ngw) {
        const int nh = task & 1, rt = (task >> 1) & 15, g = task >> 5, r32 = lane & 31, hi = lane >> 5;
        const bf16_t* A = (const bf16_t*)(ws + WS_UG) + ((size_t)(g * NROW + rt * 32 + r32)) * 256 + hi * 8;
        const unsigned char* B = ws + WS_EMAT + (size_t)(g * 8 + nh * 4) * 16 * 1024 + lane * 16;
        f32x16 acc[4] = {};
#pragma unroll 4
        for (int ks = 0; ks < 16; ++ks) { const bf16x8 a = *(const bf16x8*)(A + ks * 16);
#pragma unroll
            for (int nt = 0; nt < 4; ++nt) { const bf16x8 b = *(const bf16x8*)(B + (size_t)(nt * 16 + ks) * 1024); acc[nt] = __builtin_amdgcn_mfma_f32_32x32x16_bf16(a, b, acc[nt], 0, 0, 0); } }
        float* S = (float*)(ws + WS_SLOC) + ((size_t)(g * NROW + rt * 32)) * 256 + nh * 128 + r32;
#pragma unroll
        for (int nt = 0; nt < 4; ++nt)
#pragma unroll
            for (int r = 0; r < 16; ++r) S[(size_t)crow16(r, hi) * 256 + nt * 32] = acc[nt][r];
    }
}
__device__ __forceinline__ void s5_scan(unsigned char* ws, int gw, int ngw, int lane) {
    for (int task = gw; task < BATCH * SG * 2; task += ngw) {
        const int dir = task & 1, g = (task >> 1) & 63, b = task >> 7;
        const float* AT = (const float*)(ws + WS_ATAB) + ((g * 2 + dir) * 64 + lane) * 2; const float ar = AT[0], ai = AT[1];
        const float* S = (const float*)(ws + WS_SLOC) + ((size_t)(g * NROW + b * NCH)) * 256 + dir * 128 + lane;
        bf16_t* H = (bf16_t*)(ws + WS_HIN) + ((size_t)(g * NROW + b * NCH)) * 256 + dir * 128 + lane;
        float hr = 0.f, hi = 0.f;
        for (int c0 = 0; c0 < NCH; c0 += 16) {
            float sr[16], si[16];
#pragma unroll
            for (int k = 0; k < 16; ++k) { const int c = dir == 0 ? c0 + k : NCH - 1 - (c0 + k); sr[k] = S[(size_t)c * 256]; si[k] = S[(size_t)c * 256 + 64]; }
#pragma unroll
            for (int k = 0; k < 16; ++k) { const int c = dir == 0 ? c0 + k : NCH - 1 - (c0 + k);
                H[(size_t)c * 256] = (bf16_t)(cvtpk(hr, 0.f) & 0xffffu); H[(size_t)c * 256 + 64] = (bf16_t)(cvtpk(hi, 0.f) & 0xffffu);
                const float nr = ar * hr - ai * hi + sr[k], ni = ar * hi + ai * hr + si[k]; hr = nr; hi = ni; }
        }
    }
}
__device__ __forceinline__ void s5_output(unsigned char* ws, int gw, int ngw, int lane) {
    for (int task = gw; task < SG * 16 * 2; task += ngw) {
        const int nh = task & 1, rt = (task >> 1) & 15, g = task >> 5, r32 = lane & 31, hi = lane >> 5;
        const bf16_t* A0 = (const bf16_t*)(ws + WS_UG) + ((size_t)(g * NROW + rt * 32 + r32)) * 256 + hi * 8;
        const bf16_t* A1 = (const bf16_t*)(ws + WS_HIN) + ((size_t)(g * NROW + rt * 32 + r32)) * 256 + hi * 8;
        const unsigned char* B = ws + WS_MFT + (size_t)(g * 8 + nh * 4) * 32 * 1024 + lane * 16;
        f32x16 acc[4] = {};
#pragma unroll 4
        for (int ks = 0; ks < 16; ++ks) { const bf16x8 a = *(const bf16x8*)(A0 + ks * 16);
#pragma unroll
            for (int nt = 0; nt < 4; ++nt) { const bf16x8 b = *(const bf16x8*)(B + (size_t)(nt * 32 + ks) * 1024); acc[nt] = __builtin_amdgcn_mfma_f32_32x32x16_bf16(a, b, acc[nt], 0, 0, 0); } }
#pragma unroll 4
        for (int ks = 0; ks < 16; ++ks) { const bf16x8 a = *(const bf16x8*)(A1 + ks * 16);
#pragma unroll
            for (int nt = 0; nt < 4; ++nt) { const bf16x8 b = *(const bf16x8*)(B + (size_t)(nt * 32 + 16 + ks) * 1024); acc[nt] = __builtin_amdgcn_mfma_f32_32x32x16_bf16(a, b, acc[nt], 0, 0, 0); } }
        bf16_t* GBp = (bf16_t*)(ws + WS_GB);
#pragma unroll
        for (int nt = 0; nt < 4; ++nt) { const int no = nh * 128 + nt * 32 + r32, tau = no >> 4, pp = no & 15;
#pragma unroll
            for (int r = 0; r < 16; ++r) { const int crw = rt * 32 + crow16(r, hi); const float y = acc[nt][r];
                const float z2 = 1.5957691216057308f * (y + 0.044715f * y * y * y);
                const float gl = y * __builtin_amdgcn_rcpf(1.0f + __builtin_amdgcn_exp2f(-1.4426950408889634f * z2));
                GBp[(size_t)(crw * 16 + tau) * SW + g * 16 + pp] = (bf16_t)(cvtpk(gl, 0.f) & 0xffffu); } }
    }
}
#define XB_TMO      128
#define XB_XCNT(j)  (256  + 64 * (j))
#define XB_XSUB(j)  (1280 + 64 * (j))
#define XB_XGEN(j)  (2304 + 64 * (j))
#define XB_TOP      3328
#define XB_TOPGEN   3392
#define XCD_BAR_WORDS 3456
#define XB_SPIN_CAP (1u << 18)

__device__ __forceinline__ unsigned xb_ld(unsigned* p)              { return __hip_atomic_load(p, __ATOMIC_RELAXED, __HIP_MEMORY_SCOPE_AGENT); }
__device__ __forceinline__ unsigned xb_add(unsigned* p, unsigned v) { return __hip_atomic_fetch_add(p, v, __ATOMIC_RELAXED, __HIP_MEMORY_SCOPE_AGENT); }
__device__ __forceinline__ unsigned xb_xcc_id() { return (unsigned)__builtin_amdgcn_s_getreg((3 << 11) | 20) & 0xFu; }
#define XB_SPIN(cond, bar) do { unsigned _sp = 0; while (cond) { __builtin_amdgcn_s_sleep(1); \
    if ((++_sp & 255u) == 0u) { if (xb_ld(&(bar)[XB_TMO])) break; if (_sp > XB_SPIN_CAP) { atomicAdd(&(bar)[XB_TMO], 1u); break; } } } } while (0)

struct XcdBarrier {
    unsigned* bar; unsigned x;
    volatile LAS unsigned* st;
};

__device__ __forceinline__ XcdBarrier xcd_barrier_post(unsigned* bar, volatile LAS unsigned* st) {
    XcdBarrier b; b.bar = bar; b.x = xb_xcc_id(); b.st = st;
    if (threadIdx.x == 0) (void)xb_add(&bar[XB_XCNT(b.x)], 1u);
    return b;
}
__device__ __forceinline__ void xcd_barrier_complete(unsigned* bar, unsigned x, unsigned& nloc, unsigned& nx) {
    const unsigned G = gridDim.x * gridDim.y * gridDim.z;
    unsigned sum, cnt, mine, sp = 0u;
    for (;;) {
        sum = 0u; cnt = 0u; mine = 0u;
#pragma unroll
        for (unsigned j = 0; j < 16; ++j) { const unsigned c = xb_ld(&bar[XB_XCNT(j)]); sum += c; cnt += (c > 0u) ? 1u : 0u; mine = (j == x) ? c : mine; }
        if (sum == G) break;
        __builtin_amdgcn_s_sleep(1);
        if ((++sp & 255u) == 0u) { if (xb_ld(&bar[XB_TMO])) break; if (sp > XB_SPIN_CAP) { atomicAdd(&bar[XB_TMO], 1u); break; } }
    }
    nloc = mine > 0u ? mine : 1u; nx = cnt > 0u ? cnt : 1u;
}

__device__ __forceinline__ void xcd_barrier(const XcdBarrier& b) {
    asm volatile("s_waitcnt vmcnt(0)" ::: "memory");
    __syncthreads();
    if (threadIdx.x == 0) {
        unsigned* bar = b.bar;
        __builtin_amdgcn_s_waitcnt(0);
        unsigned nloc = b.st[0], nx = b.st[1];
        if (nloc == 0u) { xcd_barrier_complete(bar, b.x, nloc, nx); b.st[0] = nloc; b.st[1] = nx; }
        const unsigned old = xb_add(&bar[XB_XSUB(b.x)], 1u);
        const unsigned gen = old / nloc;
        if (old + 1u == (gen + 1u) * nloc) {
            __builtin_amdgcn_fence(__ATOMIC_RELEASE, "agent");
            asm volatile("s_waitcnt vmcnt(0)" ::: "memory");
            const unsigned og = xb_add(&bar[XB_TOP], 1u);
            const unsigned tg = og / nx;
            if (og + 1u == (tg + 1u) * nx) xb_add(&bar[XB_TOPGEN], 1u);
            else XB_SPIN(xb_ld(&bar[XB_TOPGEN]) == tg, bar);
            __builtin_amdgcn_fence(__ATOMIC_ACQUIRE, "agent");
            xb_add(&bar[XB_XGEN(b.x)], 1u);
            asm volatile("s_waitcnt vmcnt(0)" ::: "memory");
        } else {
            XB_SPIN(xb_ld(&bar[XB_XGEN(b.x)]) == gen, bar);
            __builtin_amdgcn_fence(__ATOMIC_ACQUIRE, "agent");
            asm volatile("s_waitcnt vmcnt(0)" ::: "memory");
        }
    }
    __syncthreads();
}

__global__ void __launch_bounds__(NWAVES * 64, 2) fwd_megakernel(Params p) {
    extern __shared__ __attribute__((aligned(16))) unsigned char lds[];
    cg::grid_group grid = cg::this_grid();
    const int tid = threadIdx.x, lane = tid & 63, wave = __builtin_amdgcn_readfirstlane(tid >> 6);
    const int G = gridDim.x, bx = blockIdx.x, vcu = (G % 8 == 0) ? (bx % 8) * (G / 8) + bx / 8 : bx;
    const int gw = vcu * NWAVES + wave, ngw = G * NWAVES;
    const int HB = G / 2, hgw = (bx - HB) * NWAVES + wave, hngw = (G - HB) * NWAVES;
    unsigned char* ws = p.ws;
    LAS unsigned char* ldsl = (LAS unsigned char*)lds;
    LAS float* scr = (LAS float*)(ldsl + wave * 8448);
    const int lo = p.ph_lo, hi = p.ph_hi;
    if (tid < 2) ((volatile LAS unsigned*)(ldsl + LDS_BARST))[tid] = 0u;
    __syncthreads();
    XcdBarrier bar = xcd_barrier_post((unsigned*)(ws + WS_CTL), (volatile LAS unsigned*)(ldsl + LDS_BARST));
    if (hi > 1000) grid.sync();
#ifndef PH_MASK
#define PH_MASK 0x7fff
#endif
#define IN(k) (((PH_MASK >> (k)) & 1) && lo <= (k) && (k) < hi)
#ifndef DBL_MASK
#define DBL_MASK 0
#endif
#define REP(k) for (int _rp = 0; _rp < 1 + ((DBL_MASK >> (k)) & 1); ++_rp)
#ifndef SYNC_REP
#define SYNC_REP 1
#endif
#define SEAM(k) do { if (IN(k) && IN((k) + 1)) { for (int _r = 0; _r < SYNC_REP; ++_r) xcd_barrier(bar); } } while (0)
    bf16_t* XN = (bf16_t*)(ws + WS_XN); bf16_t* HFF = (bf16_t*)(ws + WS_HFF); bf16_t* Y = (bf16_t*)(ws + WS_Y); float* SSQ = (float*)(ws + WS_SSQ); float* SSQ2 = (float*)(ws + WS_SSQ2);
    bf16_t* QKV = (bf16_t*)(ws + WS_QKV); bf16_t* UG = (bf16_t*)(ws + WS_UG); bf16_t* GB = (bf16_t*)(ws + WS_GB); bf16_t* SPRE = (bf16_t*)(ws + WS_SPRE);

    if (IN(0)) REP(0) {
        convert_gateup(p.in[2], p.in[3], ws, scr, gw, ngw, lane);
        prenorm_rows(p.in[0], p.in[1], XN, gw, ngw, lane);
        for (int g = G - 1 - bx; g < SG; g += G) s5_tables(p, g, (float*)lds);
    }
    SEAM(0);
#define FFN_GATEUP() do { pg8::Gemm g{XN, (const bf16_t*)(ws + WS_W1G), MT, NGU, DM}; pg8::StaticOrder S; S.init(MT, NGU, G, bx); \
            pg8::EpiSwiGLU E{HFF, DFF}; pg8::gemm_phase<pg8::EpiSwiGLU, pg8::StaticOrder, true, true>(ldsl, g, S, E); } while (0)
#define FFN_DOWN() do { pg8::Gemm g{HFF, (const bf16_t*)(ws + WS_W1D), MT, DM, DFF}; pg8::StaticOrder S; S.init(MT, DM, G, bx); \
            pg8::EpiYSsq E{Y, SSQ, 32}; pg8::gemm_phase<pg8::EpiYSsq, pg8::StaticOrder, true, true>(ldsl, g, S, E); } while (0)
    if (IN(1)) { REP(1) FFN_GATEUP();
        if (bx >= HB) {
            convert_plain(p.in[4], DFF, DM, (bf16_t*)(ws + WS_W1D), scr, hgw, hngw, lane);
            convert_plain(p.in[7], DM, INC, (bf16_t*)(ws + WS_WIN), scr, hgw, hngw, lane);
            convert_plain(p.in[24], DM, DM, (bf16_t*)(ws + WS_WOUT), scr, hgw, hngw, lane);
            convert_plain(p.in[21], SW, SW, (bf16_t*)(ws + WS_WGLU), scr, hgw, hngw, lane);
        } }
    SEAM(1);
    if (IN(2)) REP(2) FFN_DOWN();
    SEAM(2);
    if (IN(3)) REP(3) resid_rows(p.in[0], Y, SSQ, 32, p.in[5], 0.5f, p.out, p.in[6], XN, gw, ngw, lane);
    SEAM(3);
    if (IN(4)) REP(4) {
        pg8::Gemm g{XN, (const bf16_t*)(ws + WS_WIN), MT, INC, DM}; pg8::StaticOrder S; S.init(MT, INC, G, bx);
        pg8::EpiQKVU E{QKV, UG, 0.125f * 1.4426950408889634f};
        pg8::gemm_phase<pg8::EpiQKVU, pg8::StaticOrder, true, true>(ldsl, g, S, E);
    }
    SEAM(4);
    if (IN(5)) {
        float lam;
        { const float a = wave_sum(p.in[8][lane] * p.in[9][lane]), c = wave_sum(p.in[10][lane] * p.in[11][lane]); lam = expf(a) - expf(c) + 0.2f; }
        #ifndef ATT_REP
#define ATT_REP 1
#endif
        for (int u = vcu; u < ATT_REP * BATCH * 8 * 16; u += G) att::attn_unit(QKV, XN, (u >> 7) & 3, (u >> 4) & 7, u & 15, lam, p.in[12], (char*)lds);
#ifndef EST_REP
#define EST_REP 1
#endif
        for (int _r = 0; _r < EST_REP; ++_r) s5_estate(ws, gw, ngw, lane);
    }
    SEAM(5);
    if (IN(6)) { REP(6) s5_scan(ws, gw, ngw, lane);
        if (vcu >= 64) convert_gateup(p.in[27], p.in[28], ws, scr, (vcu - 64) * NWAVES + wave, (G - 64) * NWAVES, lane); }
    SEAM(6);
    if (IN(7)) REP(7) s5_output(ws, gw, ngw, lane);
    SEAM(7);
    if (IN(8)) REP(8) {
        pg8::Gemm g{GB, (const bf16_t*)(ws + WS_WGLU), MT, SW, SW}; pg8::StaticOrder S; S.init(MT, SW, G, bx);
        pg8::EpiGLU E{GB, SPRE, p.in[22], SSQ2};
        pg8::gemm_phase<pg8::EpiGLU, pg8::StaticOrder, true, true>(ldsl, g, S, E);
        if (bx >= HB) convert_plain(p.in[29], DFF, DM, (bf16_t*)(ws + WS_W1D), scr, hgw, hngw, lane);
    }
    SEAM(8);
    if (IN(9)) REP(9) snorm_rows(SPRE, SSQ2, p.in[23], XN, gw, ngw, lane);
    SEAM(9);
    if (IN(10)) REP(10) {
        pg8::Gemm g{XN, (const bf16_t*)(ws + WS_WOUT), MT, DM, DM}; pg8::StaticOrder S; S.init(MT, DM, G, bx);
        pg8::EpiYSsq E{Y, SSQ, 32};
        pg8::gemm_phase<pg8::EpiYSsq, pg8::StaticOrder, true, true>(ldsl, g, S, E);
    }
    SEAM(10);
    if (IN(11)) resid_rows(p.out, Y, SSQ, 32, p.in[25], 1.0f, p.out, p.in[26], XN, gw, ngw, lane);
    SEAM(11);
    if (IN(12)) FFN_GATEUP();
    SEAM(12);
    if (IN(13)) FFN_DOWN();
    SEAM(13);
    if (IN(14)) resid_rows(p.out, Y, SSQ, 32, p.in[30], 0.5f, p.out, nullptr, nullptr, gw, ngw, lane);
#undef IN
#undef SEAM
}

extern "C" void kernel_launch(void* const* d_in, const int* in_sizes, int n_in, void* d_out, int out_size, void* d_ws, size_t ws_size, hipStream_t stream) {
    static int grid = 0;
    if (grid == 0) {
        if (n_in != 31 || in_sizes[0] != MT * DM || out_size != MT * DM || ws_size < WS_END) {
            fprintf(stderr, "kernel_launch: shape/workspace mismatch: n_in %d in0 %d out %d ws %zu (need %zu)\n", n_in, n_in > 0 ? in_sizes[0] : -1, out_size, ws_size, (size_t)WS_END); grid = -1; return; }
        int dev = 0, cus = 0, per_cu = 0;
        hipGetDevice(&dev); hipDeviceGetAttribute(&cus, hipDeviceAttributeMultiprocessorCount, dev);
        if (hipFuncSetAttribute((const void*)fwd_megakernel, hipFuncAttributeMaxDynamicSharedMemorySize, LDS_BYTES) != hipSuccess) { fprintf(stderr, "kernel_launch: hipFuncSetAttribute failed\n"); grid = -1; return; }
        if (hipOccupancyMaxActiveBlocksPerMultiprocessor(&per_cu, (const void*)fwd_megakernel, NWAVES * 64, LDS_BYTES) != hipSuccess || per_cu < 1) { fprintf(stderr, "kernel_launch: occupancy query says %d\n", per_cu); (void)hipGetLastError(); per_cu = 1; }
        grid = cus;
        fprintf(stderr, "kernel_launch: grid %d (cus %d x per_cu %d), ws %zu need %zu\n", grid, cus, per_cu, ws_size, (size_t)WS_END);
    }
    if (grid < 0) return;
    if (hipMemsetAsync((char*)d_ws + WS_CTL, 0, CTL_BYTES, stream) != hipSuccess) { fprintf(stderr, "kernel_launch: memset failed\n"); return; }
    Params p{};
    for (int i = 0; i < 31; ++i) p.in[i] = (const float*)d_in[i];
    p.out = (float*)d_out; p.ws = (unsigned char*)d_ws;
#if MK_N_LAUNCHES == 1
    p.ph_lo = 0; p.ph_hi = 15;
    void* args[] = {&p};
    hipError_t e = hipLaunchCooperativeKernel((const void*)fwd_megakernel, dim3(grid), dim3(NWAVES * 64), args, LDS_BYTES, stream);
    if (e != hipSuccess) fprintf(stderr, "cooperative launch failed: %s (grid %d)\n", hipGetErrorString(e), grid);
#else
    for (int k = 0; k < 15; ++k) { p.ph_lo = k; p.ph_hi = k + 1; hipLaunchKernelGGL(fwd_megakernel, dim3(grid), dim3(NWAVES * 64), LDS_BYTES, stream, p); }
#endif
}
```

```cpp
#include <hip/hip_runtime.h>
#include <hip/hip_cooperative_groups.h>
#include <cstdio>
#include <cstdint>
namespace cg = cooperative_groups;
#ifndef MK_N_LAUNCHES
#define MK_N_LAUNCHES 1
#endif
namespace pg8 {
#define PG8_LAS __attribute__((address_space(3)))
typedef unsigned short bf16_t;
typedef short bf16x8 __attribute__((ext_vector_type(8)));
typedef float f32x4 __attribute__((ext_vector_type(4)));
typedef unsigned u32x4 __attribute__((ext_vector_type(4)));
constexpr int BM = 256, BK = 64, HALF = 128, HTB = HALF * BK * 2  , STAGE_BYTES = 8 * HTB, NXCD = 8, WGM = 8;

__host__ __device__ __forceinline__ int lds_byte(int r, int c) { const int st = (r >> 4) * 2 + (c >> 5), rr = r & 15, cc = c & 31, ob = rr * 64 + cc * 2; return st * 1024 + (ob ^ (((ob >> 9) & 1) << 5)); }
__host__ __device__ __forceinline__ void stage_rc(int b, int& R, int& C) { const int st = b / 1024, sb = b % 1024, swz = sb ^ (((sb >> 9) & 1) << 5); R = (st >> 1) * 16 + swz / 64; C = (st & 1) * 32 + (swz % 64) / 2; }
__host__ __device__ __forceinline__ int perm32(int rho) { const int n = rho >> 4, i = rho & 15; return 8 * (i >> 2) + 4 * n + (i & 3); }

struct Unit { int pm, pn; };
struct Gemm { const bf16_t* A; const bf16_t* Bt; int M, N, K; };

struct StaticOrder {
    int nM, nN, nwg, G, c;
    __host__ __device__ void init(int M, int N, int G_, int c_) { nM = M / BM; nN = N / BM; nwg = nM * nN; G = G_; c = c_; }
    __host__ __device__ bool next(int i, Unit& u) const {
        const long L = (long)i * G + c; if (L >= nwg) return false;
        int wgid = (int)L; { const int q = nwg / NXCD, r = nwg % NXCD, xcd = wgid % NXCD, off = wgid / NXCD; wgid = (xcd < r ? xcd * (q + 1) : r * (q + 1) + (xcd - r) * q) + off; }
        const int nig = WGM * nN, gid = wgid / nig, fm = gid * WGM, gsz = (nM - fm) < WGM ? (nM - fm) : WGM;
        u.pm = fm + ((wgid % nig) % gsz); u.pn = (wgid % nig) / gsz; return true;
    }
    __device__ __forceinline__ void a_ready(const Unit&) const {}
    __device__ __forceinline__ void done(const Unit&) const {}
};

__device__ __forceinline__ unsigned cvt_pk_bf16(float lo, float hi) { unsigned r; asm volatile("v_cvt_pk_bf16_f32 %0, %1, %2" : "=v"(r) : "v"(lo), "v"(hi)); return r; }
typedef unsigned u32x2 __attribute__((ext_vector_type(2)));
__device__ __forceinline__ float bf_lo(unsigned w) { return __uint_as_float(w << 16); }
__device__ __forceinline__ float bf_hi(unsigned w) { return __uint_as_float(w & 0xffff0000u); }
__device__ __forceinline__ float sigmoid_f(float z) { return __builtin_amdgcn_rcpf(1.0f + __builtin_amdgcn_exp2f(-1.4426950408889634f * z)); }
__device__ __forceinline__ float silu_f(float z) { return z * sigmoid_f(z); }

struct EpiSwiGLU {
    static constexpr bool PERM = true, AFTER_DRAIN = false;
    bf16_t* O; int ldc;
    __device__ __forceinline__ void operator()(const f32x4 (&acc)[2][2][4][2], const Unit& u, int wr, int wc, int fr, int fq) const {
        const int row0 = u.pm * BM + wr * 64 + fr, col0 = u.pn * HALF + wc * 32 + 8 * fq;
#pragma unroll
        for (int ai = 0; ai < 2; ++ai)
#pragma unroll
            for (int m = 0; m < 4; ++m) {
                bf16_t* rowp = O + (size_t)(row0 + ai * HALF + m * 16) * ldc + col0;
                const f32x4 g0 = acc[ai][0][m][0], g1 = acc[ai][0][m][1], u0 = acc[ai][1][m][0], u1 = acc[ai][1][m][1];
                u32x4 w;
                w.x = cvt_pk_bf16(silu_f(g0[0]) * u0[0], silu_f(g0[1]) * u0[1]); w.y = cvt_pk_bf16(silu_f(g0[2]) * u0[2], silu_f(g0[3]) * u0[3]);
                w.z = cvt_pk_bf16(silu_f(g1[0]) * u1[0], silu_f(g1[1]) * u1[1]); w.w = cvt_pk_bf16(silu_f(g1[2]) * u1[2], silu_f(g1[3]) * u1[3]);
                *(u32x4*)rowp = w;
            }
    }
};
struct EpiQKVU {
    static constexpr bool PERM = true, AFTER_DRAIN = false;
    bf16_t* QKV; bf16_t* UG; float qscale;
    __device__ __forceinline__ void operator()(const f32x4 (&acc)[2][2][4][2], const Unit& u, int wr, int wc, int fr, int fq) const {
        const int row0 = u.pm * BM + wr * 64 + fr, colt = u.pn * BM;
        const float sc = colt < 1024 ? qscale : 1.0f;
#pragma unroll
        for (int ai = 0; ai < 2; ++ai)
#pragma unroll
            for (int m = 0; m < 4; ++m) {
                const int row = row0 + ai * HALF + m * 16;
#pragma unroll
                for (int bj = 0; bj < 2; ++bj) {
                    const int col = colt + bj * HALF + wc * 32 + 8 * fq;
                    const f32x4 v0 = acc[ai][bj][m][0] * sc, v1 = acc[ai][bj][m][1] * sc;
                    u32x4 w; w.x = cvt_pk_bf16(v0[0], v0[1]); w.y = cvt_pk_bf16(v0[2], v0[3]); w.z = cvt_pk_bf16(v1[0], v1[1]); w.w = cvt_pk_bf16(v1[2], v1[3]);
                    bf16_t* dst;
                    if (colt < 3072) dst = QKV + (size_t)row * 3072 + col;
                    else { const int cc = col - 3072; dst = UG + ((size_t)((cc >> 4) * 512 + (row >> 4)) * 256 + (row & 15) * 16 + (cc & 15)); }
                    *(u32x4*)dst = w;
                }
            }
    }
};
struct EpiYSsq {
    static constexpr bool PERM = true, AFTER_DRAIN = false;
    bf16_t* Y; float* SSQ; int npart;
    __device__ __forceinline__ void operator()(const f32x4 (&acc)[2][2][4][2], const Unit& u, int wr, int wc, int fr, int fq) const {
        const int row0 = u.pm * BM + wr * 64 + fr, col0 = u.pn * BM + wc * 32 + 8 * fq;
#pragma unroll
        for (int ai = 0; ai < 2; ++ai)
#pragma unroll
            for (int m = 0; m < 4; ++m) {
                const int row = row0 + ai * HALF + m * 16; float s = 0.f;
#pragma unroll
                for (int bj = 0; bj < 2; ++bj) { const f32x4 v0 = acc[ai][bj][m][0], v1 = acc[ai][bj][m][1];
                    s += (v0[0] * v0[0] + v0[1] * v0[1]) + (v0[2] * v0[2] + v0[3] * v0[3]) + (v1[0] * v1[0] + v1[1] * v1[1]) + (v1[2] * v1[2] + v1[3] * v1[3]);
                    u32x4 w; w.x = cvt_pk_bf16(v0[0], v0[1]); w.y = cvt_pk_bf16(v0[2], v0[3]); w.z = cvt_pk_bf16(v1[0], v1[1]); w.w = cvt_pk_bf16(v1[2], v1[3]);
                    *(u32x4*)(Y + (size_t)row * 2048 + col0 + bj * HALF) = w; }
                s += __shfl_xor(s, 16); s += __shfl_xor(s, 32);
                if (fq == 0) SSQ[(size_t)row * npart + u.pn * 4 + wc] = s;
            }
    }
};
struct EpiGLU {
    static constexpr bool PERM = true, AFTER_DRAIN = false;
    const bf16_t* GB; bf16_t* SPRE; const float* bias; float* SSQ2;
    __device__ __forceinline__ void operator()(const f32x4 (&acc)[2][2][4][2], const Unit& u, int wr, int wc, int fr, int fq) const {
        const int row0 = u.pm * BM + wr * 64 + fr, colb = u.pn * BM + wc * 32 + 8 * fq;
#pragma unroll
        for (int ai = 0; ai < 2; ++ai)
#pragma unroll
            for (int m = 0; m < 4; ++m) {
                const int row = row0 + ai * HALF + m * 16; float s = 0.f;
#pragma unroll
                for (int bj = 0; bj < 2; ++bj) {
                    const int col = colb + bj * HALF;
                    const u32x4 gw = *(const u32x4*)(GB + (size_t)row * 1024 + col);
                    const f32x4 b0 = *(const f32x4*)(bias + col), b1 = *(const f32x4*)(bias + col + 4);
                    const f32x4 z0 = acc[ai][bj][m][0] + b0, z1 = acc[ai][bj][m][1] + b1;
                    float o[8];
                    o[0] = bf_lo(gw.x) * sigmoid_f(z0[0]); o[1] = bf_hi(gw.x) * sigmoid_f(z0[1]); o[2] = bf_lo(gw.y) * sigmoid_f(z0[2]); o[3] = bf_hi(gw.y) * sigmoid_f(z0[3]);
                    o[4] = bf_lo(gw.z) * sigmoid_f(z1[0]); o[5] = bf_hi(gw.z) * sigmoid_f(z1[1]); o[6] = bf_lo(gw.w) * sigmoid_f(z1[2]); o[7] = bf_hi(gw.w) * sigmoid_f(z1[3]);
#pragma unroll
                    for (int k = 0; k < 8; ++k) s += o[k] * o[k];
                    u32x4 w; w.x = cvt_pk_bf16(o[0], o[1]); w.y = cvt_pk_bf16(o[2], o[3]); w.z = cvt_pk_bf16(o[4], o[5]); w.w = cvt_pk_bf16(o[6], o[7]);
                    *(u32x4*)(SPRE + (size_t)row * 1024 + col) = w;
                }
                s += __shfl_xor(s, 16); s += __shfl_xor(s, 32);
                if (fq == 0) SSQ2[(size_t)row * 16 + u.pn * 4 + wc] = s;
            }
    }
};
template <class Epi, class Sched, bool ALIGN_EPI = false, bool SP2 = false>
__device__ __forceinline__ void gemm_phase(PG8_LAS unsigned char* lds, const Gemm g, const Sched& S, const Epi& E) {
    const int tid = threadIdx.x, wid = __builtin_amdgcn_readfirstlane(tid >> 6), lane = tid & 63, wr = wid >> 2, wc = wid & 3, fr = lane & 15, fq = lane >> 4;
    const int K = g.K, nt = K / BK;
    unsigned voffA[2], voffB[2];
#pragma unroll
    for (int i = 0; i < 2; ++i) { int R, C; stage_rc(tid * 16 + i * 8192, R, C); const int Rb = Epi::PERM ? ((R & ~31) + perm32(R & 31)) : R;
        voffA[i] = (unsigned)(R * K + C) * 2u; voffB[i] = (unsigned)(Rb * K + C) * 2u; }
    const size_t kstep = (size_t)(BK * 2);
    const size_t hstep = (size_t)HALF * K * 2;
    const size_t tstep = 2 * hstep;
    const unsigned ldsw = (unsigned)wid * 1024u;
    const int aoff = lds_byte(wr * 64 + fr, fq * 8), boff = lds_byte(wc * 32 + fr, fq * 8);
#define PG8_SA(b, h) (((b) * 2 + (h)) * HTB)
#define PG8_SB(b, h) ((4 + (b) * 2 + (h)) * HTB)
#define PG8_STAGE(bufoff, gbase, voff) do { _Pragma("unroll") for (int _i = 0; _i < 2; ++_i) \
        __builtin_amdgcn_global_load_lds((const unsigned*)((const char*)(gbase) + (voff)[_i]), (PG8_LAS unsigned*)(lds + (bufoff) + ldsw + _i * 8192), 16, 0, 0); } while (0)
#define PG8_LDA(dst, b, h) do { _Pragma("unroll") for (int m = 0; m < 4; ++m) _Pragma("unroll") for (int k = 0; k < 2; ++k) dst[m][k] = *(const PG8_LAS bf16x8*)(lds + PG8_SA(b, h) + aoff + m * 2048 + k * 1024); } while (0)
#define PG8_LDB(dst, b, h) do { _Pragma("unroll") for (int n = 0; n < 2; ++n) _Pragma("unroll") for (int k = 0; k < 2; ++k) dst[n][k] = *(const PG8_LAS bf16x8*)(lds + PG8_SB(b, h) + boff + n * 2048 + k * 1024); } while (0)
#define PG8_MMA(ai, bj, At, Bt) do { __builtin_amdgcn_s_setprio(1); _Pragma("unroll") for (int m = 0; m < 4; ++m) _Pragma("unroll") for (int n = 0; n < 2; ++n) _Pragma("unroll") for (int k = 0; k < 2; ++k) \
        acc[ai][bj][m][n] = __builtin_amdgcn_mfma_f32_16x16x32_bf16(Bt[n][k], At[m][k], acc[ai][bj][m][n], 0, 0, 0); __builtin_amdgcn_s_setprio(0); } while (0)
#define PG8_WAIT_V(n) asm volatile("s_waitcnt vmcnt(" #n ")" ::: "memory")
#define PG8_WAIT_L(n) asm volatile("s_waitcnt lgkmcnt(" #n ")" ::: "memory")
#define PG8_BAR __builtin_amdgcn_s_barrier()
#define PG8_SCHED __builtin_amdgcn_sched_barrier(0)
    Unit cur, nxt; int ui = 0;
    if (!S.next(0, cur)) return;
    f32x4 acc[2][2][4][2];
#pragma unroll
    for (int a = 0; a < 2; ++a)
#pragma unroll
        for (int b = 0; b < 2; ++b)
#pragma unroll
            for (int m = 0; m < 4; ++m)
#pragma unroll
                for (int n = 0; n < 2; ++n) acc[a][b][m][n] = (f32x4){0.f, 0.f, 0.f, 0.f};
    bf16x8 At[4][2], B0[2][2], B1[2][2];
    const char* cA = (const char*)g.A + (size_t)cur.pm * tstep; const char* cB = (const char*)g.Bt + (size_t)cur.pn * tstep;
    S.a_ready(cur);
    if constexpr (SP2) {
        PG8_STAGE(PG8_SB(0, 0), cB, voffB); PG8_STAGE(PG8_SB(0, 1), cB + hstep, voffB); PG8_STAGE(PG8_SA(0, 0), cA, voffA); PG8_STAGE(PG8_SA(0, 1), cA + hstep, voffA);
        if (wr == 1) PG8_BAR;
        PG8_WAIT_V(2); PG8_BAR;
        PG8_STAGE(PG8_SB(1, 0), cB + kstep, voffB); PG8_STAGE(PG8_SA(1, 0), cA + kstep, voffA); PG8_STAGE(PG8_SB(1, 1), cB + hstep + kstep, voffB);
        PG8_WAIT_V(6); PG8_BAR;
    } else {
        PG8_STAGE(PG8_SB(0, 0), cB, voffB); PG8_STAGE(PG8_SA(0, 0), cA, voffA); PG8_STAGE(PG8_SB(0, 1), cB + hstep, voffB); PG8_STAGE(PG8_SA(0, 1), cA + hstep, voffA);
        if (wr == 1) PG8_BAR;
        PG8_WAIT_V(4); PG8_BAR;
        PG8_STAGE(PG8_SB(1, 0), cB + kstep, voffB); PG8_STAGE(PG8_SA(1, 0), cA + kstep, voffA); PG8_STAGE(PG8_SB(1, 1), cB + hstep + kstep, voffB);
        PG8_WAIT_V(6); PG8_BAR;
    }
    for (;;) {
        const bool has_next = S.next(ui + 1, nxt);
        const char* nA = has_next ? (const char*)g.A + (size_t)nxt.pm * tstep : cA; const char* nB = has_next ? (const char*)g.Bt + (size_t)nxt.pn * tstep : cB;
        for (int t = 0; t < nt; t += 2) {
            const bool last = (t == nt - 2);
            const char* a1 = cA + (size_t)(t + 1) * kstep;
            const char* a2 = last ? nA : cA + (size_t)(t + 2) * kstep; const char* b2 = last ? nB : cB + (size_t)(t + 2) * kstep;
            const char* a3 = a2 + kstep; const char* b3 = b2 + kstep;
            if (last && has_next) S.a_ready(nxt);
            if constexpr (SP2) {
            PG8_LDB(B0, 0, 0); PG8_LDB(B1, 0, 1); PG8_SCHED; PG8_LDA(At, 0, 0); PG8_STAGE(PG8_SA(1, 1), a1 + hstep, voffA);
            PG8_WAIT_V(8); PG8_WAIT_L(0); PG8_BAR; PG8_MMA(0, 0, At, B0); PG8_MMA(0, 1, At, B1); PG8_BAR; PG8_SCHED;
            PG8_LDA(At, 0, 1); PG8_STAGE(PG8_SB(0, 0), b2, voffB); PG8_STAGE(PG8_SB(0, 1), b2 + hstep, voffB); PG8_STAGE(PG8_SA(0, 0), a2, voffA);
            PG8_WAIT_V(8); PG8_WAIT_L(0); PG8_BAR; PG8_MMA(1, 0, At, B0); PG8_MMA(1, 1, At, B1); PG8_BAR; PG8_SCHED;
            PG8_LDB(B0, 1, 0); PG8_LDB(B1, 1, 1); PG8_SCHED; PG8_LDA(At, 1, 0); PG8_STAGE(PG8_SA(0, 1), a2 + hstep, voffA);
            PG8_WAIT_V(8); PG8_WAIT_L(0); PG8_BAR; PG8_MMA(0, 0, At, B0); PG8_MMA(0, 1, At, B1); PG8_BAR; PG8_SCHED;
            PG8_LDA(At, 1, 1); PG8_STAGE(PG8_SB(1, 0), b3, voffB); PG8_STAGE(PG8_SB(1, 1), b3 + hstep, voffB); PG8_STAGE(PG8_SA(1, 0), a3, voffA);
            PG8_WAIT_V(8); PG8_WAIT_L(0); PG8_BAR; PG8_MMA(1, 0, At, B0); PG8_MMA(1, 1, At, B1); PG8_BAR; PG8_SCHED;
            } else {
            PG8_LDB(B0, 0, 0); PG8_SCHED; PG8_LDA(At, 0, 0); PG8_STAGE(PG8_SA(1, 1), a1 + hstep, voffA);
            PG8_WAIT_L(8); PG8_BAR; PG8_WAIT_L(0); PG8_MMA(0, 0, At, B0); PG8_BAR; PG8_SCHED;
            PG8_LDB(B1, 0, 1); PG8_STAGE(PG8_SB(0, 0), b2, voffB);
            PG8_BAR; PG8_WAIT_L(0); PG8_MMA(0, 1, At, B1); PG8_BAR;
            PG8_LDA(At, 0, 1); PG8_STAGE(PG8_SA(0, 0), a2, voffA);
            PG8_BAR; PG8_WAIT_L(0); PG8_MMA(1, 0, At, B0); PG8_BAR; PG8_SCHED;
            PG8_STAGE(PG8_SB(0, 1), b2 + hstep, voffB);
            PG8_WAIT_V(6); PG8_BAR; PG8_MMA(1, 1, At, B1); PG8_BAR;
            PG8_LDB(B0, 1, 0); PG8_SCHED; PG8_LDA(At, 1, 0); PG8_STAGE(PG8_SA(0, 1), a2 + hstep, voffA);
            PG8_WAIT_L(8); PG8_BAR; PG8_WAIT_L(0); PG8_MMA(0, 0, At, B0); PG8_BAR; PG8_SCHED;
            PG8_LDB(B1, 1, 1); PG8_STAGE(PG8_SB(1, 0), b3, voffB);
            PG8_BAR; PG8_WAIT_L(0); PG8_MMA(0, 1, At, B1); PG8_BAR;
            PG8_LDA(At, 1, 1); PG8_STAGE(PG8_SA(1, 0), a3, voffA);
            PG8_BAR; PG8_WAIT_L(0); PG8_MMA(1, 0, At, B0); PG8_BAR; PG8_SCHED;
            PG8_STAGE(PG8_SB(1, 1), b3 + hstep, voffB);
            PG8_WAIT_V(6); PG8_BAR; PG8_MMA(1, 1, At, B1); PG8_BAR;
            }
        }
        if constexpr (ALIGN_EPI) { if (wr == 0) PG8_BAR; }
        if constexpr (!Epi::AFTER_DRAIN) { E(acc, cur, wr, wc, fr, fq); S.done(cur); }
        if (!has_next) break;
#pragma unroll
        for (int a = 0; a < 2; ++a)
#pragma unroll
            for (int b = 0; b < 2; ++b)
#pragma unroll
                for (int m = 0; m < 4; ++m)
#pragma unroll
                    for (int n = 0; n < 2; ++n) acc[a][b][m][n] = (f32x4){0.f, 0.f, 0.f, 0.f};
        cur = nxt; cA = nA; cB = nB; ++ui;
        if constexpr (ALIGN_EPI) { if (wr == 1) PG8_BAR; }
    }
    PG8_WAIT_V(0);
    if constexpr (!ALIGN_EPI) { if (wr == 0) PG8_BAR; }
    PG8_BAR;
    if constexpr (Epi::AFTER_DRAIN) { E.fused(acc, cur, wr, wc, fr, fq, lds, wid, lane); S.done(cur); }
#undef PG8_SA
#undef PG8_SB
#undef PG8_STAGE
#undef PG8_LDA
#undef PG8_LDB
#undef PG8_MMA
#undef PG8_WAIT_V
#undef PG8_WAIT_L
#undef PG8_BAR
#undef PG8_SCHED
}
}
namespace att {
typedef short bf16x8 __attribute__((ext_vector_type(8)));
typedef short s16x4 __attribute__((ext_vector_type(4)));
typedef float f32x16 __attribute__((ext_vector_type(16)));
typedef float f32x4 __attribute__((ext_vector_type(4)));
typedef unsigned u32x4 __attribute__((ext_vector_type(4)));
typedef unsigned short bf16_t;
constexpr int KVBLK = 64, LDK = 3072, NT = 2048 / KVBLK;
constexpr int SHM_V = KVBLK * 128 * 2, SHM_K = KVBLK * 128 * 2;
constexpr int WS_OFF = 131072;
constexpr float THRL = 11.5f;
#ifndef ATT_SDEPTH
#define ATT_SDEPTH 1
#endif
constexpr int SDEPTH = ATT_SDEPTH;
#define KSWZ(row, colB) ((row) * 256 + ((colB) ^ (((row) & 7) << 4)))
#define SBAR() __builtin_amdgcn_sched_barrier(0)
__device__ __forceinline__ int crow(int r, int hi) { return (r & 3) + 8 * (r >> 2) + 4 * hi; }
__device__ __forceinline__ unsigned cvtpk(float lo, float hi) { unsigned r; asm volatile("v_cvt_pk_bf16_f32 %0, %1, %2" : "=v"(r) : "v"(lo), "v"(hi)); return r; }

__device__ __forceinline__ void partialSM(f32x16& p0, f32x16& p1, float& m_reg, float& mn, float& alpha) {
  float pmax = p0[0];
#pragma unroll
  for (int r = 1; r < 16; ++r) pmax = fmaxf(pmax, p0[r]);
#pragma unroll
  for (int r = 0; r < 16; ++r) pmax = fmaxf(pmax, p1[r]);
  { auto rr = __builtin_amdgcn_permlane32_swap(__float_as_uint(pmax), __float_as_uint(pmax), false, false);
    pmax = fmaxf(__uint_as_float(rr[0]), __uint_as_float(rr[1])); }
  if (__builtin_expect(__all(pmax - m_reg <= THRL), 1)) { mn = m_reg; alpha = 1.f; }
  else { mn = fmaxf(m_reg, pmax); alpha = __builtin_amdgcn_exp2f(m_reg - mn); m_reg = mn; }
#pragma unroll
  for (int r = 0; r < 16; ++r) p0[r] = p0[r] - mn;
#pragma unroll
  for (int r = 0; r < 16; ++r) p1[r] = p1[r] - mn;
#pragma unroll
  for (int r = 0; r < 16; ++r) p0[r] = __builtin_amdgcn_exp2f(p0[r]);
}
__device__ __forceinline__ void finishSM(f32x16& p0, f32x16& p1, float alpha, float& l_reg, bf16x8& pa0, bf16x8& pa1, bf16x8& pa2, bf16x8& pa3) {
#pragma unroll
  for (int r = 0; r < 16; ++r) p1[r] = __builtin_amdgcn_exp2f(p1[r]);
  float ps = 0;
#pragma unroll
  for (int r = 0; r < 16; ++r) ps += p0[r];
#pragma unroll
  for (int r = 0; r < 16; ++r) ps += p1[r];
  { auto rr = __builtin_amdgcn_permlane32_swap(__float_as_uint(ps), __float_as_uint(ps), false, false);
    ps = __uint_as_float(rr[0]) + __uint_as_float(rr[1]); }
  l_reg = l_reg * alpha + ps;
#define PK4(P, BASE, OUT) do { unsigned a0 = cvtpk(P[BASE + 0], P[BASE + 1]), a1 = cvtpk(P[BASE + 2], P[BASE + 3]);   \
    unsigned b0 = cvtpk(P[BASE + 4], P[BASE + 5]), b1 = cvtpk(P[BASE + 6], P[BASE + 7]);                              \
    auto r0 = __builtin_amdgcn_permlane32_swap(a0, b0, false, false); auto r1 = __builtin_amdgcn_permlane32_swap(a1, b1, false, false); \
    u32x4 w = {r0[0], r1[0], r0[1], r1[1]}; OUT = *reinterpret_cast<bf16x8*>(&w); } while (0)
  PK4(p0, 0, pa0); PK4(p0, 8, pa1); PK4(p1, 0, pa2); PK4(p1, 8, pa3);
#undef PK4
}
__device__ __forceinline__ void qkt(f32x16& p0, f32x16& p1, const char* Ks, const char* qr, int r32, int hi, int cofs, float dq, float nsl) {
#pragma unroll
  for (int r = 0; r < 16; ++r) { const float cr = (float)((r & 3) + 8 * (r >> 2)); p0[r] = nsl * __builtin_fabsf(dq - cr); p1[r] = nsl * __builtin_fabsf(dq - (32.f + cr)); }
#pragma unroll
  for (int d0 = 0; d0 < 4; ++d0) { const int cb = cofs + d0 * 32 + hi * 16;
    bf16x8 b0 = *reinterpret_cast<const bf16x8*>(Ks + KSWZ(r32, cb));
    bf16x8 b1 = *reinterpret_cast<const bf16x8*>(Ks + KSWZ(32 + r32, cb));
    const bf16x8 qf = *reinterpret_cast<const bf16x8*>(qr + d0 * 1024);
    p0 = __builtin_amdgcn_mfma_f32_32x32x16_bf16(b0, qf, p0, 0, 0, 0);
    p1 = __builtin_amdgcn_mfma_f32_32x32x16_bf16(b1, qf, p1, 0, 0, 0); }
}
__device__ __forceinline__ int v_st(int k, int c) { const int kk = (k & ~0xC) | ((k & 4) << 1) | ((k & 8) >> 1); return ((kk >> 3) * 4 + (c >> 5)) * 512 + ((kk & 7) * 32 + (c & 31)) * 2; }
__device__ __forceinline__ int v_rd_base(int lane) { return ((lane & 3) << 3) | (((lane >> 2) & 3) << 6) | (((lane >> 4) & 1) << 5) | (((lane >> 5) & 1) << 8); }
constexpr int v_rd_off(int d0, int ks, int half) { return d0 * 512 + ks * 4096 + half * 2048; }
template <int OFF> __device__ __forceinline__ s16x4 tr_read(int vb) {
  s16x4 r; asm volatile("ds_read_b64_tr_b16 %0, %1 offset:%2" : "=&v"(r) : "v"(vb), "i"(OFF) : "memory"); return r;
}
template <int D0> __device__ __forceinline__ void pv_one(f32x16& od, int vb, bf16x8 pa0, bf16x8 pa1, bf16x8 pa2, bf16x8 pa3) {
  const s16x4 l0 = tr_read<v_rd_off(D0, 0, 0)>(vb), h0 = tr_read<v_rd_off(D0, 0, 1)>(vb), l1 = tr_read<v_rd_off(D0, 1, 0)>(vb), h1 = tr_read<v_rd_off(D0, 1, 1)>(vb);
  const s16x4 l2 = tr_read<v_rd_off(D0, 2, 0)>(vb), h2 = tr_read<v_rd_off(D0, 2, 1)>(vb), l3 = tr_read<v_rd_off(D0, 3, 0)>(vb), h3 = tr_read<v_rd_off(D0, 3, 1)>(vb);
  asm volatile("s_waitcnt lgkmcnt(0)" ::: "memory"); SBAR();
#define PK(L, H) (bf16x8){L[0], L[1], L[2], L[3], H[0], H[1], H[2], H[3]}
  od = __builtin_amdgcn_mfma_f32_32x32x16_bf16(pa0, PK(l0, h0), od, 0, 0, 0);
  od = __builtin_amdgcn_mfma_f32_32x32x16_bf16(pa1, PK(l1, h1), od, 0, 0, 0);
  od = __builtin_amdgcn_mfma_f32_32x32x16_bf16(pa2, PK(l2, h2), od, 0, 0, 0);
  od = __builtin_amdgcn_mfma_f32_32x32x16_bf16(pa3, PK(l3, h3), od, 0, 0, 0);
#undef PK
}
__device__ __forceinline__ void pv_d0(f32x16* o, int vb, bf16x8 pa0, bf16x8 pa1, bf16x8 pa2, bf16x8 pa3) {
  pv_one<0>(o[0], vb, pa0, pa1, pa2, pa3); pv_one<1>(o[1], vb, pa0, pa1, pa2, pa3); pv_one<2>(o[2], vb, pa0, pa1, pa2, pa3); pv_one<3>(o[3], vb, pa0, pa1, pa2, pa3);
}

__device__ __forceinline__ void attn_unit(const bf16_t* __restrict__ QKV, bf16_t* __restrict__ CAT, int b, int h, int qb, float lam, const float* __restrict__ head_g, char* lds) {
  const int tid = threadIdx.x, wid = tid >> 6, lane = tid & 63, r32 = lane & 31, hi = lane >> 5, cmap = wid >> 2, wq = wid & 3;
  char* V_lds = lds; char* K_lds = lds + 2 * SHM_V;
  float* ws = (float*)(lds + WS_OFF) + wid * 64; float* li_l = ws; float* al_l = ws + 32;
  float m_reg = -1e30f, l_reg = 0; f32x16 o[4] = {};
  char* qr = lds + 65536 + wid * 4096 + lane * 16;
  const bf16_t* Qw = QKV + (size_t)(b * 2048 + qb * 128 + wq * 32 + r32) * LDK + h * 128 + cmap * 64 + hi * 8;
#pragma unroll
  for (int d0 = 0; d0 < 4; ++d0) *reinterpret_cast<bf16x8*>(qr + d0 * 1024) = *reinterpret_cast<const bf16x8*>(Qw + d0 * 16);
  const bf16_t* Kh = QKV + (size_t)(b * 2048) * LDK + 1024 + h * 128;
  const bf16_t* Vh = QKV + (size_t)(b * 2048) * LDK + 2048 + h * 128;
  const float dqb = (float)(qb * 128 + wq * 32 + r32 - 4 * hi);
  const float nsl = -1.4426950408889634f * __builtin_amdgcn_exp2f(-(float)(h + 1));
  const int cofs = cmap * 128;
  const int sr = tid >> 4, sc = (tid & 15) * 8, vst0 = v_st(sr, sc), vst1 = v_st(32 + sr, sc);
  const int vb0 = (int)(uintptr_t)V_lds + v_rd_base(lane);
  struct { bf16x8 vs0, vs1, ks0, ks1; } sr_[SDEPTH];
#define SLOAD(i, k0) do { sr_[i].vs0 = *reinterpret_cast<const bf16x8*>(&Vh[(size_t)((k0) + sr) * LDK + sc]); sr_[i].vs1 = *reinterpret_cast<const bf16x8*>(&Vh[(size_t)((k0) + 32 + sr) * LDK + sc]); \
    sr_[i].ks0 = *reinterpret_cast<const bf16x8*>(&Kh[(size_t)((k0) + sr) * LDK + sc]); sr_[i].ks1 = *reinterpret_cast<const bf16x8*>(&Kh[(size_t)((k0) + 32 + sr) * LDK + sc]); } while (0)
#define SWRITE(bb, i) do { *(bf16x8*)(V_lds + (bb) * SHM_V + vst0) = sr_[i].vs0;          \
    *(bf16x8*)(V_lds + (bb) * SHM_V + vst1) = sr_[i].vs1; int kc = sc * 2;               \
    *(bf16x8*)(K_lds + (bb) * SHM_K + KSWZ(sr, kc)) = sr_[i].ks0;                       \
    *(bf16x8*)(K_lds + (bb) * SHM_K + KSWZ(32 + sr, kc)) = sr_[i].ks1; } while (0)
#define SWAIT() do { if constexpr (SDEPTH == 2) asm volatile("s_waitcnt vmcnt(4)" ::: "memory"); else asm volatile("s_waitcnt vmcnt(0)" ::: "memory"); } while (0)
#define RESC(a) do { if (__any((a) < 1.f)) { if (hi == 0) al_l[r32] = (a); asm volatile("s_waitcnt lgkmcnt(0)" ::: "memory"); \
    _Pragma("unroll") for (int d = 0; d < 4; ++d) _Pragma("unroll") for (int r = 0; r < 16; ++r) o[d][r] *= al_l[crow(r, hi)]; } } while (0)
  f32x16 pA0, pA1, pB0, pB1; float mnA, mnB, alA, alB; bf16x8 pa0, pa1, pa2, pa3;
  constexpr int SE = 0, SO = SDEPTH - 1;
  SLOAD(SE, 0); asm volatile("s_waitcnt vmcnt(0)" ::: "memory"); SWRITE(0, SE); __syncthreads();
  qkt(pA0, pA1, K_lds, qr, r32, hi, cofs, dqb, nsl); partialSM(pA0, pA1, m_reg, mnA, alA);
  SLOAD(SO, KVBLK); if constexpr (SDEPTH == 2) SLOAD(SE, 2 * KVBLK);
  SWAIT(); SWRITE(1, SO); __syncthreads();
  for (int j = 1; j + 1 < NT; j += 2) {
    SBAR(); qkt(pB0, pB1, K_lds + SHM_K, qr, r32, hi, cofs, dqb - (float)(j * KVBLK), nsl);
    finishSM(pA0, pA1, alA, l_reg, pa0, pa1, pa2, pa3); SBAR();
    SLOAD(SO, (j + SDEPTH) * KVBLK); SBAR();
    pv_d0(o, vb0, pa0, pa1, pa2, pa3); partialSM(pB0, pB1, m_reg, mnB, alB);
    __syncthreads(); SWAIT(); SWRITE(0, SE);
    RESC(alB); __syncthreads();
    SBAR(); qkt(pA0, pA1, K_lds, qr, r32, hi, cofs, dqb - (float)((j + 1) * KVBLK), nsl);
    finishSM(pB0, pB1, alB, l_reg, pa0, pa1, pa2, pa3); SBAR();
    if (SDEPTH == 1 || j + 3 < NT) SLOAD(SE, (j + 1 + SDEPTH) * KVBLK); SBAR();
    pv_d0(o, vb0 + SHM_V, pa0, pa1, pa2, pa3); partialSM(pA0, pA1, m_reg, mnA, alA);
    __syncthreads(); SWAIT(); SWRITE(1, SO);
    RESC(alA); __syncthreads();
  }
  SBAR(); qkt(pB0, pB1, K_lds + SHM_K, qr, r32, hi, cofs, dqb - (float)((NT - 1) * KVBLK), nsl);
  finishSM(pA0, pA1, alA, l_reg, pa0, pa1, pa2, pa3); SBAR();
  pv_d0(o, vb0, pa0, pa1, pa2, pa3); partialSM(pB0, pB1, m_reg, mnB, alB);
  __syncthreads(); RESC(alB);
  finishSM(pB0, pB1, alB, l_reg, pa0, pa1, pa2, pa3); SBAR();
  pv_d0(o, vb0 + SHM_V, pa0, pa1, pa2, pa3);
  if (hi == 0) li_l[r32] = l_reg; asm volatile("s_waitcnt lgkmcnt(0)" ::: "memory");
  float rli[16];
#pragma unroll
  for (int r = 0; r < 16; ++r) rli[r] = __builtin_amdgcn_rcpf(li_l[crow(r, hi)]);
  __syncthreads();
  float* OB = (float*)lds + cmap * 16384 + (wq * 32) * 128;
#pragma unroll
  for (int r = 0; r < 16; ++r) { const int orow = crow(r, hi);
#pragma unroll
    for (int d0 = 0; d0 < 4; ++d0) OB[orow * 128 + d0 * 32 + r32] = o[d0][r] * rli[r]; }
  __syncthreads();
  { const int row = tid >> 2, qtr = tid & 3;
    const f32x4* o1 = (const f32x4*)((const float*)lds + row * 128 + qtr * 32); const f32x4* o2 = o1 + 4096;
    f32x4 v[8]; float ssq = 0.f;
#pragma unroll
    for (int k = 0; k < 8; ++k) { v[k] = o1[k] - lam * o2[k]; ssq += (v[k][0] * v[k][0] + v[k][1] * v[k][1]) + (v[k][2] * v[k][2] + v[k][3] * v[k][3]); }
    ssq += __shfl_xor(ssq, 1); ssq += __shfl_xor(ssq, 2);
    const float rs = rsqrtf(ssq * (1.0f / 128.0f) + 1e-6f) * 0.8f;
    bf16_t* dst = CAT + (size_t)(b * 2048 + qb * 128 + row) * 2048 + h * 128 + qtr * 32;
    const f32x4* hg = (const f32x4*)(head_g + qtr * 32);
#pragma unroll
    for (int k = 0; k < 8; k += 2) { const f32x4 g0 = hg[k], g1 = hg[k + 1]; const f32x4 a = v[k] * rs * g0, c = v[k + 1] * rs * g1;
      u32x4 w; w.x = cvtpk(a[0], a[1]); w.y = cvtpk(a[2], a[3]); w.z = cvtpk(c[0], c[1]); w.w = cvtpk(c[2], c[3]);
      *(u32x4*)(dst + k * 4) = w; }
  }
  __syncthreads();
#undef SLOAD
#undef SWRITE
#undef SWAIT
#undef RESC
}
#undef SBAR
}
#define LAS __attribute__((address_space(3)))
typedef unsigned short bf16_t;
typedef short bf16x8 __attribute__((ext_vector_type(8)));
typedef float f32x4 __attribute__((ext_vector_type(4)));
typedef float f32x16 __attribute__((ext_vector_type(16)));
typedef unsigned u32x4 __attribute__((ext_vector_type(4)));
typedef unsigned u32x2 __attribute__((ext_vector_type(2)));
constexpr int DM = 2048, BATCH = 4, SEQ = 2048, MT = BATCH * SEQ, DFF = 5632, NGU = 2 * DFF, INC = 4096, SW = 1024;
constexpr int SG = 64, CT = 16, NCH = SEQ / CT, NROW = BATCH * NCH;
constexpr float EPS = 1e-6f;
constexpr int NWAVES = 8, LDS_BYTES = 136 * 1024;
constexpr size_t al256(size_t x) { return (x + 255) / 256 * 256; }
constexpr size_t WS_W1G = 0;
constexpr size_t WS_W1D = WS_W1G + (size_t)NGU * DM * 2;
constexpr size_t WS_WIN = WS_W1D + (size_t)DM * DFF * 2;
constexpr size_t WS_WOUT = WS_WIN + (size_t)INC * DM * 2;
constexpr size_t WS_WGLU = WS_WOUT + (size_t)DM * DM * 2;
constexpr size_t WS_XN = WS_WGLU + (size_t)SW * SW * 2;
constexpr size_t WS_HFF = WS_XN + (size_t)MT * DM * 2;
constexpr size_t WS_QKV = WS_HFF, WS_UG = WS_QKV + (size_t)MT * 3072 * 2, WS_HIN = WS_UG + (size_t)SG * NROW * 256 * 2;
constexpr size_t WS_Y = WS_HFF + (size_t)MT * DFF * 2;
constexpr size_t WS_SLOC = WS_Y, WS_GB = WS_SLOC + (size_t)SG * NROW * 256 * 4, WS_SPRE = WS_GB + (size_t)MT * SW * 2;
constexpr size_t WS_SSQ = WS_Y + (size_t)MT * DM * 4;
constexpr size_t WS_SSQ2 = WS_SSQ + (size_t)MT * 32 * 4;
constexpr size_t WS_EMAT = WS_SSQ2 + (size_t)MT * 16 * 4;
constexpr size_t WS_MFT = WS_EMAT + (size_t)SG * 8 * 16 * 1024;
constexpr size_t WS_ATAB = WS_MFT + (size_t)SG * 8 * 32 * 1024;
constexpr size_t WS_CTL = WS_ATAB + (size_t)SG * 2 * 64 * 2 * 4;
constexpr size_t CTL_BYTES = 16384;
constexpr size_t WS_END = WS_CTL + CTL_BYTES;
constexpr int LDS_BARST = 133120;
static_assert(WS_HIN + (size_t)SG * NROW * 256 * 2 <= WS_Y && WS_SPRE + (size_t)MT * SW * 2 <= WS_SSQ, "overlays");

__device__ __forceinline__ unsigned cvtpk(float lo, float hi) { unsigned r; asm volatile("v_cvt_pk_bf16_f32 %0, %1, %2" : "=v"(r) : "v"(lo), "v"(hi)); return r; }
__device__ __forceinline__ float wave_sum(float v) {
#pragma unroll
    for (int o = 1; o < 64; o <<= 1) v += __shfl_xor(v, o);
    return v;
}
__device__ __forceinline__ float bf2f_lo(unsigned w) { return __uint_as_float(w << 16); }
__device__ __forceinline__ float bf2f_hi(unsigned w) { return __uint_as_float(w & 0xffff0000u); }

struct Params { const float* in[31]; float* out; unsigned char* ws; int ph_lo, ph_hi; };

__device__ __forceinline__ void transpose_item(const float* __restrict__ W, int K, int N, bf16_t* __restrict__ WT, int k0, int n0, int rowbase, LAS float* scr, int lane) {
    const int r0 = lane >> 3, c4 = (lane & 7) * 4;
    const float* src = W + (size_t)(k0 + r0) * N + n0 + c4;
    f32x4 v[8];
#pragma unroll
    for (int i = 0; i < 8; ++i) v[i] = *(const f32x4*)(src + (size_t)(8 * i) * N);
#pragma unroll
    for (int i = 0; i < 8; ++i) { LAS float* d = scr + (r0 + 8 * i) * 33 + c4; d[0] = v[i][0]; d[1] = v[i][1]; d[2] = v[i][2]; d[3] = v[i][3]; }
    asm volatile("s_waitcnt lgkmcnt(0)" ::: "memory");
    const int c = lane & 7;
#pragma unroll
    for (int j = 0; j < 4; ++j) { const int n = (lane >> 3) + 8 * j; const LAS float* s = scr + (8 * c) * 33 + n;
        u32x4 o; o.x = cvtpk(s[0 * 33], s[1 * 33]); o.y = cvtpk(s[2 * 33], s[3 * 33]); o.z = cvtpk(s[4 * 33], s[5 * 33]); o.w = cvtpk(s[6 * 33], s[7 * 33]);
        *(u32x4*)(WT + (size_t)(rowbase + n) * K + k0 + 8 * c) = o; }
    asm volatile("s_waitcnt lgkmcnt(0)" ::: "memory");
}
__device__ __forceinline__ void convert_gateup(const float* wg, const float* wu, unsigned char* ws, LAS float* scr, int gw, int ngw, int lane) {
    constexpr int IG = (DM / 64) * (DFF / 32);
    bf16_t* G = (bf16_t*)(ws + WS_W1G);
    for (int it = gw; it < 2 * IG; it += ngw) {
        int r = it; const int up = r >= IG; if (up) r -= IG; const int nb = r % (DFF / 32), kb = r / (DFF / 32), n0 = nb * 32;
        transpose_item(up ? wu : wg, DM, DFF, G, kb * 64, n0, (n0 >> 7) * 256 + (n0 & 127) + up * 128, scr, lane);
    }
}
__device__ __forceinline__ void convert_plain(const float* w, int K, int N, bf16_t* WT, LAS float* scr, int gw, int ngw, int lane) {
    const int items = (K / 64) * (N / 32);
    for (int r = gw; r < items; r += ngw) { const int nb = r % (N / 32), kb = r / (N / 32); transpose_item(w, K, N, WT, kb * 64, nb * 32, nb * 32, scr, lane); }
}
__device__ __forceinline__ void prenorm_rows(const float* __restrict__ X, const float* __restrict__ g, bf16_t* __restrict__ XN, int gw, int ngw, int lane) {
    for (int row = gw; row < MT; row += ngw) {
        const f32x4* xr = (const f32x4*)(X + (size_t)row * DM) + lane; f32x4 v[8]; float s = 0.f;
#pragma unroll
        for (int j = 0; j < 8; ++j) { v[j] = xr[64 * j]; s += (v[j][0] * v[j][0] + v[j][1] * v[j][1]) + (v[j][2] * v[j][2] + v[j][3] * v[j][3]); }
        const float rs = rsqrtf(wave_sum(s) * (1.0f / DM) + EPS);
        u32x2* o8 = (u32x2*)(XN + (size_t)row * DM) + lane;
#pragma unroll
        for (int j = 0; j < 8; ++j) { const f32x4 gg = ((const f32x4*)g)[lane + 64 * j]; u32x2 w; w.x = cvtpk(v[j][0] * rs * gg[0], v[j][1] * rs * gg[1]); w.y = cvtpk(v[j][2] * rs * gg[2], v[j][3] * rs * gg[3]); o8[64 * j] = w; }
    }
}
__device__ __forceinline__ void resid_rows(const float* SRC, const bf16_t* __restrict__ Y, const float* __restrict__ SSQ, int npart, const float* __restrict__ gpost, float coef,
                                           float* OUT, const float* __restrict__ gpre, bf16_t* XN, int gw, int ngw, int lane) {
    for (int row = gw; row < MT; row += ngw) {
        float s = lane < npart ? SSQ[(size_t)row * npart + lane] : 0.f;
        const float rs = rsqrtf(wave_sum(s) * (1.0f / DM) + EPS) * coef;
        const u32x2* yr = (const u32x2*)(Y + (size_t)row * DM) + lane; const f32x4* xr = (const f32x4*)(SRC + (size_t)row * DM) + lane; f32x4* orow = (f32x4*)(OUT + (size_t)row * DM) + lane;
        f32x4 v[8]; float s1 = 0.f;
#pragma unroll
        for (int j = 0; j < 8; ++j) { const f32x4 gg = ((const f32x4*)gpost)[lane + 64 * j]; const u32x2 yw = yr[64 * j]; const f32x4 yv = {bf2f_lo(yw.x), bf2f_hi(yw.x), bf2f_lo(yw.y), bf2f_hi(yw.y)}; v[j] = xr[64 * j] + yv * rs * gg; orow[64 * j] = v[j];
            s1 += (v[j][0] * v[j][0] + v[j][1] * v[j][1]) + (v[j][2] * v[j][2] + v[j][3] * v[j][3]); }
        if (XN) {
            const float r1 = rsqrtf(wave_sum(s1) * (1.0f / DM) + EPS);
            u32x2* o8 = (u32x2*)(XN + (size_t)row * DM) + lane;
#pragma unroll
            for (int j = 0; j < 8; ++j) { const f32x4 gg = ((const f32x4*)gpre)[lane + 64 * j]; u32x2 w; w.x = cvtpk(v[j][0] * r1 * gg[0], v[j][1] * r1 * gg[1]); w.y = cvtpk(v[j][2] * r1 * gg[2], v[j][3] * r1 * gg[3]); o8[64 * j] = w; }
        }
    }
}
__device__ __forceinline__ void snorm_rows(const bf16_t* __restrict__ SPRE, const float* __restrict__ SSQ2, const float* __restrict__ og, bf16_t* __restrict__ CAT, int gw, int ngw, int lane) {
    for (int row = gw; row < MT; row += ngw) {
        float s = lane < 16 ? SSQ2[(size_t)row * 16 + lane] : 0.f;
        const float rs = rsqrtf(wave_sum(s) * (1.0f / SW) + EPS);
#pragma unroll
        for (int j = 0; j < 2; ++j) { const int c8 = lane + 64 * j; const u32x4 w = *((const u32x4*)(SPRE + (size_t)row * SW) + c8);
            const f32x4 g0 = ((const f32x4*)og)[2 * c8], g1 = ((const f32x4*)og)[2 * c8 + 1]; u32x4 o;
            o.x = cvtpk(bf2f_lo(w.x) * rs * g0[0], bf2f_hi(w.x) * rs * g0[1]); o.y = cvtpk(bf2f_lo(w.y) * rs * g0[2], bf2f_hi(w.y) * rs * g0[3]);
            o.z = cvtpk(bf2f_lo(w.z) * rs * g1[0], bf2f_hi(w.z) * rs * g1[1]); o.w = cvtpk(bf2f_lo(w.w) * rs * g1[2], bf2f_hi(w.w) * rs * g1[3]);
            *((u32x4*)(CAT + (size_t)row * DM + SW) + c8) = o; }
    }
}

__device__ __forceinline__ void s5_tables(const Params& p, int g, float* L) {
    const int t = threadIdx.x;
    float* APOW = L; float* FF = APOW + 2 * 64 * 17 * 2; float* BB = FF + 2 * 64 * 2; float* CC = BB + 2 * 64 * 16 * 2; float* KL = CC + 2 * 16 * 64 * 2;
    unsigned char* ws = p.ws;
    __syncthreads();
    if (t < 128) {
        const int dir = t >> 6, n = t & 63, idx = (dir * SG + g) * 64 + n;
        const float lr = p.in[13][idx], li = p.in[14][idx], dt = expf(p.in[15][dir * SG + g]);
        const float mag = expf(lr * dt), ar = mag * cosf(li * dt), ai = mag * sinf(li * dt);
        const float den = lr * lr + li * li, nr = ar - 1.0f;
        FF[(dir * 64 + n) * 2] = (nr * lr + ai * li) / den; FF[(dir * 64 + n) * 2 + 1] = (ai * lr - nr * li) / den;
        float pr = 1.f, pi = 0.f;
        for (int k = 0; k <= 16; ++k) { APOW[((dir * 64 + n) * 17 + k) * 2] = pr; APOW[((dir * 64 + n) * 17 + k) * 2 + 1] = pi; const float qr = pr * ar - pi * ai, qi = pr * ai + pi * ar; pr = qr; pi = qi; }
        float* AT = (float*)(ws + WS_ATAB) + ((g * 2 + dir) * 64 + n) * 2;
        AT[0] = APOW[((dir * 64 + n) * 17 + 16) * 2]; AT[1] = APOW[((dir * 64 + n) * 17 + 16) * 2 + 1];
    }
    __syncthreads();
    for (int e = t; e < 2048; e += 512) {
        { const int dir = e >> 10, n = (e >> 4) & 63, q = e & 15; const size_t bi = ((size_t)(dir * SG + g) * 64 + n) * 16 + q;
          const float br = p.in[16][bi], bim = p.in[17][bi], fr = FF[(dir * 64 + n) * 2], fi = FF[(dir * 64 + n) * 2 + 1];
          BB[((dir * 64 + n) * 16 + q) * 2] = fr * br - fi * bim; BB[((dir * 64 + n) * 16 + q) * 2 + 1] = fr * bim + fi * br; }
        { const int dir = e >> 10, pp = (e >> 6) & 15, n = e & 63; const size_t ci = ((size_t)(dir * SG + g) * 16 + pp) * 64 + n;
          CC[((dir * 16 + pp) * 64 + n) * 2] = p.in[18][ci]; CC[((dir * 16 + pp) * 64 + n) * 2 + 1] = p.in[19][ci]; }
    }
    __syncthreads();
    for (int e = t; e < 8192; e += 512) {
        const int q = e & 15, pp = (e >> 4) & 15, l = (e >> 8) & 15, dir = e >> 12; float s = 0.f;
        for (int n = 0; n < 64; ++n) {
            const float cr = CC[((dir * 16 + pp) * 64 + n) * 2], ci = CC[((dir * 16 + pp) * 64 + n) * 2 + 1];
            const float ar = APOW[((dir * 64 + n) * 17 + l) * 2], ai = APOW[((dir * 64 + n) * 17 + l) * 2 + 1];
            const float wr = cr * ar - ci * ai, wi = cr * ai + ci * ar;
            s += wr * BB[((dir * 64 + n) * 16 + q) * 2] - wi * BB[((dir * 64 + n) * 16 + q) * 2 + 1];
        }
        KL[e] = s;
    }
    __syncthreads();
    for (int ch = t; ch < 8192; ch += 512) {
        const int lane = ch & 63, ks = (ch >> 6) & 15, nt = ch >> 10, np = nt * 32 + (lane & 31), dir = np >> 7, ri = (np >> 6) & 1, n = np & 63, q0 = (lane >> 5) * 8;
        const int pw = dir == 0 ? 15 - ks : ks;
        const float ar = APOW[((dir * 64 + n) * 17 + pw) * 2], ai = APOW[((dir * 64 + n) * 17 + pw) * 2 + 1];
        float z[8];
#pragma unroll
        for (int j = 0; j < 8; ++j) { const float br = BB[((dir * 64 + n) * 16 + q0 + j) * 2], bi = BB[((dir * 64 + n) * 16 + q0 + j) * 2 + 1]; z[j] = ri ? (ar * bi + ai * br) : (ar * br - ai * bi); }
        u32x4 o; o.x = cvtpk(z[0], z[1]); o.y = cvtpk(z[2], z[3]); o.z = cvtpk(z[4], z[5]); o.w = cvtpk(z[6], z[7]);
        *(u32x4*)(ws + WS_EMAT + ((size_t)((g * 8 + nt) * 16 + ks)) * 1024 + lane * 16) = o;
    }
    for (int ch = t; ch < 16384; ch += 512) {
        const int lane = ch & 63, ks = (ch >> 6) & 31, nt = ch >> 11, no = nt * 32 + (lane & 31), tau = no >> 4, pp = no & 15;
        float z[8];
        if (ks < 16) { const int sg = ks, q0 = (lane >> 5) * 8;
#pragma unroll
            for (int j = 0; j < 8; ++j) { const int q = q0 + j; float v = 0.f;
                if (sg <= tau) v += KL[((0 * 16 + (tau - sg)) * 16 + pp) * 16 + q];
                if (sg >= tau) v += KL[((1 * 16 + (sg - tau)) * 16 + pp) * 16 + q];
                if (sg == tau && pp == q) v += p.in[20][g * 16 + pp];
                z[j] = v; }
        } else { const int np0 = (ks - 16) * 16 + (lane >> 5) * 8, dir = np0 >> 7, ri = (np0 >> 6) & 1, n0 = np0 & 63, pw = dir == 0 ? tau + 1 : 16 - tau;
#pragma unroll
            for (int j = 0; j < 8; ++j) { const int n = n0 + j; const float cr = CC[((dir * 16 + pp) * 64 + n) * 2], ci = CC[((dir * 16 + pp) * 64 + n) * 2 + 1];
                const float ar = APOW[((dir * 64 + n) * 17 + pw) * 2], ai = APOW[((dir * 64 + n) * 17 + pw) * 2 + 1];
                z[j] = ri ? -(cr * ai + ci * ar) : (cr * ar - ci * ai); }
        }
        u32x4 o; o.x = cvtpk(z[0], z[1]); o.y = cvtpk(z[2], z[3]); o.z = cvtpk(z[4], z[5]); o.w = cvtpk(z[6], z[7]);
        *(u32x4*)(ws + WS_MFT + ((size_t)((g * 8 + nt) * 32 + ks)) * 1024 + lane * 16) = o;
    }
    __syncthreads();
}
__device__ __forceinline__ int crow16(int r, int hi) { return (r & 3) + 8 * (r >> 2) + 4 * hi; }
__device__ __forceinline__ void s5_estate(unsigned char* ws, int gw, int ngw, int lane) {
    for (int task = gw; task < SG * 16 * 2; task += ngw) {
        const int nh = task & 1, rt = (task >> 1) & 15, g = task >> 5, r32 = lane & 31, hi = lane >> 5;
        const bf16_t* A = (const bf16_t*)(ws + WS_UG) + ((size_t)(g * NROW + rt * 32 + r32)) * 256 + hi * 8;
        const unsigned char* B = ws + WS_EMAT + (size_t)(g * 8 + nh * 4) * 16 * 1024 + lane * 16;
        f32x16 acc[4] = {};
#pragma unroll 4
        for (int ks = 0; ks < 16; ++ks) { const bf16x8 a = *(const bf16x8*)(A + ks * 16);
#pragma unroll
            for (int nt = 0; nt < 4; ++nt) { const bf16x8 b = *(const bf16x8*)(B + (size_t)(nt * 16 + ks) * 1024); acc[nt] = __builtin_amdgcn_mfma_f32_32x32x16_bf16(a, b, acc[nt], 0, 0, 0); } }
        float* S = (float*)(ws + WS_SLOC) + ((size_t)(g * NROW + rt * 32)) * 256 + nh * 128 + r32;
#pragma unroll
        for (int nt = 0; nt < 4; ++nt)
#pragma unroll
            for (int r = 0; r < 16; ++r) S[(size_t)crow16(r, hi) * 256 + nt * 32] = acc[nt][r];
    }
}
__device__ __forceinline__ void s5_scan(unsigned char* ws, int gw, int ngw, int lane) {
    for (int task = gw; task < BATCH * SG * 2; task += ngw) {
        const int dir = task & 1, g = (task >> 1) & 63, b = task >> 7;
        const float* AT = (const float*)(ws + WS_ATAB) + ((g * 2 + dir) * 64 + lane) * 2; const float ar = AT[0], ai = AT[1];
        const float* S = (const float*)(ws + WS_SLOC) + ((size_t)(g * NROW + b * NCH)) * 256 + dir * 128 + lane;
        bf16_t* H = (bf16_t*)(ws + WS_HIN) + ((size_t)(g * NROW + b * NCH)) * 256 + dir * 128 + lane;
        float hr = 0.f, hi = 0.f;
        for (int c0 = 0; c0 < NCH; c0 += 16) {
            float sr[16], si[16];
#pragma unroll
            for (int k = 0; k < 16; ++k) { const int c = dir == 0 ? c0 + k : NCH - 1 - (c0 + k); sr[k] = S[(size_t)c * 256]; si[k] = S[(size_t)c * 256 + 64]; }
#pragma unroll
            for (int k = 0; k < 16; ++k) { const int c = dir == 0 ? c0 + k : NCH - 1 - (c0 + k);
                H[(size_t)c * 256] = (bf16_t)(cvtpk(hr, 0.f) & 0xffffu); H[(size_t)c * 256 + 64] = (bf16_t)(cvtpk(hi, 0.f) & 0xffffu);
                const float nr = ar * hr - ai * hi + sr[k], ni = ar * hi + ai * hr + si[k]; hr = nr; hi = ni; }
        }
    }
}
__device__ __forceinline__ void s5_output(unsigned char* ws, int gw, int ngw, int lane) {
    for (int task = gw; task < SG * 16 * 2; task += ngw) {
        const int nh = task & 1, rt = (task >> 1) & 15, g = task >> 5, r32 = lane & 31, hi = lane >> 5;
        const bf16_t* A0 = (const bf16_t*)(ws + WS_UG) + ((size_t)(g * NROW + rt * 32 + r32)) * 256 + hi * 8;
        const bf16_t* A1 = (const bf16_t*)(ws + WS_HIN) + ((size_t)(g * NROW + rt * 32 + r32)) * 256 + hi * 8;
        const unsigned char* B = ws + WS_MFT + (size_t)(g * 8 + nh * 4) * 32 * 1024 + lane * 16;
        f32x16 acc[4] = {};
#pragma unroll 4
        for (int ks = 0; ks < 16; ++ks) { const bf16x8 a = *(const bf16x8*)(A0 + ks * 16);
#pragma unroll
            for (int nt = 0; nt < 4; ++nt) { const bf16x8 b = *(const bf16x8*)(B + (size_t)(nt * 32 + ks) * 1024); acc[nt] = __builtin_amdgcn_mfma_f32_32x32x16_bf16(a, b, acc[nt], 0, 0, 0); } }
#pragma unroll 4
        for (int ks = 0; ks < 16; ++ks) { const bf16x8 a = *(const bf16x8*)(A1 + ks * 16);
#pragma unroll
            for (int nt = 0; nt < 4; ++nt) { const bf16x8 b = *(const bf16x8*)(B + (size_t)(nt * 32 + 16 + ks) * 1024); acc[nt] = __builtin_amdgcn_mfma_f32_32x32x16_bf16(a, b, acc[nt], 0, 0, 0); } }
        bf16_t* GBp = (bf16_t*)(ws + WS_GB);
#pragma unroll
        for (int nt = 0; nt < 4; ++nt) { const int no = nh * 128 + nt * 32 + r32, tau = no >> 4, pp = no & 15;
#pragma unroll
            for (int r = 0; r < 16; ++r) { const int crw = rt * 32 + crow16(r, hi); const float y = acc[nt][r];
                const float z2 = 1.5957691216057308f * (y + 0.044715f * y * y * y);
                const float gl = y * __builtin_amdgcn_rcpf(1.0f + __builtin_amdgcn_exp2f(-1.4426950408889634f * z2));
                GBp[(size_t)(crw * 16 + tau) * SW + g * 16 + pp] = (bf16_t)(cvtpk(gl, 0.f) & 0xffffu); } }
    }
}
#define XB_TMO      128
#define XB_XCNT(j)  (256  + 64 * (j))
#define XB_XSUB(j)  (1280 + 64 * (j))
#define XB_XGEN(j)  (2304 + 64 * (j))
#define XB_TOP      3328
#define XB_TOPGEN   3392
#define XCD_BAR_WORDS 3456
#define XB_SPIN_CAP (1u << 18)

__device__ __forceinline__ unsigned xb_ld(unsigned* p)              { return __hip_atomic_load(p, __ATOMIC_RELAXED, __HIP_MEMORY_SCOPE_AGENT); }
__device__ __forceinline__ unsigned xb_add(unsigned* p, unsigned v) { return __hip_atomic_fetch_add(p, v, __ATOMIC_RELAXED, __HIP_MEMORY_SCOPE_AGENT); }
__device__ __forceinline__ unsigned xb_xcc_id() { return (unsigned)__builtin_amdgcn_s_getreg((3 << 11) | 20) & 0xFu; }
#define XB_SPIN(cond, bar) do { unsigned _sp = 0; while (cond) { __builtin_amdgcn_s_sleep(1); \
    if ((++_sp & 255u) == 0u) { if (xb_ld(&(bar)[XB_TMO])) break; if (_sp > XB_SPIN_CAP) { atomicAdd(&(bar)[XB_TMO], 1u); break; } } } } while (0)

struct XcdBarrier {
    unsigned* bar; unsigned x;
    volatile LAS unsigned* st;
};

__device__ __forceinline__ XcdBarrier xcd_barrier_post(unsigned* bar, volatile LAS unsigned* st) {
    XcdBarrier b; b.bar = bar; b.x = xb_xcc_id(); b.st = st;
    if (threadIdx.x == 0) (void)xb_add(&bar[XB_XCNT(b.x)], 1u);
    return b;
}
__device__ __forceinline__ void xcd_barrier_complete(unsigned* bar, unsigned x, unsigned& nloc, unsigned& nx) {
    const unsigned G = gridDim.x * gridDim.y * gridDim.z;
    unsigned sum, cnt, mine, sp = 0u;
    for (;;) {
        sum = 0u; cnt = 0u; mine = 0u;
#pragma unroll
        for (unsigned j = 0; j < 16; ++j) { const unsigned c = xb_ld(&bar[XB_XCNT(j)]); sum += c; cnt += (c > 0u) ? 1u : 0u; mine = (j == x) ? c : mine; }
        if (sum == G) break;
        __builtin_amdgcn_s_sleep(1);
        if ((++sp & 255u) == 0u) { if (xb_ld(&bar[XB_TMO])) break; if (sp > XB_SPIN_CAP) { atomicAdd(&bar[XB_TMO], 1u); break; } }
    }
    nloc = mine > 0u ? mine : 1u; nx = cnt > 0u ? cnt : 1u;
}

__device__ __forceinline__ void xcd_barrier(const XcdBarrier& b) {
    asm volatile("s_waitcnt vmcnt(0)" ::: "memory");
    __syncthreads();
    if (threadIdx.x == 0) {
        unsigned* bar = b.bar;
        __builtin_amdgcn_s_waitcnt(0);
        unsigned nloc = b.st[0], nx = b.st[1];
        if (nloc == 0u) { xcd_barrier_complete(bar, b.x, nloc, nx); b.st[0] = nloc; b.st[1] = nx; }
        const unsigned old = xb_add(&bar[XB_XSUB(b.x)], 1u);
        const unsigned gen = old / nloc;
        if (old + 1u == (gen + 1u) * nloc) {
            __builtin_amdgcn_fence(__ATOMIC_RELEASE, "agent");
            asm volatile("s_waitcnt vmcnt(0)" ::: "memory");
            const unsigned og = xb_add(&bar[XB_TOP], 1u);
            const unsigned tg = og / nx;
            if (og + 1u == (tg + 1u) * nx) xb_add(&bar[XB_TOPGEN], 1u);
            else XB_SPIN(xb_ld(&bar[XB_TOPGEN]) == tg, bar);
            __builtin_amdgcn_fence(__ATOMIC_ACQUIRE, "agent");
            xb_add(&bar[XB_XGEN(b.x)], 1u);
            asm volatile("s_waitcnt vmcnt(0)" ::: "memory");
        } else {
            XB_SPIN(xb_ld(&bar[XB_XGEN(b.x)]) == gen, bar);
            __builtin_amdgcn_fence(__ATOMIC_ACQUIRE, "agent");
            asm volatile("s_waitcnt vmcnt(0)" ::: "memory");
        }
    }
    __syncthreads();
}

__global__ void __launch_bounds__(NWAVES * 64, 2) fwd_megakernel(Params p) {
    extern __shared__ __attribute__((aligned(16))) unsigned char lds[];
    cg::grid_group grid = cg::this_grid();
    const int tid = threadIdx.x, lane = tid & 63, wave = __builtin_amdgcn_readfirstlane(tid >> 6);
    const int G = gridDim.x, bx = blockIdx.x, vcu = (G % 8 == 0) ? (bx % 8) * (G / 8) + bx / 8 : bx;
    const int gw = vcu * NWAVES + wave, ngw = G * NWAVES;
    const int HB = G / 2, hgw = (bx - HB) * NWAVES + wave, hngw = (G - HB) * NWAVES;
    unsigned char* ws = p.ws;
    LAS unsigned char* ldsl = (LAS unsigned char*)lds;
    LAS float* scr = (LAS float*)(ldsl + wave * 8448);
    const int lo = p.ph_lo, hi = p.ph_hi;
    if (tid < 2) ((volatile LAS unsigned*)(ldsl + LDS_BARST))[tid] = 0u;
    __syncthreads();
    XcdBarrier bar = xcd_barrier_post((unsigned*)(ws + WS_CTL), (volatile LAS unsigned*)(ldsl + LDS_BARST));
    if (hi > 1000) grid.sync();
#ifndef PH_MASK
#define PH_MASK 0x7fff
#endif
#define IN(k) (((PH_MASK >> (k)) & 1) && lo <= (k) && (k) < hi)
#ifndef DBL_MASK
#define DBL_MASK 0
#endif
#define REP(k) for (int _rp = 0; _rp < 1 + ((DBL_MASK >> (k)) & 1); ++_rp)
#ifndef SYNC_REP
#define SYNC_REP 1
#endif
#define SEAM(k) do { if (IN(k) && IN((k) + 1)) { for (int _r = 0; _r < SYNC_REP; ++_r) xcd_barrier(bar); } } while (0)
    bf16_t* XN = (bf16_t*)(ws + WS_XN); bf16_t* HFF = (bf16_t*)(ws + WS_HFF); bf16_t* Y = (bf16_t*)(ws + WS_Y); float* SSQ = (float*)(ws + WS_SSQ); float* SSQ2 = (float*)(ws + WS_SSQ2);
    bf16_t* QKV = (bf16_t*)(ws + WS_QKV); bf16_t* UG = (bf16_t*)(ws + WS_UG); bf16_t* GB = (bf16_t*)(ws + WS_GB); bf16_t* SPRE = (bf16_t*)(ws + WS_SPRE);

    if (IN(0)) REP(0) {
        const int TB = G >= 128 ? G - 64 : G, NS = 2 * TB + (G - TB);
        for (int g = bx - TB; g >= 0 && g < SG; g += G - TB) s5_tables(p, g, (float*)lds);
        if (G < 128) for (int g = bx; g < SG; g += G) s5_tables(p, g, (float*)lds);
        const int nsl = bx < TB ? 2 : 1, sl0 = bx < TB ? 2 * bx : 2 * TB + (bx - TB);
        for (int sl = 0; sl < nsl; ++sl) {
            const int sgw = (sl0 + sl) * NWAVES + wave, sngw = NS * NWAVES;
            convert_gateup(p.in[2], p.in[3], ws, scr, sgw, sngw, lane);
            prenorm_rows(p.in[0], p.in[1], XN, sgw, sngw, lane);
            convert_plain(p.in[24], DM, DM, (bf16_t*)(ws + WS_WOUT), scr, sgw, sngw, lane);
            convert_plain(p.in[21], SW, SW, (bf16_t*)(ws + WS_WGLU), scr, sgw, sngw, lane);
        }
    }
    SEAM(0);
#define FFN_GATEUP() do { pg8::Gemm g{XN, (const bf16_t*)(ws + WS_W1G), MT, NGU, DM}; pg8::StaticOrder S; S.init(MT, NGU, G, bx); \
            pg8::EpiSwiGLU E{HFF, DFF}; pg8::gemm_phase<pg8::EpiSwiGLU, pg8::StaticOrder, true, true>(ldsl, g, S, E); } while (0)
#define FFN_DOWN() do { pg8::Gemm g{HFF, (const bf16_t*)(ws + WS_W1D), MT, DM, DFF}; pg8::StaticOrder S; S.init(MT, DM, G, bx); \
            pg8::EpiYSsq E{Y, SSQ, 32}; pg8::gemm_phase<pg8::EpiYSsq, pg8::StaticOrder, true, true>(ldsl, g, S, E); } while (0)
    if (IN(1)) { REP(1) FFN_GATEUP();
        if (bx >= HB) {
            convert_plain(p.in[4], DFF, DM, (bf16_t*)(ws + WS_W1D), scr, hgw, hngw, lane);
            convert_plain(p.in[7], DM, INC, (bf16_t*)(ws + WS_WIN), scr, hgw, hngw, lane);
        } }
    SEAM(1);
    if (IN(2)) REP(2) FFN_DOWN();
    SEAM(2);
    if (IN(3)) REP(3) resid_rows(p.in[0], Y, SSQ, 32, p.in[5], 0.5f, p.out, p.in[6], XN, gw, ngw, lane);
    SEAM(3);
    if (IN(4)) REP(4) {
        pg8::Gemm g{XN, (const bf16_t*)(ws + WS_WIN), MT, INC, DM}; pg8::StaticOrder S; S.init(MT, INC, G, bx);
        pg8::EpiQKVU E{QKV, UG, 0.125f * 1.4426950408889634f};
        pg8::gemm_phase<pg8::EpiQKVU, pg8::StaticOrder, true, true>(ldsl, g, S, E);
    }
    SEAM(4);
    if (IN(5)) {
        float lam;
        { const float a = wave_sum(p.in[8][lane] * p.in[9][lane]), c = wave_sum(p.in[10][lane] * p.in[11][lane]); lam = expf(a) - expf(c) + 0.2f; }
        #ifndef ATT_REP
#define ATT_REP 1
#endif
        for (int u = vcu; u < ATT_REP * BATCH * 8 * 16; u += G) att::attn_unit(QKV, XN, (u >> 7) & 3, (u >> 4) & 7, u & 15, lam, p.in[12], (char*)lds);
#ifndef EST_REP
#define EST_REP 1
#endif
        for (int _r = 0; _r < EST_REP; ++_r) s5_estate(ws, gw, ngw, lane);
    }
    SEAM(5);
    if (IN(6)) { REP(6) s5_scan(ws, gw, ngw, lane);
        if (vcu >= 64) convert_gateup(p.in[27], p.in[28], ws, scr, (vcu - 64) * NWAVES + wave, (G - 64) * NWAVES, lane); }
    SEAM(6);
    if (IN(7)) REP(7) s5_output(ws, gw, ngw, lane);
    SEAM(7);
    if (IN(8)) REP(8) {
        pg8::Gemm g{GB, (const bf16_t*)(ws + WS_WGLU), MT, SW, SW}; pg8::StaticOrder S; S.init(MT, SW, G, bx);
        pg8::EpiGLU E{GB, SPRE, p.in[22], SSQ2};
        pg8::gemm_phase<pg8::EpiGLU, pg8::StaticOrder, true, true>(ldsl, g, S, E);
        if (bx >= HB) convert_plain(p.in[29], DFF, DM, (bf16_t*)(ws + WS_W1D), scr, hgw, hngw, lane);
    }
    SEAM(8);
    if (IN(9)) REP(9) snorm_rows(SPRE, SSQ2, p.in[23], XN, gw, ngw, lane);
    SEAM(9);
    if (IN(10)) REP(10) {
        pg8::Gemm g{XN, (const bf16_t*)(ws + WS_WOUT), MT, DM, DM}; pg8::StaticOrder S; S.init(MT, DM, G, bx);
        pg8::EpiYSsq E{Y, SSQ, 32};
        pg8::gemm_phase<pg8::EpiYSsq, pg8::StaticOrder, true, true>(ldsl, g, S, E);
    }
    SEAM(10);
    if (IN(11)) resid_rows(p.out, Y, SSQ, 32, p.in[25], 1.0f, p.out, p.in[26], XN, gw, ngw, lane);
    SEAM(11);
    if (IN(12)) FFN_GATEUP();
    SEAM(12);
    if (IN(13)) FFN_DOWN();
    SEAM(13);
    if (IN(14)) resid_rows(p.out, Y, SSQ, 32, p.in[30], 0.5f, p.out, nullptr, nullptr, gw, ngw, lane);
#undef IN
#undef SEAM
}

extern "C" void kernel_launch(void* const* d_in, const int* in_sizes, int n_in, void* d_out, int out_size, void* d_ws, size_t ws_size, hipStream_t stream) {
    static int grid = 0;
    if (grid == 0) {
        if (n_in != 31 || in_sizes[0] != MT * DM || out_size != MT * DM || ws_size < WS_END) {
            fprintf(stderr, "kernel_launch: shape/workspace mismatch: n_in %d in0 %d out %d ws %zu (need %zu)\n", n_in, n_in > 0 ? in_sizes[0] : -1, out_size, ws_size, (size_t)WS_END); grid = -1; return; }
        int dev = 0, cus = 0, per_cu = 0;
        hipGetDevice(&dev); hipDeviceGetAttribute(&cus, hipDeviceAttributeMultiprocessorCount, dev);
        if (hipFuncSetAttribute((const void*)fwd_megakernel, hipFuncAttributeMaxDynamicSharedMemorySize, LDS_BYTES) != hipSuccess) { fprintf(stderr, "kernel_launch: hipFuncSetAttribute failed\n"); grid = -1; return; }
        if (hipOccupancyMaxActiveBlocksPerMultiprocessor(&per_cu, (const void*)fwd_megakernel, NWAVES * 64, LDS_BYTES) != hipSuccess || per_cu < 1) { fprintf(stderr, "kernel_launch: occupancy query says %d\n", per_cu); (void)hipGetLastError(); per_cu = 1; }
        grid = cus;
        fprintf(stderr, "kernel_launch: grid %d (cus %d x per_cu %d), ws %zu need %zu\n", grid, cus, per_cu, ws_size, (size_t)WS_END);
    }
    if (grid < 0) return;
    if (hipMemsetAsync((char*)d_ws + WS_CTL, 0, CTL_BYTES, stream) != hipSuccess) { fprintf(stderr, "kernel_launch: memset failed\n"); return; }
    Params p{};
    for (int i = 0; i < 31; ++i) p.in[i] = (const float*)d_in[i];
    p.out = (float*)d_out; p.ws = (unsigned char*)d_ws;
#if MK_N_LAUNCHES == 1
    p.ph_lo = 0; p.ph_hi = 15;
    void* args[] = {&p};
    hipError_t e = hipLaunchCooperativeKernel((const void*)fwd_megakernel, dim3(grid), dim3(NWAVES * 64), args, LDS_BYTES, stream);
    if (e != hipSuccess) fprintf(stderr, "cooperative launch failed: %s (grid %d)\n", hipGetErrorString(e), grid);
#else
    for (int k = 0; k < 15; ++k) { p.ph_lo = k; p.ph_hi = k + 1; hipLaunchKernelGGL(fwd_megakernel, dim3(grid), dim3(NWAVES * 64), LDS_BYTES, stream, p); }
#endif
}
```

```cpp
#include <hip/hip_runtime.h>
#include <hip/hip_cooperative_groups.h>
#include <cstdio>
#include <cstdint>
namespace cg = cooperative_groups;
#ifndef MK_N_LAUNCHES
#define MK_N_LAUNCHES 1
#endif
namespace pg8 {
#define PG8_LAS __attribute__((address_space(3)))
typedef unsigned short bf16_t;
typedef short bf16x8 __attribute__((ext_vector_type(8)));
typedef float f32x4 __attribute__((ext_vector_type(4)));
typedef unsigned u32x4 __attribute__((ext_vector_type(4)));
constexpr int BM = 256, BK = 64, HALF = 128, HTB = HALF * BK * 2  , STAGE_BYTES = 8 * HTB, NXCD = 8, WGM = 8;

__host__ __device__ __forceinline__ int lds_byte(int r, int c) { const int st = (r >> 4) * 2 + (c >> 5), rr = r & 15, cc = c & 31, ob = rr * 64 + cc * 2; return st * 1024 + (ob ^ (((ob >> 9) & 1) << 5)); }
__host__ __device__ __forceinline__ void stage_rc(int b, int& R, int& C) { const int st = b / 1024, sb = b % 1024, swz = sb ^ (((sb >> 9) & 1) << 5); R = (st >> 1) * 16 + swz / 64; C = (st & 1) * 32 + (swz % 64) / 2; }
__host__ __device__ __forceinline__ int perm32(int rho) { const int n = rho >> 4, i = rho & 15; return 8 * (i >> 2) + 4 * n + (i & 3); }

struct Unit { int pm, pn; };
struct Gemm { const bf16_t* A; const bf16_t* Bt; int M, N, K; };

struct StaticOrder {
    int nM, nN, nwg, G, c;
    __host__ __device__ void init(int M, int N, int G_, int c_) { nM = M / BM; nN = N / BM; nwg = nM * nN; G = G_; c = c_; }
    __host__ __device__ bool next(int i, Unit& u) const {
        const long L = (long)i * G + c; if (L >= nwg) return false;
        int wgid = (int)L; { const int q = nwg / NXCD, r = nwg % NXCD, xcd = wgid % NXCD, off = wgid / NXCD; wgid = (xcd < r ? xcd * (q + 1) : r * (q + 1) + (xcd - r) * q) + off; }
        const int nig = WGM * nN, gid = wgid / nig, fm = gid * WGM, gsz = (nM - fm) < WGM ? (nM - fm) : WGM;
        u.pm = fm + ((wgid % nig) % gsz); u.pn = (wgid % nig) / gsz; return true;
    }
    __device__ __forceinline__ void a_ready(const Unit&) const {}
    __device__ __forceinline__ void done(const Unit&) const {}
};

__device__ __forceinline__ unsigned cvt_pk_bf16(float lo, float hi) { unsigned r; asm volatile("v_cvt_pk_bf16_f32 %0, %1, %2" : "=v"(r) : "v"(lo), "v"(hi)); return r; }
typedef unsigned u32x2 __attribute__((ext_vector_type(2)));
__device__ __forceinline__ float bf_lo(unsigned w) { return __uint_as_float(w << 16); }
__device__ __forceinline__ float bf_hi(unsigned w) { return __uint_as_float(w & 0xffff0000u); }
__device__ __forceinline__ float sigmoid_f(float z) { return __builtin_amdgcn_rcpf(1.0f + __builtin_amdgcn_exp2f(-1.4426950408889634f * z)); }
__device__ __forceinline__ float silu_f(float z) { return z * sigmoid_f(z); }

struct EpiSwiGLU {
    static constexpr bool PERM = true, AFTER_DRAIN = false;
    bf16_t* O; int ldc; const float* RS;
    __device__ __forceinline__ void operator()(const f32x4 (&acc)[2][2][4][2], const Unit& u, int wr, int wc, int fr, int fq) const {
        const int row0 = u.pm * BM + wr * 64 + fr, col0 = u.pn * HALF + wc * 32 + 8 * fq;
#pragma unroll
        for (int ai = 0; ai < 2; ++ai)
#pragma unroll
            for (int m = 0; m < 4; ++m) {
                bf16_t* rowp = O + (size_t)(row0 + ai * HALF + m * 16) * ldc + col0;
                const float rr = RS[row0 + ai * HALF + m * 16];
                const f32x4 g0 = acc[ai][0][m][0] * rr, g1 = acc[ai][0][m][1] * rr, u0 = acc[ai][1][m][0] * rr, u1 = acc[ai][1][m][1] * rr;
                u32x4 w;
                w.x = cvt_pk_bf16(silu_f(g0[0]) * u0[0], silu_f(g0[1]) * u0[1]); w.y = cvt_pk_bf16(silu_f(g0[2]) * u0[2], silu_f(g0[3]) * u0[3]);
                w.z = cvt_pk_bf16(silu_f(g1[0]) * u1[0], silu_f(g1[1]) * u1[1]); w.w = cvt_pk_bf16(silu_f(g1[2]) * u1[2], silu_f(g1[3]) * u1[3]);
                *(u32x4*)rowp = w;
            }
    }
};
struct EpiQKVU {
    static constexpr bool PERM = true, AFTER_DRAIN = false;
    bf16_t* QKV; bf16_t* UG; float qscale; const float* RS;
    __device__ __forceinline__ void operator()(const f32x4 (&acc)[2][2][4][2], const Unit& u, int wr, int wc, int fr, int fq) const {
        const int row0 = u.pm * BM + wr * 64 + fr, colt = u.pn * BM;
        const float sc = colt < 1024 ? qscale : 1.0f;
#pragma unroll
        for (int ai = 0; ai < 2; ++ai)
#pragma unroll
            for (int m = 0; m < 4; ++m) {
                const int row = row0 + ai * HALF + m * 16; const float scr = sc * RS[row];
#pragma unroll
                for (int bj = 0; bj < 2; ++bj) {
                    const int col = colt + bj * HALF + wc * 32 + 8 * fq;
                    const f32x4 v0 = acc[ai][bj][m][0] * scr, v1 = acc[ai][bj][m][1] * scr;
                    u32x4 w; w.x = cvt_pk_bf16(v0[0], v0[1]); w.y = cvt_pk_bf16(v0[2], v0[3]); w.z = cvt_pk_bf16(v1[0], v1[1]); w.w = cvt_pk_bf16(v1[2], v1[3]);
                    bf16_t* dst;
                    if (colt < 3072) dst = QKV + (size_t)row * 3072 + col;
                    else { const int cc = col - 3072; dst = UG + ((size_t)((cc >> 4) * 512 + (row >> 4)) * 256 + (row & 15) * 16 + (cc & 15)); }
                    *(u32x4*)dst = w;
                }
            }
    }
};
struct EpiYSsq {
    static constexpr bool PERM = true, AFTER_DRAIN = false;
    bf16_t* Y; float* SSQ; int npart;
    __device__ __forceinline__ void operator()(const f32x4 (&acc)[2][2][4][2], const Unit& u, int wr, int wc, int fr, int fq) const {
        const int row0 = u.pm * BM + wr * 64 + fr, col0 = u.pn * BM + wc * 32 + 8 * fq;
#pragma unroll
        for (int ai = 0; ai < 2; ++ai)
#pragma unroll
            for (int m = 0; m < 4; ++m) {
                const int row = row0 + ai * HALF + m * 16; float s = 0.f;
#pragma unroll
                for (int bj = 0; bj < 2; ++bj) { const f32x4 v0 = acc[ai][bj][m][0], v1 = acc[ai][bj][m][1];
                    s += (v0[0] * v0[0] + v0[1] * v0[1]) + (v0[2] * v0[2] + v0[3] * v0[3]) + (v1[0] * v1[0] + v1[1] * v1[1]) + (v1[2] * v1[2] + v1[3] * v1[3]);
                    u32x4 w; w.x = cvt_pk_bf16(v0[0], v0[1]); w.y = cvt_pk_bf16(v0[2], v0[3]); w.z = cvt_pk_bf16(v1[0], v1[1]); w.w = cvt_pk_bf16(v1[2], v1[3]);
                    *(u32x4*)(Y + (size_t)row * 2048 + col0 + bj * HALF) = w; }
                s += __shfl_xor(s, 16); s += __shfl_xor(s, 32);
                if (fq == 0) SSQ[(size_t)row * npart + u.pn * 4 + wc] = s;
            }
    }
};
struct EpiPart {
    static constexpr bool PERM = true, AFTER_DRAIN = false;
    bf16_t* O;
    __device__ __forceinline__ void operator()(const f32x4 (&acc)[2][2][4][2], const Unit& u, int wr, int wc, int fr, int fq) const {
        const int row0 = u.pm * BM + wr * 64 + fr, col0 = u.pn * BM + wc * 32 + 8 * fq;
#pragma unroll
        for (int ai = 0; ai < 2; ++ai)
#pragma unroll
            for (int m = 0; m < 4; ++m)
#pragma unroll
                for (int bj = 0; bj < 2; ++bj) { const f32x4 v0 = acc[ai][bj][m][0], v1 = acc[ai][bj][m][1];
                    u32x4 w; w.x = cvt_pk_bf16(v0[0], v0[1]); w.y = cvt_pk_bf16(v0[2], v0[3]); w.z = cvt_pk_bf16(v1[0], v1[1]); w.w = cvt_pk_bf16(v1[2], v1[3]);
                    *(u32x4*)(O + (size_t)(row0 + ai * HALF + m * 16) * 2048 + col0 + bj * HALF) = w; }
    }
};
struct EpiYSsqAdd {
    static constexpr bool PERM = true, AFTER_DRAIN = false;
    bf16_t* Y; float* SSQ; const bf16_t* PART; const float* SSQ2;
    __device__ __forceinline__ void operator()(const f32x4 (&acc)[2][2][4][2], const Unit& u, int wr, int wc, int fr, int fq) const {
        const int row0 = u.pm * BM + wr * 64 + fr, col0 = u.pn * BM + wc * 32 + 8 * fq;
#pragma unroll
        for (int ai = 0; ai < 2; ++ai)
#pragma unroll
            for (int m = 0; m < 4; ++m) {
                const int row = row0 + ai * HALF + m * 16; float s = 0.f;
                const f32x4* q4 = (const f32x4*)(SSQ2 + (size_t)row * 16); const f32x4 q0 = q4[0], q1 = q4[1], q2 = q4[2], q3 = q4[3];
                const float rr = rsqrtf((((q0[0] + q0[1]) + (q0[2] + q0[3])) + ((q1[0] + q1[1]) + (q1[2] + q1[3])) + ((q2[0] + q2[1]) + (q2[2] + q2[3])) + ((q3[0] + q3[1]) + (q3[2] + q3[3]))) * (1.0f / 1024.0f) + 1e-6f);
#pragma unroll
                for (int bj = 0; bj < 2; ++bj) {
                    const u32x4 pw = *(const u32x4*)(PART + (size_t)row * 2048 + col0 + bj * HALF);
                    const f32x4 p0 = {bf_lo(pw.x), bf_hi(pw.x), bf_lo(pw.y), bf_hi(pw.y)}, p1 = {bf_lo(pw.z), bf_hi(pw.z), bf_lo(pw.w), bf_hi(pw.w)};
                    const f32x4 v0 = p0 + acc[ai][bj][m][0] * rr, v1 = p1 + acc[ai][bj][m][1] * rr;
                    s += (v0[0] * v0[0] + v0[1] * v0[1]) + (v0[2] * v0[2] + v0[3] * v0[3]) + (v1[0] * v1[0] + v1[1] * v1[1]) + (v1[2] * v1[2] + v1[3] * v1[3]);
                    u32x4 w; w.x = cvt_pk_bf16(v0[0], v0[1]); w.y = cvt_pk_bf16(v0[2], v0[3]); w.z = cvt_pk_bf16(v1[0], v1[1]); w.w = cvt_pk_bf16(v1[2], v1[3]);
                    *(u32x4*)(Y + (size_t)row * 2048 + col0 + bj * HALF) = w; }
                s += __shfl_xor(s, 16); s += __shfl_xor(s, 32);
                if (fq == 0) SSQ[(size_t)row * 32 + u.pn * 4 + wc] = s;
            }
    }
};
struct EpiGLU {
    static constexpr bool PERM = true, AFTER_DRAIN = false;
    const bf16_t* GB; bf16_t* SPRE; const float* bias; float* SSQ2;
    __device__ __forceinline__ void operator()(const f32x4 (&acc)[2][2][4][2], const Unit& u, int wr, int wc, int fr, int fq) const {
        const int row0 = u.pm * BM + wr * 64 + fr, colb = u.pn * BM + wc * 32 + 8 * fq;
#pragma unroll
        for (int ai = 0; ai < 2; ++ai)
#pragma unroll
            for (int m = 0; m < 4; ++m) {
                const int row = row0 + ai * HALF + m * 16; float s = 0.f;
#pragma unroll
                for (int bj = 0; bj < 2; ++bj) {
                    const int col = colb + bj * HALF;
                    const u32x4 gw = *(const u32x4*)(GB + (size_t)row * 1024 + col);
                    const f32x4 b0 = *(const f32x4*)(bias + col), b1 = *(const f32x4*)(bias + col + 4);
                    const f32x4 z0 = acc[ai][bj][m][0] + b0, z1 = acc[ai][bj][m][1] + b1;
                    float o[8];
                    o[0] = bf_lo(gw.x) * sigmoid_f(z0[0]); o[1] = bf_hi(gw.x) * sigmoid_f(z0[1]); o[2] = bf_lo(gw.y) * sigmoid_f(z0[2]); o[3] = bf_hi(gw.y) * sigmoid_f(z0[3]);
                    o[4] = bf_lo(gw.z) * sigmoid_f(z1[0]); o[5] = bf_hi(gw.z) * sigmoid_f(z1[1]); o[6] = bf_lo(gw.w) * sigmoid_f(z1[2]); o[7] = bf_hi(gw.w) * sigmoid_f(z1[3]);
#pragma unroll
                    for (int k = 0; k < 8; ++k) s += o[k] * o[k];
                    u32x4 w; w.x = cvt_pk_bf16(o[0], o[1]); w.y = cvt_pk_bf16(o[2], o[3]); w.z = cvt_pk_bf16(o[4], o[5]); w.w = cvt_pk_bf16(o[6], o[7]);
                    *(u32x4*)(SPRE + (size_t)row * 1024 + col) = w;
                }
                s += __shfl_xor(s, 16); s += __shfl_xor(s, 32);
                if (fq == 0) SSQ2[(size_t)row * 16 + u.pn * 4 + wc] = s;
            }
    }
};
template <class Epi, class Sched, bool ALIGN_EPI = false, bool SP2 = false>
__device__ __forceinline__ void gemm_phase(PG8_LAS unsigned char* lds, const Gemm g, const Sched& S, const Epi& E) {
    const int tid = threadIdx.x, wid = __builtin_amdgcn_readfirstlane(tid >> 6), lane = tid & 63, wr = wid >> 2, wc = wid & 3, fr = lane & 15, fq = lane >> 4;
    const int K = g.K, nt = K / BK;
    unsigned voffA[2], voffB[2];
#pragma unroll
    for (int i = 0; i < 2; ++i) { int R, C; stage_rc(tid * 16 + i * 8192, R, C); const int Rb = Epi::PERM ? ((R & ~31) + perm32(R & 31)) : R;
        voffA[i] = (unsigned)(R * K + C) * 2u; voffB[i] = (unsigned)(Rb * K + C) * 2u; }
    const size_t kstep = (size_t)(BK * 2);
    const size_t hstep = (size_t)HALF * K * 2;
    const size_t tstep = 2 * hstep;
    const unsigned ldsw = (unsigned)wid * 1024u;
    const int aoff = lds_byte(wr * 64 + fr, fq * 8), boff = lds_byte(wc * 32 + fr, fq * 8);
#define PG8_SA(b, h) (((b) * 2 + (h)) * HTB)
#define PG8_SB(b, h) ((4 + (b) * 2 + (h)) * HTB)
#define PG8_STAGE(bufoff, gbase, voff) do { _Pragma("unroll") for (int _i = 0; _i < 2; ++_i) \
        __builtin_amdgcn_global_load_lds((const unsigned*)((const char*)(gbase) + (voff)[_i]), (PG8_LAS unsigned*)(lds + (bufoff) + ldsw + _i * 8192), 16, 0, 0); } while (0)
#define PG8_LDA(dst, b, h) do { _Pragma("unroll") for (int m = 0; m < 4; ++m) _Pragma("unroll") for (int k = 0; k < 2; ++k) dst[m][k] = *(const PG8_LAS bf16x8*)(lds + PG8_SA(b, h) + aoff + m * 2048 + k * 1024); } while (0)
#define PG8_LDB(dst, b, h) do { _Pragma("unroll") for (int n = 0; n < 2; ++n) _Pragma("unroll") for (int k = 0; k < 2; ++k) dst[n][k] = *(const PG8_LAS bf16x8*)(lds + PG8_SB(b, h) + boff + n * 2048 + k * 1024); } while (0)
#define PG8_MMA(ai, bj, At, Bt) do { __builtin_amdgcn_s_setprio(1); _Pragma("unroll") for (int m = 0; m < 4; ++m) _Pragma("unroll") for (int n = 0; n < 2; ++n) _Pragma("unroll") for (int k = 0; k < 2; ++k) \
        acc[ai][bj][m][n] = __builtin_amdgcn_mfma_f32_16x16x32_bf16(Bt[n][k], At[m][k], acc[ai][bj][m][n], 0, 0, 0); __builtin_amdgcn_s_setprio(0); } while (0)
#define PG8_WAIT_V(n) asm volatile("s_waitcnt vmcnt(" #n ")" ::: "memory")
#define PG8_WAIT_L(n) asm volatile("s_waitcnt lgkmcnt(" #n ")" ::: "memory")
#define PG8_BAR __builtin_amdgcn_s_barrier()
#define PG8_SCHED __builtin_amdgcn_sched_barrier(0)
    Unit cur, nxt; int ui = 0;
    if (!S.next(0, cur)) return;
    f32x4 acc[2][2][4][2];
#pragma unroll
    for (int a = 0; a < 2; ++a)
#pragma unroll
        for (int b = 0; b < 2; ++b)
#pragma unroll
            for (int m = 0; m < 4; ++m)
#pragma unroll
                for (int n = 0; n < 2; ++n) acc[a][b][m][n] = (f32x4){0.f, 0.f, 0.f, 0.f};
    bf16x8 At[4][2], B0[2][2], B1[2][2];
    const char* cA = (const char*)g.A + (size_t)cur.pm * tstep; const char* cB = (const char*)g.Bt + (size_t)cur.pn * tstep;
    S.a_ready(cur);
    if constexpr (SP2) {
        PG8_STAGE(PG8_SB(0, 0), cB, voffB); PG8_STAGE(PG8_SB(0, 1), cB + hstep, voffB); PG8_STAGE(PG8_SA(0, 0), cA, voffA); PG8_STAGE(PG8_SA(0, 1), cA + hstep, voffA);
        if (wr == 1) PG8_BAR;
        PG8_WAIT_V(2); PG8_BAR;
        PG8_STAGE(PG8_SB(1, 0), cB + kstep, voffB); PG8_STAGE(PG8_SA(1, 0), cA + kstep, voffA); PG8_STAGE(PG8_SB(1, 1), cB + hstep + kstep, voffB);
        PG8_WAIT_V(6); PG8_BAR;
    } else {
        PG8_STAGE(PG8_SB(0, 0), cB, voffB); PG8_STAGE(PG8_SA(0, 0), cA, voffA); PG8_STAGE(PG8_SB(0, 1), cB + hstep, voffB); PG8_STAGE(PG8_SA(0, 1), cA + hstep, voffA);
        if (wr == 1) PG8_BAR;
        PG8_WAIT_V(4); PG8_BAR;
        PG8_STAGE(PG8_SB(1, 0), cB + kstep, voffB); PG8_STAGE(PG8_SA(1, 0), cA + kstep, voffA); PG8_STAGE(PG8_SB(1, 1), cB + hstep + kstep, voffB);
        PG8_WAIT_V(6); PG8_BAR;
    }
    for (;;) {
        const bool has_next = S.next(ui + 1, nxt);
        const char* nA = has_next ? (const char*)g.A + (size_t)nxt.pm * tstep : cA; const char* nB = has_next ? (const char*)g.Bt + (size_t)nxt.pn * tstep : cB;
        for (int t = 0; t < nt; t += 2) {
            const bool last = (t == nt - 2);
            const char* a1 = cA + (size_t)(t + 1) * kstep;
            const char* a2 = last ? nA : cA + (size_t)(t + 2) * kstep; const char* b2 = last ? nB : cB + (size_t)(t + 2) * kstep;
            const char* a3 = a2 + kstep; const char* b3 = b2 + kstep;
            if (last && has_next) S.a_ready(nxt);
            if constexpr (SP2) {
            PG8_LDB(B0, 0, 0); PG8_LDB(B1, 0, 1); PG8_SCHED; PG8_LDA(At, 0, 0); PG8_STAGE(PG8_SA(1, 1), a1 + hstep, voffA);
            PG8_WAIT_V(8); PG8_WAIT_L(0); PG8_BAR; PG8_MMA(0, 0, At, B0); PG8_MMA(0, 1, At, B1); PG8_BAR; PG8_SCHED;
            PG8_LDA(At, 0, 1); PG8_STAGE(PG8_SB(0, 0), b2, voffB); PG8_STAGE(PG8_SB(0, 1), b2 + hstep, voffB); PG8_STAGE(PG8_SA(0, 0), a2, voffA);
            PG8_WAIT_V(8); PG8_WAIT_L(0); PG8_BAR; PG8_MMA(1, 0, At, B0); PG8_MMA(1, 1, At, B1); PG8_BAR; PG8_SCHED;
            PG8_LDB(B0, 1, 0); PG8_LDB(B1, 1, 1); PG8_SCHED; PG8_LDA(At, 1, 0); PG8_STAGE(PG8_SA(0, 1), a2 + hstep, voffA);
            PG8_WAIT_V(8); PG8_WAIT_L(0); PG8_BAR; PG8_MMA(0, 0, At, B0); PG8_MMA(0, 1, At, B1); PG8_BAR; PG8_SCHED;
            PG8_LDA(At, 1, 1); PG8_STAGE(PG8_SB(1, 0), b3, voffB); PG8_STAGE(PG8_SB(1, 1), b3 + hstep, voffB); PG8_STAGE(PG8_SA(1, 0), a3, voffA);
            PG8_WAIT_V(8); PG8_WAIT_L(0); PG8_BAR; PG8_MMA(1, 0, At, B0); PG8_MMA(1, 1, At, B1); PG8_BAR; PG8_SCHED;
            } else {
            PG8_LDB(B0, 0, 0); PG8_SCHED; PG8_LDA(At, 0, 0); PG8_STAGE(PG8_SA(1, 1), a1 + hstep, voffA);
            PG8_WAIT_L(8); PG8_BAR; PG8_WAIT_L(0); PG8_MMA(0, 0, At, B0); PG8_BAR; PG8_SCHED;
            PG8_LDB(B1, 0, 1); PG8_STAGE(PG8_SB(0, 0), b2, voffB);
            PG8_BAR; PG8_WAIT_L(0); PG8_MMA(0, 1, At, B1); PG8_BAR;
            PG8_LDA(At, 0, 1); PG8_STAGE(PG8_SA(0, 0), a2, voffA);
            PG8_BAR; PG8_WAIT_L(0); PG8_MMA(1, 0, At, B0); PG8_BAR; PG8_SCHED;
            PG8_STAGE(PG8_SB(0, 1), b2 + hstep, voffB);
            PG8_WAIT_V(6); PG8_BAR; PG8_MMA(1, 1, At, B1); PG8_BAR;
            PG8_LDB(B0, 1, 0); PG8_SCHED; PG8_LDA(At, 1, 0); PG8_STAGE(PG8_SA(0, 1), a2 + hstep, voffA);
            PG8_WAIT_L(8); PG8_BAR; PG8_WAIT_L(0); PG8_MMA(0, 0, At, B0); PG8_BAR; PG8_SCHED;
            PG8_LDB(B1, 1, 1); PG8_STAGE(PG8_SB(1, 0), b3, voffB);
            PG8_BAR; PG8_WAIT_L(0); PG8_MMA(0, 1, At, B1); PG8_BAR;
            PG8_LDA(At, 1, 1); PG8_STAGE(PG8_SA(1, 0), a3, voffA);
            PG8_BAR; PG8_WAIT_L(0); PG8_MMA(1, 0, At, B0); PG8_BAR; PG8_SCHED;
            PG8_STAGE(PG8_SB(1, 1), b3 + hstep, voffB);
            PG8_WAIT_V(6); PG8_BAR; PG8_MMA(1, 1, At, B1); PG8_BAR;
            }
        }
        if constexpr (ALIGN_EPI) { if (wr == 0) PG8_BAR; }
        if constexpr (!Epi::AFTER_DRAIN) { E(acc, cur, wr, wc, fr, fq); S.done(cur); }
        if (!has_next) break;
#pragma unroll
        for (int a = 0; a < 2; ++a)
#pragma unroll
            for (int b = 0; b < 2; ++b)
#pragma unroll
                for (int m = 0; m < 4; ++m)
#pragma unroll
                    for (int n = 0; n < 2; ++n) acc[a][b][m][n] = (f32x4){0.f, 0.f, 0.f, 0.f};
        cur = nxt; cA = nA; cB = nB; ++ui;
        if constexpr (ALIGN_EPI) { if (wr == 1) PG8_BAR; }
    }
    PG8_WAIT_V(0);
    if constexpr (!ALIGN_EPI) { if (wr == 0) PG8_BAR; }
    PG8_BAR;
    if constexpr (Epi::AFTER_DRAIN) { E.fused(acc, cur, wr, wc, fr, fq, lds, wid, lane); S.done(cur); }
#undef PG8_SA
#undef PG8_SB
#undef PG8_STAGE
#undef PG8_LDA
#undef PG8_LDB
#undef PG8_MMA
#undef PG8_WAIT_V
#undef PG8_WAIT_L
#undef PG8_BAR
#undef PG8_SCHED
}
}
namespace att {
typedef short bf16x8 __attribute__((ext_vector_type(8)));
typedef short s16x4 __attribute__((ext_vector_type(4)));
typedef float f32x16 __attribute__((ext_vector_type(16)));
typedef float f32x4 __attribute__((ext_vector_type(4)));
typedef unsigned u32x4 __attribute__((ext_vector_type(4)));
typedef unsigned short bf16_t;
constexpr int KVBLK = 64, LDK = 3072, NT = 2048 / KVBLK;
constexpr int SHM_V = KVBLK * 128 * 2, SHM_K = KVBLK * 128 * 2;
constexpr int WS_OFF = 131072;
constexpr float THRL = 11.5f;
#ifndef ATT_SDEPTH
#define ATT_SDEPTH 1
#endif
constexpr int SDEPTH = ATT_SDEPTH;
#define KSWZ(row, colB) ((row) * 256 + ((colB) ^ (((row) & 7) << 4)))
#define SBAR() __builtin_amdgcn_sched_barrier(0)
__device__ __forceinline__ int crow(int r, int hi) { return (r & 3) + 8 * (r >> 2) + 4 * hi; }
__device__ __forceinline__ unsigned cvtpk(float lo, float hi) { unsigned r; asm volatile("v_cvt_pk_bf16_f32 %0, %1, %2" : "=v"(r) : "v"(lo), "v"(hi)); return r; }

__device__ __forceinline__ void partialSM(f32x16& p0, f32x16& p1, float& m_reg, float& mn, float& alpha) {
  float pmax = p0[0];
#pragma unroll
  for (int r = 1; r < 16; ++r) pmax = fmaxf(pmax, p0[r]);
#pragma unroll
  for (int r = 0; r < 16; ++r) pmax = fmaxf(pmax, p1[r]);
  { auto rr = __builtin_amdgcn_permlane32_swap(__float_as_uint(pmax), __float_as_uint(pmax), false, false);
    pmax = fmaxf(__uint_as_float(rr[0]), __uint_as_float(rr[1])); }
  if (__builtin_expect(__all(pmax - m_reg <= THRL), 1)) { mn = m_reg; alpha = 1.f; }
  else { mn = fmaxf(m_reg, pmax); alpha = __builtin_amdgcn_exp2f(m_reg - mn); m_reg = mn; }
#pragma unroll
  for (int r = 0; r < 16; ++r) p0[r] = p0[r] - mn;
#pragma unroll
  for (int r = 0; r < 16; ++r) p1[r] = p1[r] - mn;
#pragma unroll
  for (int r = 0; r < 16; ++r) p0[r] = __builtin_amdgcn_exp2f(p0[r]);
}
__device__ __forceinline__ void finishSM(f32x16& p0, f32x16& p1, float alpha, float& l_reg, bf16x8& pa0, bf16x8& pa1, bf16x8& pa2, bf16x8& pa3) {
#pragma unroll
  for (int r = 0; r < 16; ++r) p1[r] = __builtin_amdgcn_exp2f(p1[r]);
  float ps = 0;
#pragma unroll
  for (int r = 0; r < 16; ++r) ps += p0[r];
#pragma unroll
  for (int r = 0; r < 16; ++r) ps += p1[r];
  { auto rr = __builtin_amdgcn_permlane32_swap(__float_as_uint(ps), __float_as_uint(ps), false, false);
    ps = __uint_as_float(rr[0]) + __uint_as_float(rr[1]); }
  l_reg = l_reg * alpha + ps;
#define PK4(P, BASE, OUT) do { unsigned a0 = cvtpk(P[BASE + 0], P[BASE + 1]), a1 = cvtpk(P[BASE + 2], P[BASE + 3]);   \
    unsigned b0 = cvtpk(P[BASE + 4], P[BASE + 5]), b1 = cvtpk(P[BASE + 6], P[BASE + 7]);                              \
    auto r0 = __builtin_amdgcn_permlane32_swap(a0, b0, false, false); auto r1 = __builtin_amdgcn_permlane32_swap(a1, b1, false, false); \
    u32x4 w = {r0[0], r1[0], r0[1], r1[1]}; OUT = *reinterpret_cast<bf16x8*>(&w); } while (0)
  PK4(p0, 0, pa0); PK4(p0, 8, pa1); PK4(p1, 0, pa2); PK4(p1, 8, pa3);
#undef PK4
}
__device__ __forceinline__ void qkt(f32x16& p0, f32x16& p1, const char* Ks, const char* qr, int r32, int hi, int cofs, float dq, float nsl) {
#pragma unroll
  for (int r = 0; r < 16; ++r) { const float cr = (float)((r & 3) + 8 * (r >> 2)); p0[r] = nsl * __builtin_fabsf(dq - cr); p1[r] = nsl * __builtin_fabsf(dq - (32.f + cr)); }
#pragma unroll
  for (int d0 = 0; d0 < 4; ++d0) { const int cb = cofs + d0 * 32 + hi * 16;
    bf16x8 b0 = *reinterpret_cast<const bf16x8*>(Ks + KSWZ(r32, cb));
    bf16x8 b1 = *reinterpret_cast<const bf16x8*>(Ks + KSWZ(32 + r32, cb));
    const bf16x8 qf = *reinterpret_cast<const bf16x8*>(qr + d0 * 1024);
    p0 = __builtin_amdgcn_mfma_f32_32x32x16_bf16(b0, qf, p0, 0, 0, 0);
    p1 = __builtin_amdgcn_mfma_f32_32x32x16_bf16(b1, qf, p1, 0, 0, 0); }
}
__device__ __forceinline__ int v_st(int k, int c) { const int kk = (k & ~0xC) | ((k & 4) << 1) | ((k & 8) >> 1); return ((kk >> 3) * 4 + (c >> 5)) * 512 + ((kk & 7) * 32 + (c & 31)) * 2; }
__device__ __forceinline__ int v_rd_base(int lane) { return ((lane & 3) << 3) | (((lane >> 2) & 3) << 6) | (((lane >> 4) & 1) << 5) | (((lane >> 5) & 1) << 8); }
constexpr int v_rd_off(int d0, int ks, int half) { return d0 * 512 + ks * 4096 + half * 2048; }
template <int OFF> __device__ __forceinline__ s16x4 tr_read(int vb) {
  s16x4 r; asm volatile("ds_read_b64_tr_b16 %0, %1 offset:%2" : "=&v"(r) : "v"(vb), "i"(OFF) : "memory"); return r;
}
template <int D0> __device__ __forceinline__ void pv_one(f32x16& od, int vb, bf16x8 pa0, bf16x8 pa1, bf16x8 pa2, bf16x8 pa3) {
  const s16x4 l0 = tr_read<v_rd_off(D0, 0, 0)>(vb), h0 = tr_read<v_rd_off(D0, 0, 1)>(vb), l1 = tr_read<v_rd_off(D0, 1, 0)>(vb), h1 = tr_read<v_rd_off(D0, 1, 1)>(vb);
  const s16x4 l2 = tr_read<v_rd_off(D0, 2, 0)>(vb), h2 = tr_read<v_rd_off(D0, 2, 1)>(vb), l3 = tr_read<v_rd_off(D0, 3, 0)>(vb), h3 = tr_read<v_rd_off(D0, 3, 1)>(vb);
  asm volatile("s_waitcnt lgkmcnt(0)" ::: "memory"); SBAR();
#define PK(L, H) (bf16x8){L[0], L[1], L[2], L[3], H[0], H[1], H[2], H[3]}
  od = __builtin_amdgcn_mfma_f32_32x32x16_bf16(pa0, PK(l0, h0), od, 0, 0, 0);
  od = __builtin_amdgcn_mfma_f32_32x32x16_bf16(pa1, PK(l1, h1), od, 0, 0, 0);
  od = __builtin_amdgcn_mfma_f32_32x32x16_bf16(pa2, PK(l2, h2), od, 0, 0, 0);
  od = __builtin_amdgcn_mfma_f32_32x32x16_bf16(pa3, PK(l3, h3), od, 0, 0, 0);
#undef PK
}
__device__ __forceinline__ void pv_d0(f32x16* o, int vb, bf16x8 pa0, bf16x8 pa1, bf16x8 pa2, bf16x8 pa3) {
  pv_one<0>(o[0], vb, pa0, pa1, pa2, pa3); pv_one<1>(o[1], vb, pa0, pa1, pa2, pa3); pv_one<2>(o[2], vb, pa0, pa1, pa2, pa3); pv_one<3>(o[3], vb, pa0, pa1, pa2, pa3);
}

__device__ __forceinline__ void attn_unit(const bf16_t* __restrict__ QKV, bf16_t* __restrict__ CAT, int b, int h, int qb, float lam, const float* __restrict__ head_g, char* lds) {
  const int tid = threadIdx.x, wid = tid >> 6, lane = tid & 63, r32 = lane & 31, hi = lane >> 5, cmap = wid >> 2, wq = wid & 3;
  char* V_lds = lds; char* K_lds = lds + 2 * SHM_V;
  float* ws = (float*)(lds + WS_OFF) + wid * 64; float* li_l = ws; float* al_l = ws + 32;
  float m_reg = -1e30f, l_reg = 0; f32x16 o[4] = {};
  char* qr = lds + 65536 + wid * 4096 + lane * 16;
  const bf16_t* Qw = QKV + (size_t)(b * 2048 + qb * 128 + wq * 32 + r32) * LDK + h * 128 + cmap * 64 + hi * 8;
#pragma unroll
  for (int d0 = 0; d0 < 4; ++d0) *reinterpret_cast<bf16x8*>(qr + d0 * 1024) = *reinterpret_cast<const bf16x8*>(Qw + d0 * 16);
  const bf16_t* Kh = QKV + (size_t)(b * 2048) * LDK + 1024 + h * 128;
  const bf16_t* Vh = QKV + (size_t)(b * 2048) * LDK + 2048 + h * 128;
  const float dqb = (float)(qb * 128 + wq * 32 + r32 - 4 * hi);
  const float nsl = -1.4426950408889634f * __builtin_amdgcn_exp2f(-(float)(h + 1));
  const int cofs = cmap * 128;
  const int sr = tid >> 4, sc = (tid & 15) * 8, vst0 = v_st(sr, sc), vst1 = v_st(32 + sr, sc);
  const int vb0 = (int)(uintptr_t)V_lds + v_rd_base(lane);
  struct { bf16x8 vs0, vs1, ks0, ks1; } sr_[SDEPTH];
#define SLOAD(i, k0) do { sr_[i].vs0 = *reinterpret_cast<const bf16x8*>(&Vh[(size_t)((k0) + sr) * LDK + sc]); sr_[i].vs1 = *reinterpret_cast<const bf16x8*>(&Vh[(size_t)((k0) + 32 + sr) * LDK + sc]); \
    sr_[i].ks0 = *reinterpret_cast<const bf16x8*>(&Kh[(size_t)((k0) + sr) * LDK + sc]); sr_[i].ks1 = *reinterpret_cast<const bf16x8*>(&Kh[(size_t)((k0) + 32 + sr) * LDK + sc]); } while (0)
#define SWRITE(bb, i) do { *(bf16x8*)(V_lds + (bb) * SHM_V + vst0) = sr_[i].vs0;          \
    *(bf16x8*)(V_lds + (bb) * SHM_V + vst1) = sr_[i].vs1; int kc = sc * 2;               \
    *(bf16x8*)(K_lds + (bb) * SHM_K + KSWZ(sr, kc)) = sr_[i].ks0;                       \
    *(bf16x8*)(K_lds + (bb) * SHM_K + KSWZ(32 + sr, kc)) = sr_[i].ks1; } while (0)
#define SWAIT() do { if constexpr (SDEPTH == 2) asm volatile("s_waitcnt vmcnt(4)" ::: "memory"); else asm volatile("s_waitcnt vmcnt(0)" ::: "memory"); } while (0)
#define RESC(a) do { if (__any((a) < 1.f)) { if (hi == 0) al_l[r32] = (a); asm volatile("s_waitcnt lgkmcnt(0)" ::: "memory"); \
    _Pragma("unroll") for (int d = 0; d < 4; ++d) _Pragma("unroll") for (int r = 0; r < 16; ++r) o[d][r] *= al_l[crow(r, hi)]; } } while (0)
  f32x16 pA0, pA1, pB0, pB1; float mnA, mnB, alA, alB; bf16x8 pa0, pa1, pa2, pa3;
  constexpr int SE = 0, SO = SDEPTH - 1;
  SLOAD(SE, 0); asm volatile("s_waitcnt vmcnt(0)" ::: "memory"); SWRITE(0, SE); __syncthreads();
  qkt(pA0, pA1, K_lds, qr, r32, hi, cofs, dqb, nsl); partialSM(pA0, pA1, m_reg, mnA, alA);
  SLOAD(SO, KVBLK); if constexpr (SDEPTH == 2) SLOAD(SE, 2 * KVBLK);
  SWAIT(); SWRITE(1, SO); __syncthreads();
  for (int j = 1; j + 1 < NT; j += 2) {
    SBAR(); qkt(pB0, pB1, K_lds + SHM_K, qr, r32, hi, cofs, dqb - (float)(j * KVBLK), nsl);
    finishSM(pA0, pA1, alA, l_reg, pa0, pa1, pa2, pa3); SBAR();
    SLOAD(SO, (j + SDEPTH) * KVBLK); SBAR();
    pv_d0(o, vb0, pa0, pa1, pa2, pa3); partialSM(pB0, pB1, m_reg, mnB, alB);
    __syncthreads(); SWAIT(); SWRITE(0, SE);
    RESC(alB); __syncthreads();
    SBAR(); qkt(pA0, pA1, K_lds, qr, r32, hi, cofs, dqb - (float)((j + 1) * KVBLK), nsl);
    finishSM(pB0, pB1, alB, l_reg, pa0, pa1, pa2, pa3); SBAR();
    if (SDEPTH == 1 || j + 3 < NT) SLOAD(SE, (j + 1 + SDEPTH) * KVBLK); SBAR();
    pv_d0(o, vb0 + SHM_V, pa0, pa1, pa2, pa3); partialSM(pA0, pA1, m_reg, mnA, alA);
    __syncthreads(); SWAIT(); SWRITE(1, SO);
    RESC(alA); __syncthreads();
  }
  SBAR(); qkt(pB0, pB1, K_lds + SHM_K, qr, r32, hi, cofs, dqb - (float)((NT - 1) * KVBLK), nsl);
  finishSM(pA0, pA1, alA, l_reg, pa0, pa1, pa2, pa3); SBAR();
  pv_d0(o, vb0, pa0, pa1, pa2, pa3); partialSM(pB0, pB1, m_reg, mnB, alB);
  __syncthreads(); RESC(alB);
  finishSM(pB0, pB1, alB, l_reg, pa0, pa1, pa2, pa3); SBAR();
  pv_d0(o, vb0 + SHM_V, pa0, pa1, pa2, pa3);
  if (hi == 0) li_l[r32] = l_reg; asm volatile("s_waitcnt lgkmcnt(0)" ::: "memory");
  float rli[16];
#pragma unroll
  for (int r = 0; r < 16; ++r) rli[r] = __builtin_amdgcn_rcpf(li_l[crow(r, hi)]);
  __syncthreads();
  float* OB = (float*)lds + cmap * 16384 + (wq * 32) * 128;
#pragma unroll
  for (int r = 0; r < 16; ++r) { const int orow = crow(r, hi);
#pragma unroll
    for (int d0 = 0; d0 < 4; ++d0) OB[orow * 128 + d0 * 32 + r32] = o[d0][r] * rli[r]; }
  __syncthreads();
  { const int row = tid >> 2, qtr = tid & 3;
    const f32x4* o1 = (const f32x4*)((const float*)lds + row * 128 + qtr * 32); const f32x4* o2 = o1 + 4096;
    f32x4 v[8]; float ssq = 0.f;
#pragma unroll
    for (int k = 0; k < 8; ++k) { v[k] = o1[k] - lam * o2[k]; ssq += (v[k][0] * v[k][0] + v[k][1] * v[k][1]) + (v[k][2] * v[k][2] + v[k][3] * v[k][3]); }
    ssq += __shfl_xor(ssq, 1); ssq += __shfl_xor(ssq, 2);
    const float rs = rsqrtf(ssq * (1.0f / 128.0f) + 1e-6f) * 0.8f;
    bf16_t* dst = CAT + (size_t)(b * 2048 + qb * 128 + row) * 1024 + h * 128 + qtr * 32;
    const f32x4* hg = (const f32x4*)(head_g + qtr * 32);
#pragma unroll
    for (int k = 0; k < 8; k += 2) { const f32x4 g0 = hg[k], g1 = hg[k + 1]; const f32x4 a = v[k] * rs * g0, c = v[k + 1] * rs * g1;
      u32x4 w; w.x = cvtpk(a[0], a[1]); w.y = cvtpk(a[2], a[3]); w.z = cvtpk(c[0], c[1]); w.w = cvtpk(c[2], c[3]);
      *(u32x4*)(dst + k * 4) = w; }
  }
  __syncthreads();
#undef SLOAD
#undef SWRITE
#undef SWAIT
#undef RESC
}
#undef SBAR
}
#define LAS __attribute__((address_space(3)))
typedef unsigned short bf16_t;
typedef short bf16x8 __attribute__((ext_vector_type(8)));
typedef float f32x4 __attribute__((ext_vector_type(4)));
typedef float f32x16 __attribute__((ext_vector_type(16)));
typedef unsigned u32x4 __attribute__((ext_vector_type(4)));
typedef unsigned u32x2 __attribute__((ext_vector_type(2)));
constexpr int DM = 2048, BATCH = 4, SEQ = 2048, MT = BATCH * SEQ, DFF = 5632, NGU = 2 * DFF, INC = 4096, SW = 1024;
constexpr int SG = 64, CT = 16, NCH = SEQ / CT, NROW = BATCH * NCH;
constexpr float EPS = 1e-6f;
constexpr int NWAVES = 8, LDS_BYTES = 136 * 1024;
constexpr size_t al256(size_t x) { return (x + 255) / 256 * 256; }
constexpr size_t WS_W1G = 0;
constexpr size_t WS_W1D = WS_W1G + (size_t)NGU * DM * 2;
constexpr size_t WS_WIN = WS_W1D + (size_t)DM * DFF * 2;
constexpr size_t WS_WOUT = WS_WIN + (size_t)INC * DM * 2;
constexpr size_t WS_WGLU = WS_WOUT + (size_t)DM * DM * 2;
constexpr size_t WS_XN = WS_WGLU + (size_t)SW * SW * 2;
constexpr size_t WS_HFF = WS_XN + (size_t)MT * DM * 2;
constexpr size_t WS_YPART = WS_HFF;
constexpr size_t WS_QKV = WS_HFF, WS_UG = WS_QKV + (size_t)MT * 3072 * 2, WS_HIN = WS_UG + (size_t)SG * NROW * 256 * 2;
constexpr size_t WS_Y = WS_HFF + (size_t)MT * DFF * 2;
constexpr size_t WS_SLOC = WS_Y, WS_GB = WS_SLOC + (size_t)SG * NROW * 256 * 4, WS_SPRE = WS_GB + (size_t)MT * SW * 2;
constexpr size_t WS_SSQ = WS_Y + (size_t)MT * DM * 4;
constexpr size_t WS_SSQ2 = WS_SSQ + (size_t)MT * 32 * 4;
constexpr size_t WS_EMAT = WS_SSQ2 + (size_t)MT * 16 * 4;
constexpr size_t WS_MFT = WS_EMAT + (size_t)SG * 8 * 16 * 1024;
constexpr size_t WS_ATAB = WS_MFT + (size_t)SG * 8 * 32 * 1024;
constexpr size_t WS_X1 = WS_ATAB + (size_t)SG * 2 * 64 * 2 * 4;
constexpr size_t WS_RS = WS_X1 + (size_t)MT * DM * 2;
constexpr size_t WS_CTL = WS_RS + (size_t)MT * 4;
constexpr size_t CTL_BYTES = 16384;
constexpr size_t WS_END = WS_CTL + CTL_BYTES;
constexpr int LDS_BARST = 133120;
static_assert(WS_HIN + (size_t)SG * NROW * 256 * 2 <= WS_Y && WS_SPRE + (size_t)MT * SW * 2 <= WS_SSQ, "overlays");

__device__ __forceinline__ unsigned cvtpk(float lo, float hi) { unsigned r; asm volatile("v_cvt_pk_bf16_f32 %0, %1, %2" : "=v"(r) : "v"(lo), "v"(hi)); return r; }
__device__ __forceinline__ float wave_sum(float v) {
#pragma unroll
    for (int o = 1; o < 64; o <<= 1) v += __shfl_xor(v, o);
    return v;
}
__device__ __forceinline__ float bf2f_lo(unsigned w) { return __uint_as_float(w << 16); }
__device__ __forceinline__ float bf2f_hi(unsigned w) { return __uint_as_float(w & 0xffff0000u); }

struct Params { const float* in[31]; float* out; unsigned char* ws; int ph_lo, ph_hi; };

__device__ __forceinline__ void transpose_item(const float* __restrict__ W, int K, int N, bf16_t* __restrict__ WT, int k0, int n0, int rowbase, LAS float* scr, int lane, const float* __restrict__ gk = nullptr) {
    const int r0 = lane >> 3, c4 = (lane & 7) * 4;
    const float* src = W + (size_t)(k0 + r0) * N + n0 + c4;
    f32x4 v[8];
#pragma unroll
    for (int i = 0; i < 8; ++i) v[i] = *(const f32x4*)(src + (size_t)(8 * i) * N);
    if (gk) {
#pragma unroll
        for (int i = 0; i < 8; ++i) v[i] = v[i] * gk[k0 + r0 + 8 * i]; }
#pragma unroll
    for (int i = 0; i < 8; ++i) { LAS float* d = scr + (r0 + 8 * i) * 33 + c4; d[0] = v[i][0]; d[1] = v[i][1]; d[2] = v[i][2]; d[3] = v[i][3]; }
    asm volatile("s_waitcnt lgkmcnt(0)" ::: "memory");
    const int c = lane & 7;
#pragma unroll
    for (int j = 0; j < 4; ++j) { const int n = (lane >> 3) + 8 * j; const LAS float* s = scr + (8 * c) * 33 + n;
        u32x4 o; o.x = cvtpk(s[0 * 33], s[1 * 33]); o.y = cvtpk(s[2 * 33], s[3 * 33]); o.z = cvtpk(s[4 * 33], s[5 * 33]); o.w = cvtpk(s[6 * 33], s[7 * 33]);
        *(u32x4*)(WT + (size_t)(rowbase + n) * K + k0 + 8 * c) = o; }
    asm volatile("s_waitcnt lgkmcnt(0)" ::: "memory");
}
constexpr int GU_ITEMS = 2 * (DM / 64) * (DFF / 32);
__device__ __forceinline__ void convert_gateup(const float* wg, const float* wu, const float* gk, unsigned char* ws, LAS float* scr, int gw, int ngw, int lane, int it0 = 0, int it1 = GU_ITEMS) {
    constexpr int IG = (DM / 64) * (DFF / 32);
    bf16_t* G = (bf16_t*)(ws + WS_W1G);
    for (int it = it0 + gw; it < it1; it += ngw) {
        int r = it; const int up = r >= IG; if (up) r -= IG; const int nb = r % (DFF / 32), kb = r / (DFF / 32), n0 = nb * 32;
        transpose_item(up ? wu : wg, DM, DFF, G, kb * 64, n0, (n0 >> 7) * 256 + (n0 & 127) + up * 128, scr, lane, gk);
    }
}
__device__ __forceinline__ void convert_plain(const float* w, int K, int N, bf16_t* WT, LAS float* scr, int gw, int ngw, int lane, const float* gk = nullptr) {
    const int items = (K / 64) * (N / 32);
    for (int r = gw; r < items; r += ngw) { const int nb = r % (N / 32), kb = r / (N / 32); transpose_item(w, K, N, WT, kb * 64, nb * 32, nb * 32, scr, lane, gk); }
}
__device__ __forceinline__ void prenorm_rows(const float* __restrict__ X, bf16_t* __restrict__ XB, float* __restrict__ RS, int gw, int ngw, int lane) {
    for (int row = gw; row < MT; row += ngw) {
        const f32x4* xr = (const f32x4*)(X + (size_t)row * DM) + lane; f32x4 v[8]; float s = 0.f;
#pragma unroll
        for (int j = 0; j < 8; ++j) { v[j] = xr[64 * j]; s += (v[j][0] * v[j][0] + v[j][1] * v[j][1]) + (v[j][2] * v[j][2] + v[j][3] * v[j][3]); }
        s = wave_sum(s);
        if (lane == 0) RS[row] = rsqrtf(s * (1.0f / DM) + EPS);
        u32x2* o8 = (u32x2*)(XB + (size_t)row * DM) + lane;
#pragma unroll
        for (int j = 0; j < 8; ++j) { u32x2 w; w.x = cvtpk(v[j][0], v[j][1]); w.y = cvtpk(v[j][2], v[j][3]); o8[64 * j] = w; }
    }
}
template <bool SRCBF, bool FINAL>
__device__ __forceinline__ void resid_rows(const void* SRC, const bf16_t* __restrict__ Y, const float* __restrict__ SSQ, int npart, const float* __restrict__ gpost, float coef,
                                           float* OUTF, bf16_t* XB, float* RS, int gw, int ngw, int lane) {
    for (int row = gw; row < MT; row += ngw) {
        float s = lane < npart ? SSQ[(size_t)row * npart + lane] : 0.f;
        const float rs = rsqrtf(wave_sum(s) * (1.0f / DM) + EPS) * coef;
        const u32x2* yr = (const u32x2*)(Y + (size_t)row * DM) + lane;
        f32x4 v[8]; float s1 = 0.f;
#pragma unroll
        for (int j = 0; j < 8; ++j) { const f32x4 gg = ((const f32x4*)gpost)[lane + 64 * j];
            const u32x2 yw = yr[64 * j]; const f32x4 yv = {bf2f_lo(yw.x), bf2f_hi(yw.x), bf2f_lo(yw.y), bf2f_hi(yw.y)};
            f32x4 xv;
            if (SRCBF) { const u32x2 xw = ((const u32x2*)((const bf16_t*)SRC + (size_t)row * DM) + lane)[64 * j]; xv = (f32x4){bf2f_lo(xw.x), bf2f_hi(xw.x), bf2f_lo(xw.y), bf2f_hi(xw.y)}; }
            else xv = ((const f32x4*)((const float*)SRC + (size_t)row * DM) + lane)[64 * j];
            v[j] = xv + yv * rs * gg;
            s1 += (v[j][0] * v[j][0] + v[j][1] * v[j][1]) + (v[j][2] * v[j][2] + v[j][3] * v[j][3]); }
        if (FINAL) { f32x4* orow = (f32x4*)(OUTF + (size_t)row * DM) + lane;
#pragma unroll
            for (int j = 0; j < 8; ++j) orow[64 * j] = v[j];
        } else {
            s1 = wave_sum(s1);
            if (lane == 0) RS[row] = rsqrtf(s1 * (1.0f / DM) + EPS);
            u32x2* o8 = (u32x2*)(XB + (size_t)row * DM) + lane;
#pragma unroll
            for (int j = 0; j < 8; ++j) { u32x2 w; w.x = cvtpk(v[j][0], v[j][1]); w.y = cvtpk(v[j][2], v[j][3]); o8[64 * j] = w; }
        }
    }
}
__device__ __forceinline__ void snorm_rows(const bf16_t* __restrict__ SPRE, const float* __restrict__ SSQ2, const float* __restrict__ og, bf16_t* __restrict__ CAT, int gw, int ngw, int lane) {
    for (int row = gw; row < MT; row += ngw) {
        float s = lane < 16 ? SSQ2[(size_t)row * 16 + lane] : 0.f;
        const float rs = rsqrtf(wave_sum(s) * (1.0f / SW) + EPS);
#pragma unroll
        for (int j = 0; j < 2; ++j) { const int c8 = lane + 64 * j; const u32x4 w = *((const u32x4*)(SPRE + (size_t)row * SW) + c8);
            const f32x4 g0 = ((const f32x4*)og)[2 * c8], g1 = ((const f32x4*)og)[2 * c8 + 1]; u32x4 o;
            o.x = cvtpk(bf2f_lo(w.x) * rs * g0[0], bf2f_hi(w.x) * rs * g0[1]); o.y = cvtpk(bf2f_lo(w.y) * rs * g0[2], bf2f_hi(w.y) * rs * g0[3]);
            o.z = cvtpk(bf2f_lo(w.z) * rs * g1[0], bf2f_hi(w.z) * rs * g1[1]); o.w = cvtpk(bf2f_lo(w.w) * rs * g1[2], bf2f_hi(w.w) * rs * g1[3]);
            *((u32x4*)(CAT + (size_t)row * DM + SW) + c8) = o; }
    }
}

__device__ __forceinline__ void s5_tables(const Params& p, int g, float* L) {
    const int t = threadIdx.x;
    float* APOW = L; float* FF = APOW + 2 * 64 * 17 * 2; float* BB = FF + 2 * 64 * 2; float* CC = BB + 2 * 64 * 16 * 2; float* KL = CC + 2 * 16 * 65 * 2;
    unsigned char* ws = p.ws;
    __syncthreads();
    if (t < 128) {
        const int dir = t >> 6, n = t & 63, idx = (dir * SG + g) * 64 + n;
        const float lr = p.in[13][idx], li = p.in[14][idx], dt = expf(p.in[15][dir * SG + g]);
        const float mag = expf(lr * dt), ar = mag * cosf(li * dt), ai = mag * sinf(li * dt);
        const float den = lr * lr + li * li, nr = ar - 1.0f;
        FF[(dir * 64 + n) * 2] = (nr * lr + ai * li) / den; FF[(dir * 64 + n) * 2 + 1] = (ai * lr - nr * li) / den;
        float pr = 1.f, pi = 0.f;
        for (int k = 0; k <= 16; ++k) { APOW[((dir * 64 + n) * 17 + k) * 2] = pr; APOW[((dir * 64 + n) * 17 + k) * 2 + 1] = pi; const float qr = pr * ar - pi * ai, qi = pr * ai + pi * ar; pr = qr; pi = qi; }
        float* AT = (float*)(ws + WS_ATAB) + ((g * 2 + dir) * 64 + n) * 2;
        AT[0] = APOW[((dir * 64 + n) * 17 + 16) * 2]; AT[1] = APOW[((dir * 64 + n) * 17 + 16) * 2 + 1];
    }
    __syncthreads();
    for (int e = t; e < 2048; e += 512) {
        { const int dir = e >> 10, n = (e >> 4) & 63, q = e & 15; const size_t bi = ((size_t)(dir * SG + g) * 64 + n) * 16 + q;
          const float br = p.in[16][bi], bim = p.in[17][bi], fr = FF[(dir * 64 + n) * 2], fi = FF[(dir * 64 + n) * 2 + 1];
          BB[((dir * 64 + n) * 16 + q) * 2] = fr * br - fi * bim; BB[((dir * 64 + n) * 16 + q) * 2 + 1] = fr * bim + fi * br; }
        { const int dir = e >> 10, pp = (e >> 6) & 15, n = e & 63; const size_t ci = ((size_t)(dir * SG + g) * 16 + pp) * 64 + n;
          CC[((dir * 16 + pp) * 65 + n) * 2] = p.in[18][ci]; CC[((dir * 16 + pp) * 65 + n) * 2 + 1] = p.in[19][ci]; }
    }
    __syncthreads();
    {
        typedef float f32x2 __attribute__((ext_vector_type(2)));
        const int pp = t & 15, l = (t >> 4) & 15, dir = t >> 8;
        float acc[16];
#pragma unroll
        for (int q = 0; q < 16; ++q) acc[q] = 0.f;
        for (int n = 0; n < 64; ++n) {
            const f32x2 c = *(const f32x2*)(CC + ((dir * 16 + pp) * 65 + n) * 2), a = *(const f32x2*)(APOW + ((dir * 64 + n) * 17 + l) * 2);
            const float wr = c.x * a.x - c.y * a.y, wi = c.x * a.y + c.y * a.x;
#pragma unroll
            for (int q = 0; q < 16; ++q) { const f32x2 bq = *(const f32x2*)(BB + ((dir * 64 + n) * 16 + q) * 2); acc[q] += wr * bq.x - wi * bq.y; }
        }
#pragma unroll
        for (int q = 0; q < 16; ++q) KL[((dir * 16 + l) * 16 + pp) * 16 + q] = acc[q];
    }
    __syncthreads();
    for (int ch = t; ch < 8192; ch += 512) {
        const int lane = ch & 63, ks = (ch >> 6) & 15, nt = ch >> 10, np = nt * 32 + (lane & 31), dir = np >> 7, ri = (np >> 6) & 1, n = np & 63, q0 = (lane >> 5) * 8;
        const int pw = dir == 0 ? 15 - ks : ks;
        const float ar = APOW[((dir * 64 + n) * 17 + pw) * 2], ai = APOW[((dir * 64 + n) * 17 + pw) * 2 + 1];
        float z[8];
#pragma unroll
        for (int j = 0; j < 8; ++j) { const float br = BB[((dir * 64 + n) * 16 + q0 + j) * 2], bi = BB[((dir * 64 + n) * 16 + q0 + j) * 2 + 1]; z[j] = ri ? (ar * bi + ai * br) : (ar * br - ai * bi); }
        u32x4 o; o.x = cvtpk(z[0], z[1]); o.y = cvtpk(z[2], z[3]); o.z = cvtpk(z[4], z[5]); o.w = cvtpk(z[6], z[7]);
        *(u32x4*)(ws + WS_EMAT + ((size_t)((g * 8 + nt) * 16 + ks)) * 1024 + lane * 16) = o;
    }
    for (int ch = t; ch < 16384; ch += 512) {
        const int lane = ch & 63, ks = (ch >> 6) & 31, nt = ch >> 11, no = nt * 32 + (lane & 31), tau = no >> 4, pp = no & 15;
        float z[8];
        if (ks < 16) { const int sg = ks, q0 = (lane >> 5) * 8;
#pragma unroll
            for (int j = 0; j < 8; ++j) { const int q = q0 + j; float v = 0.f;
                if (sg <= tau) v += KL[((0 * 16 + (tau - sg)) * 16 + pp) * 16 + q];
                if (sg >= tau) v += KL[((1 * 16 + (sg - tau)) * 16 + pp) * 16 + q];
                if (sg == tau && pp == q) v += p.in[20][g * 16 + pp];
                z[j] = v; }
        } else { const int np0 = (ks - 16) * 16 + (lane >> 5) * 8, dir = np0 >> 7, ri = (np0 >> 6) & 1, n0 = np0 & 63, pw = dir == 0 ? tau + 1 : 16 - tau;
#pragma unroll
            for (int j = 0; j < 8; ++j) { const int n = n0 + j; const float cr = CC[((dir * 16 + pp) * 65 + n) * 2], ci = CC[((dir * 16 + pp) * 65 + n) * 2 + 1];
                const float ar = APOW[((dir * 64 + n) * 17 + pw) * 2], ai = APOW[((dir * 64 + n) * 17 + pw) * 2 + 1];
                z[j] = ri ? -(cr * ai + ci * ar) : (cr * ar - ci * ai); }
        }
        u32x4 o; o.x = cvtpk(z[0], z[1]); o.y = cvtpk(z[2], z[3]); o.z = cvtpk(z[4], z[5]); o.w = cvtpk(z[6], z[7]);
        *(u32x4*)(ws + WS_MFT + ((size_t)((g * 8 + nt) * 32 + ks)) * 1024 + lane * 16) = o;
    }
    __syncthreads();
}
__device__ __forceinline__ int crow16(int r, int hi) { return (r & 3) + 8 * (r >> 2) + 4 * hi; }
__device__ __forceinline__ void s5_estate(unsigned char* ws, int gw, int ngw, int lane) {
    for (int task = gw; task < SG * 16 * 2; task += ngw) {
        const int nh = task & 1, rt = (task >> 1) & 15, g = task >> 5, r32 = lane & 31, hi = lane >> 5;
        const bf16_t* A = (const bf16_t*)(ws + WS_UG) + ((size_t)(g * NROW + rt * 32 + r32)) * 256 + hi * 8;
        const unsigned char* B = ws + WS_EMAT + (size_t)(g * 8 + nh * 4) * 16 * 1024 + lane * 16;
        f32x16 acc[4] = {};
#pragma unroll 4
        for (int ks = 0; ks < 16; ++ks) { const bf16x8 a = *(const bf16x8*)(A + ks * 16);
#pragma unroll
            for (int nt = 0; nt < 4; ++nt) { const bf16x8 b = *(const bf16x8*)(B + (size_t)(nt * 16 + ks) * 1024); acc[nt] = __builtin_amdgcn_mfma_f32_32x32x16_bf16(a, b, acc[nt], 0, 0, 0); } }
        float* S = (float*)(ws + WS_SLOC) + ((size_t)(g * NROW + rt * 32)) * 256 + nh * 128 + r32;
#pragma unroll
        for (int nt = 0; nt < 4; ++nt)
#pragma unroll
            for (int r = 0; r < 16; ++r) S[(size_t)crow16(r, hi) * 256 + nt * 32] = acc[nt][r];
    }
}
__device__ __forceinline__ void s5_scan(unsigned char* ws, int gw, int ngw, int lane) {
    for (int task = gw; task < BATCH * SG * 2; task += ngw) {
        const int dir = task & 1, g = (task >> 1) & 63, b = task >> 7;
        const float* AT = (const float*)(ws + WS_ATAB) + ((g * 2 + dir) * 64 + lane) * 2; const float ar = AT[0], ai = AT[1];
        const float* S = (const float*)(ws + WS_SLOC) + ((size_t)(g * NROW + b * NCH)) * 256 + dir * 128 + lane;
        bf16_t* H = (bf16_t*)(ws + WS_HIN) + ((size_t)(g * NROW + b * NCH)) * 256 + dir * 128 + lane;
        float hr = 0.f, hi = 0.f;
        for (int c0 = 0; c0 < NCH; c0 += 16) {
            float sr[16], si[16];
#pragma unroll
            for (int k = 0; k < 16; ++k) { const int c = dir == 0 ? c0 + k : NCH - 1 - (c0 + k); sr[k] = S[(size_t)c * 256]; si[k] = S[(size_t)c * 256 + 64]; }
#pragma unroll
            for (int k = 0; k < 16; ++k) { const int c = dir == 0 ? c0 + k : NCH - 1 - (c0 + k);
                H[(size_t)c * 256] = (bf16_t)(cvtpk(hr, 0.f) & 0xffffu); H[(size_t)c * 256 + 64] = (bf16_t)(cvtpk(hi, 0.f) & 0xffffu);
                const float nr = ar * hr - ai * hi + sr[k], ni = ar * hi + ai * hr + si[k]; hr = nr; hi = ni; }
        }
    }
}
__device__ __forceinline__ void s5_output(unsigned char* ws, int gw, int ngw, int lane) {
    for (int task = gw; task < SG * 16 * 2; task += ngw) {
        const int nh = task & 1, rt = (task >> 1) & 15, g = task >> 5, r32 = lane & 31, hi = lane >> 5;
        const bf16_t* A0 = (const bf16_t*)(ws + WS_UG) + ((size_t)(g * NROW + rt * 32 + r32)) * 256 + hi * 8;
        const bf16_t* A1 = (const bf16_t*)(ws + WS_HIN) + ((size_t)(g * NROW + rt * 32 + r32)) * 256 + hi * 8;
        const unsigned char* B = ws + WS_MFT + (size_t)(g * 8 + nh * 4) * 32 * 1024 + lane * 16;
        f32x16 acc[4] = {};
#pragma unroll 4
        for (int ks = 0; ks < 16; ++ks) { const bf16x8 a = *(const bf16x8*)(A0 + ks * 16);
#pragma unroll
            for (int nt = 0; nt < 4; ++nt) { const bf16x8 b = *(const bf16x8*)(B + (size_t)(nt * 32 + ks) * 1024); acc[nt] = __builtin_amdgcn_mfma_f32_32x32x16_bf16(a, b, acc[nt], 0, 0, 0); } }
#pragma unroll 4
        for (int ks = 0; ks < 16; ++ks) { const bf16x8 a = *(const bf16x8*)(A1 + ks * 16);
#pragma unroll
            for (int nt = 0; nt < 4; ++nt) { const bf16x8 b = *(const bf16x8*)(B + (size_t)(nt * 32 + 16 + ks) * 1024); acc[nt] = __builtin_amdgcn_mfma_f32_32x32x16_bf16(a, b, acc[nt], 0, 0, 0); } }
        bf16_t* GBp = (bf16_t*)(ws + WS_GB);
#pragma unroll
        for (int nt = 0; nt < 4; ++nt) { const int no = nh * 128 + nt * 32 + r32, tau = no >> 4, pp = no & 15;
#pragma unroll
            for (int r = 0; r < 16; ++r) { const int crw = rt * 32 + crow16(r, hi); const float y = acc[nt][r];
                const float z2 = 1.5957691216057308f * (y + 0.044715f * y * y * y);
                const float gl = y * __builtin_amdgcn_rcpf(1.0f + __builtin_amdgcn_exp2f(-1.4426950408889634f * z2));
                GBp[(size_t)(crw * 16 + tau) * SW + g * 16 + pp] = (bf16_t)(cvtpk(gl, 0.f) & 0xffffu); } }
    }
}
#define XB_TMO      128
#define XB_XCNT(j)  (256  + 64 * (j))
#define XB_XSUB(j)  (1280 + 64 * (j))
#define XB_XGEN(j)  (2304 + 64 * (j))
#define XB_TOP      3328
#define XB_TOPGEN   3392
#define XCD_BAR_WORDS 3456
#define XB_SPIN_CAP (1u << 18)

__device__ __forceinline__ unsigned xb_ld(unsigned* p)              { return __hip_atomic_load(p, __ATOMIC_RELAXED, __HIP_MEMORY_SCOPE_AGENT); }
__device__ __forceinline__ unsigned xb_add(unsigned* p, unsigned v) { return __hip_atomic_fetch_add(p, v, __ATOMIC_RELAXED, __HIP_MEMORY_SCOPE_AGENT); }
__device__ __forceinline__ unsigned xb_xcc_id() { return (unsigned)__builtin_amdgcn_s_getreg((3 << 11) | 20) & 0xFu; }
#define XB_SPIN(cond, bar) do { unsigned _sp = 0; while (cond) { __builtin_amdgcn_s_sleep(1); \
    if ((++_sp & 255u) == 0u) { if (xb_ld(&(bar)[XB_TMO])) break; if (_sp > XB_SPIN_CAP) { atomicAdd(&(bar)[XB_TMO], 1u); break; } } } } while (0)

struct XcdBarrier {
    unsigned* bar; unsigned x;
    volatile LAS unsigned* st;
};

__device__ __forceinline__ XcdBarrier xcd_barrier_post(unsigned* bar, volatile LAS unsigned* st) {
    XcdBarrier b; b.bar = bar; b.x = xb_xcc_id(); b.st = st;
    if (threadIdx.x == 0) (void)xb_add(&bar[XB_XCNT(b.x)], 1u);
    return b;
}
__device__ __forceinline__ void xcd_barrier_complete(unsigned* bar, unsigned x, unsigned& nloc, unsigned& nx) {
    const unsigned G = gridDim.x * gridDim.y * gridDim.z;
    unsigned sum, cnt, mine, sp = 0u;
    for (;;) {
        sum = 0u; cnt = 0u; mine = 0u;
#pragma unroll
        for (unsigned j = 0; j < 16; ++j) { const unsigned c = xb_ld(&bar[XB_XCNT(j)]); sum += c; cnt += (c > 0u) ? 1u : 0u; mine = (j == x) ? c : mine; }
        if (sum == G) break;
        __builtin_amdgcn_s_sleep(1);
        if ((++sp & 255u) == 0u) { if (xb_ld(&bar[XB_TMO])) break; if (sp > XB_SPIN_CAP) { atomicAdd(&bar[XB_TMO], 1u); break; } }
    }
    nloc = mine > 0u ? mine : 1u; nx = cnt > 0u ? cnt : 1u;
}

__device__ __forceinline__ void xcd_barrier(const XcdBarrier& b) {
    asm volatile("s_waitcnt vmcnt(0)" ::: "memory");
    __syncthreads();
    if (threadIdx.x == 0) {
        unsigned* bar = b.bar;
        __builtin_amdgcn_s_waitcnt(0);
        unsigned nloc = b.st[0], nx = b.st[1];
        if (nloc == 0u) { xcd_barrier_complete(bar, b.x, nloc, nx); b.st[0] = nloc; b.st[1] = nx; }
        const unsigned old = xb_add(&bar[XB_XSUB(b.x)], 1u);
        const unsigned gen = old / nloc;
        if (old + 1u == (gen + 1u) * nloc) {
            __builtin_amdgcn_fence(__ATOMIC_RELEASE, "agent");
            asm volatile("s_waitcnt vmcnt(0)" ::: "memory");
            const unsigned og = xb_add(&bar[XB_TOP], 1u);
            const unsigned tg = og / nx;
            if (og + 1u == (tg + 1u) * nx) xb_add(&bar[XB_TOPGEN], 1u);
            else XB_SPIN(xb_ld(&bar[XB_TOPGEN]) == tg, bar);
            __builtin_amdgcn_fence(__ATOMIC_ACQUIRE, "agent");
            xb_add(&bar[XB_XGEN(b.x)], 1u);
            asm volatile("s_waitcnt vmcnt(0)" ::: "memory");
        } else {
            XB_SPIN(xb_ld(&bar[XB_XGEN(b.x)]) == gen, bar);
            __builtin_amdgcn_fence(__ATOMIC_ACQUIRE, "agent");
            asm volatile("s_waitcnt vmcnt(0)" ::: "memory");
        }
    }
    __syncthreads();
}

__global__ void __launch_bounds__(NWAVES * 64, 2) fwd_megakernel(Params p) {
    extern __shared__ __attribute__((aligned(16))) unsigned char lds[];
    cg::grid_group grid = cg::this_grid();
    const int tid = threadIdx.x, lane = tid & 63, wave = __builtin_amdgcn_readfirstlane(tid >> 6);
    const int G = gridDim.x, bx = blockIdx.x, vcu = (G % 8 == 0) ? (bx % 8) * (G / 8) + bx / 8 : bx;
    const int gw = vcu * NWAVES + wave, ngw = G * NWAVES;
    const int HB = G / 2, hgw = (bx - HB) * NWAVES + wave, hngw = (G - HB) * NWAVES;
    unsigned char* ws = p.ws;
    LAS unsigned char* ldsl = (LAS unsigned char*)lds;
    LAS float* scr = (LAS float*)(ldsl + wave * 8448);
    const int lo = p.ph_lo, hi = p.ph_hi;
#ifndef GU_SPLIT_PCT
#define GU_SPLIT_PCT 55
#endif
    constexpr int GU_SPLIT = GU_ITEMS / 100 * GU_SPLIT_PCT;
    if (tid < 2) ((volatile LAS unsigned*)(ldsl + LDS_BARST))[tid] = 0u;
    __syncthreads();
    XcdBarrier bar = xcd_barrier_post((unsigned*)(ws + WS_CTL), (volatile LAS unsigned*)(ldsl + LDS_BARST));
    if (hi > 1000) grid.sync();
#ifndef PH_MASK
#define PH_MASK 0x7fff
#endif
#define IN(k) (((PH_MASK >> (k)) & 1) && lo <= (k) && (k) < hi)
#ifndef DBL_MASK
#define DBL_MASK 0
#endif
#define REP(k) for (int _rp = 0; _rp < 1 + ((DBL_MASK >> (k)) & 1); ++_rp)
#ifndef SYNC_REP
#define SYNC_REP 1
#endif
#ifdef TSA
#define STAMP(i) do { if (bx == 0 && tid == 0) ((unsigned long long*)(ws + WS_CTL + 14336))[i] = __builtin_amdgcn_s_memrealtime(); } while (0)
#else
#define STAMP(i) do {} while (0)
#endif
#define SEAM(k) do { if (IN(k) && IN((k) + 1)) { for (int _r = 0; _r < SYNC_REP; ++_r) xcd_barrier(bar); } STAMP((k) + 1); } while (0)
    bf16_t* XN = (bf16_t*)(ws + WS_XN); bf16_t* X1 = (bf16_t*)(ws + WS_X1); float* RS = (float*)(ws + WS_RS); bf16_t* HFF = (bf16_t*)(ws + WS_HFF); bf16_t* Y = (bf16_t*)(ws + WS_Y); float* SSQ = (float*)(ws + WS_SSQ); float* SSQ2 = (float*)(ws + WS_SSQ2);
    bf16_t* QKV = (bf16_t*)(ws + WS_QKV); bf16_t* UG = (bf16_t*)(ws + WS_UG); bf16_t* GB = (bf16_t*)(ws + WS_GB); bf16_t* SPRE = (bf16_t*)(ws + WS_SPRE);

    STAMP(0);
    if (IN(0)) REP(0) {
        const int TB = G >= 128 ? G - 64 : G, NS = 2 * TB + (G - TB);
        for (int g = bx - TB; g >= 0 && g < SG; g += G - TB) s5_tables(p, g, (float*)lds);
        if (G < 128) for (int g = bx; g < SG; g += G) s5_tables(p, g, (float*)lds);
        const int nsl = bx < TB ? 2 : 1, sl0 = bx < TB ? 2 * bx : 2 * TB + (bx - TB);
        for (int sl = 0; sl < nsl; ++sl) {
            const int sgw = (sl0 + sl) * NWAVES + wave, sngw = NS * NWAVES;
            convert_gateup(p.in[2], p.in[3], p.in[1], ws, scr, sgw, sngw, lane);
            prenorm_rows(p.in[0], XN, RS, sgw, sngw, lane);
            convert_plain(p.in[24], SW, DM, (bf16_t*)(ws + WS_WOUT), scr, sgw, sngw, lane);
            convert_plain(p.in[24] + (size_t)SW * DM, SW, DM, (bf16_t*)(ws + WS_WOUT) + (size_t)DM * SW, scr, sgw, sngw, lane, p.in[23]);
            convert_plain(p.in[21], SW, SW, (bf16_t*)(ws + WS_WGLU), scr, sgw, sngw, lane);
        }
    }
    SEAM(0);
#define FFN_GATEUP(AIN) do { pg8::Gemm g{AIN, (const bf16_t*)(ws + WS_W1G), MT, NGU, DM}; pg8::StaticOrder S; S.init(MT, NGU, G, bx); \
            pg8::EpiSwiGLU E{HFF, DFF, RS}; pg8::gemm_phase<pg8::EpiSwiGLU, pg8::StaticOrder, true, true>(ldsl, g, S, E); } while (0)
#define FFN_DOWN() do { pg8::Gemm g{HFF, (const bf16_t*)(ws + WS_W1D), MT, DM, DFF}; pg8::StaticOrder S; S.init(MT, DM, G, bx); \
            pg8::EpiYSsq E{Y, SSQ, 32}; pg8::gemm_phase<pg8::EpiYSsq, pg8::StaticOrder, true, true>(ldsl, g, S, E); } while (0)
    if (IN(1)) REP(1) { FFN_GATEUP(XN);
        if (bx >= HB) {
            convert_plain(p.in[4], DFF, DM, (bf16_t*)(ws + WS_W1D), scr, hgw, hngw, lane);
            convert_plain(p.in[7], DM, INC, (bf16_t*)(ws + WS_WIN), scr, hgw, hngw, lane, p.in[6]);
        } }
    SEAM(1);
    if (IN(2)) REP(2) FFN_DOWN();
    SEAM(2);
    if (IN(3)) REP(3) resid_rows<false, false>(p.in[0], Y, SSQ, 32, p.in[5], 0.5f, nullptr, X1, RS, gw, ngw, lane);
    SEAM(3);
    if (IN(4)) REP(4) {
        pg8::Gemm g{X1, (const bf16_t*)(ws + WS_WIN), MT, INC, DM}; pg8::StaticOrder S; S.init(MT, INC, G, bx);
        pg8::EpiQKVU E{QKV, UG, 0.125f * 1.4426950408889634f, RS};
        pg8::gemm_phase<pg8::EpiQKVU, pg8::StaticOrder, true, true>(ldsl, g, S, E);
    }
    SEAM(4);
    if (IN(5)) {
        float lam;
        { const float a = wave_sum(p.in[8][lane] * p.in[9][lane]), c = wave_sum(p.in[10][lane] * p.in[11][lane]); lam = expf(a) - expf(c) + 0.2f; }
        #ifndef ATT_REP
#define ATT_REP 1
#endif
        for (int u = vcu; u < ATT_REP * BATCH * 8 * 16; u += G) att::attn_unit(QKV, XN, (u >> 7) & 3, (u >> 4) & 7, u & 15, lam, p.in[12], (char*)lds);
#ifndef EST_REP
#define EST_REP 1
#endif
        for (int _r = 0; _r < EST_REP; ++_r) s5_estate(ws, gw, ngw, lane);
    }
    SEAM(5);
    if (IN(6)) REP(6) { s5_scan(ws, gw, ngw, lane);
        if (vcu >= 64) convert_gateup(p.in[27], p.in[28], p.in[26], ws, scr, (vcu - 64) * NWAVES + wave, (G - 64) * NWAVES, lane, 0, GU_SPLIT); }
    SEAM(6);
    if (IN(7)) REP(7) s5_output(ws, gw, ngw, lane);
    SEAM(7);
    if (IN(8)) REP(8) {
        pg8::Gemm g{GB, (const bf16_t*)(ws + WS_WGLU), MT, SW, SW}; pg8::StaticOrder S; S.init(MT, SW, G, bx);
        pg8::EpiGLU E{GB, SPRE, p.in[22], SSQ2};
        pg8::gemm_phase<pg8::EpiGLU, pg8::StaticOrder, true, true>(ldsl, g, S, E);
        if (bx >= HB) convert_gateup(p.in[27], p.in[28], p.in[26], ws, scr, hgw, hngw, lane, GU_SPLIT, GU_ITEMS);
        __syncthreads();
        { pg8::Gemm g2{XN, (const bf16_t*)(ws + WS_WOUT), MT, DM, SW}; pg8::StaticOrder S2; S2.init(MT, DM, G, bx);
          pg8::EpiPart E2{(bf16_t*)(ws + WS_YPART)};
          pg8::gemm_phase<pg8::EpiPart, pg8::StaticOrder, true, true>(ldsl, g2, S2, E2); }
    }
    do { if (IN(8) && IN(10)) xcd_barrier(bar); } while (0);
    if (IN(10)) REP(10) {
        pg8::Gemm g{SPRE, (const bf16_t*)(ws + WS_WOUT) + (size_t)DM * SW, MT, DM, SW}; pg8::StaticOrder S; S.init(MT, DM, G, bx);
        pg8::EpiYSsqAdd E{Y, SSQ, (const bf16_t*)(ws + WS_YPART), SSQ2};
        pg8::gemm_phase<pg8::EpiYSsqAdd, pg8::StaticOrder, true, true>(ldsl, g, S, E);
    }
    SEAM(10);
    if (IN(11)) resid_rows<true, false>(X1, Y, SSQ, 32, p.in[25], 1.0f, nullptr, X1, RS, gw, ngw, lane);
    SEAM(11);
    if (IN(12)) { FFN_GATEUP(X1);
        if (bx >= HB) convert_plain(p.in[29], DFF, DM, (bf16_t*)(ws + WS_W1D), scr, hgw, hngw, lane); }
    SEAM(12);
    if (IN(13)) FFN_DOWN();
    SEAM(13);
    if (IN(14)) resid_rows<true, true>(X1, Y, SSQ, 32, p.in[30], 0.5f, p.out, nullptr, nullptr, gw, ngw, lane);
#ifdef TSA
    xcd_barrier(bar); STAMP(15); xcd_barrier(bar);
    { const unsigned long long* TS = (const unsigned long long*)(ws + WS_CTL + 14336);
      const float ta = (float)(TS[TSA + 1] - TS[TSA]) * 0.01f, tb = (TSB == 99) ? 100.f : (float)(TS[(TSB == 99 ? 0 : TSB) + 1] - TS[(TSB == 99 ? 0 : TSB)]) * 0.01f;
      for (size_t i = (size_t)bx * 512 + tid; i < (size_t)MT * DM; i += (size_t)G * 512) p.out[i] += 1000.f * tb;
      __syncthreads();
      if (bx == 0 && tid == 0) p.out[0] += 64000.f * ta; }
#endif
#undef IN
#undef SEAM
}

extern "C" void kernel_launch(void* const* d_in, const int* in_sizes, int n_in, void* d_out, int out_size, void* d_ws, size_t ws_size, hipStream_t stream) {
    static int grid = 0;
    if (grid == 0) {
        if (n_in != 31 || in_sizes[0] != MT * DM || out_size != MT * DM || ws_size < WS_END) {
            fprintf(stderr, "kernel_launch: shape/workspace mismatch: n_in %d in0 %d out %d ws %zu (need %zu)\n", n_in, n_in > 0 ? in_sizes[0] : -1, out_size, ws_size, (size_t)WS_END); grid = -1; return; }
        int dev = 0, cus = 0, per_cu = 0;
        hipGetDevice(&dev); hipDeviceGetAttribute(&cus, hipDeviceAttributeMultiprocessorCount, dev);
        if (hipFuncSetAttribute((const void*)fwd_megakernel, hipFuncAttributeMaxDynamicSharedMemorySize, LDS_BYTES) != hipSuccess) { fprintf(stderr, "kernel_launch: hipFuncSetAttribute failed\n"); grid = -1; return; }
        if (hipOccupancyMaxActiveBlocksPerMultiprocessor(&per_cu, (const void*)fwd_megakernel, NWAVES * 64, LDS_BYTES) != hipSuccess || per_cu < 1) { fprintf(stderr, "kernel_launch: occupancy query says %d\n", per_cu); (void)hipGetLastError(); per_cu = 1; }
        grid = cus;
        fprintf(stderr, "kernel_launch: grid %d (cus %d x per_cu %d), ws %zu need %zu\n", grid, cus, per_cu, ws_size, (size_t)WS_END);
    }
    if (grid < 0) return;
    if (hipMemsetAsync((char*)d_ws + WS_CTL, 0, CTL_BYTES, stream) != hipSuccess) { fprintf(stderr, "kernel_launch: memset failed\n"); return; }
    Params p{};
    for (int i = 0; i < 31; ++i) p.in[i] = (const float*)d_in[i];
    p.out = (float*)d_out; p.ws = (unsigned char*)d_ws;
#if MK_N_LAUNCHES == 1
    p.ph_lo = 0; p.ph_hi = 15;
    void* args[] = {&p};
    hipError_t e = hipLaunchCooperativeKernel((const void*)fwd_megakernel, dim3(grid), dim3(NWAVES * 64), args, LDS_BYTES, stream);
    if (e != hipSuccess) fprintf(stderr, "cooperative launch failed: %s (grid %d)\n", hipGetErrorString(e), grid);
#else
    for (int k = 0; k < 15; ++k) { p.ph_lo = k; p.ph_hi = k + 1; hipLaunchKernelGGL(fwd_megakernel, dim3(grid), dim3(NWAVES * 64), LDS_BYTES, stream, p); }
#endif
}
```

```cpp
#include <hip/hip_runtime.h>
#include <hip/hip_cooperative_groups.h>
#include <cstdio>
#include <cstdint>
namespace cg = cooperative_groups;
#ifndef MK_N_LAUNCHES
#define MK_N_LAUNCHES 1
#endif
namespace pg8 {
#define PG8_LAS __attribute__((address_space(3)))
typedef unsigned short bf16_t;
typedef short bf16x8 __attribute__((ext_vector_type(8)));
typedef float f32x4 __attribute__((ext_vector_type(4)));
typedef unsigned u32x4 __attribute__((ext_vector_type(4)));
constexpr int BM = 256, BK = 64, HALF = 128, HTB = HALF * BK * 2  , STAGE_BYTES = 8 * HTB, NXCD = 8, WGM = 8;

__host__ __device__ __forceinline__ int lds_byte(int r, int c) { const int st = (r >> 4) * 2 + (c >> 5), rr = r & 15, cc = c & 31, ob = rr * 64 + cc * 2; return st * 1024 + (ob ^ (((ob >> 9) & 1) << 5)); }
__host__ __device__ __forceinline__ void stage_rc(int b, int& R, int& C) { const int st = b / 1024, sb = b % 1024, swz = sb ^ (((sb >> 9) & 1) << 5); R = (st >> 1) * 16 + swz / 64; C = (st & 1) * 32 + (swz % 64) / 2; }
__host__ __device__ __forceinline__ int perm32(int rho) { const int n = rho >> 4, i = rho & 15; return 8 * (i >> 2) + 4 * n + (i & 3); }

struct Unit { int pm, pn; };
struct Gemm { const bf16_t* A; const bf16_t* Bt; int M, N, K; };

struct StaticOrder {
    int nM, nN, nwg, G, c;
    __host__ __device__ void init(int M, int N, int G_, int c_) { nM = M / BM; nN = N / BM; nwg = nM * nN; G = G_; c = c_; }
    __host__ __device__ bool next(int i, Unit& u) const {
        const long L = (long)i * G + c; if (L >= nwg) return false;
        int wgid = (int)L; { const int q = nwg / NXCD, r = nwg % NXCD, xcd = wgid % NXCD, off = wgid / NXCD; wgid = (xcd < r ? xcd * (q + 1) : r * (q + 1) + (xcd - r) * q) + off; }
        const int nig = WGM * nN, gid = wgid / nig, fm = gid * WGM, gsz = (nM - fm) < WGM ? (nM - fm) : WGM;
        u.pm = fm + ((wgid % nig) % gsz); u.pn = (wgid % nig) / gsz; return true;
    }
    __device__ __forceinline__ void a_ready(const Unit&) const {}
    __device__ __forceinline__ void done(const Unit&) const {}
};

__device__ __forceinline__ unsigned cvt_pk_bf16(float lo, float hi) { unsigned r; asm volatile("v_cvt_pk_bf16_f32 %0, %1, %2" : "=v"(r) : "v"(lo), "v"(hi)); return r; }
typedef unsigned u32x2 __attribute__((ext_vector_type(2)));
__device__ __forceinline__ float bf_lo(unsigned w) { return __uint_as_float(w << 16); }
__device__ __forceinline__ float bf_hi(unsigned w) { return __uint_as_float(w & 0xffff0000u); }
__device__ __forceinline__ float sigmoid_f(float z) { return __builtin_amdgcn_rcpf(1.0f + __builtin_amdgcn_exp2f(-1.4426950408889634f * z)); }
__device__ __forceinline__ float silu_f(float z) { return z * sigmoid_f(z); }

struct EpiSwiGLU {
    static constexpr bool PERM = true, AFTER_DRAIN = false;
    bf16_t* O; int ldc; const float* RS;
    __device__ __forceinline__ void operator()(const f32x4 (&acc)[2][2][4][2], const Unit& u, int wr, int wc, int fr, int fq) const {
        const int row0 = u.pm * BM + wr * 64 + fr, col0 = u.pn * HALF + wc * 32 + 8 * fq;
#pragma unroll
        for (int ai = 0; ai < 2; ++ai)
#pragma unroll
            for (int m = 0; m < 4; ++m) {
                bf16_t* rowp = O + (size_t)(row0 + ai * HALF + m * 16) * ldc + col0;
                const float rr = RS[row0 + ai * HALF + m * 16];
                const f32x4 g0 = acc[ai][0][m][0] * rr, g1 = acc[ai][0][m][1] * rr, u0 = acc[ai][1][m][0] * rr, u1 = acc[ai][1][m][1] * rr;
                u32x4 w;
                w.x = cvt_pk_bf16(silu_f(g0[0]) * u0[0], silu_f(g0[1]) * u0[1]); w.y = cvt_pk_bf16(silu_f(g0[2]) * u0[2], silu_f(g0[3]) * u0[3]);
                w.z = cvt_pk_bf16(silu_f(g1[0]) * u1[0], silu_f(g1[1]) * u1[1]); w.w = cvt_pk_bf16(silu_f(g1[2]) * u1[2], silu_f(g1[3]) * u1[3]);
                *(u32x4*)rowp = w;
            }
    }
};
struct EpiQKVU {
    static constexpr bool PERM = true, AFTER_DRAIN = false;
    bf16_t* QKV; bf16_t* UG; float qscale; const float* RS;
    __device__ __forceinline__ void operator()(const f32x4 (&acc)[2][2][4][2], const Unit& u, int wr, int wc, int fr, int fq) const {
        const int row0 = u.pm * BM + wr * 64 + fr, colt = u.pn * BM;
        const float sc = colt < 1024 ? qscale : 1.0f;
#pragma unroll
        for (int ai = 0; ai < 2; ++ai)
#pragma unroll
            for (int m = 0; m < 4; ++m) {
                const int row = row0 + ai * HALF + m * 16; const float scr = sc * RS[row];
#pragma unroll
                for (int bj = 0; bj < 2; ++bj) {
                    const int col = colt + bj * HALF + wc * 32 + 8 * fq;
                    const f32x4 v0 = acc[ai][bj][m][0] * scr, v1 = acc[ai][bj][m][1] * scr;
                    u32x4 w; w.x = cvt_pk_bf16(v0[0], v0[1]); w.y = cvt_pk_bf16(v0[2], v0[3]); w.z = cvt_pk_bf16(v1[0], v1[1]); w.w = cvt_pk_bf16(v1[2], v1[3]);
                    bf16_t* dst;
                    if (colt < 3072) dst = QKV + (size_t)row * 3072 + col;
                    else { const int cc = col - 3072; dst = UG + ((size_t)((cc >> 4) * 512 + (row >> 4)) * 256 + (row & 15) * 16 + (cc & 15)); }
                    *(u32x4*)dst = w;
                }
            }
    }
};
struct EpiYSsq {
    static constexpr bool PERM = true, AFTER_DRAIN = false;
    bf16_t* Y; float* SSQ; int npart;
    __device__ __forceinline__ void operator()(const f32x4 (&acc)[2][2][4][2], const Unit& u, int wr, int wc, int fr, int fq) const {
        const int row0 = u.pm * BM + wr * 64 + fr, col0 = u.pn * BM + wc * 32 + 8 * fq;
#pragma unroll
        for (int ai = 0; ai < 2; ++ai)
#pragma unroll
            for (int m = 0; m < 4; ++m) {
                const int row = row0 + ai * HALF + m * 16; float s = 0.f;
#pragma unroll
                for (int bj = 0; bj < 2; ++bj) { const f32x4 v0 = acc[ai][bj][m][0], v1 = acc[ai][bj][m][1];
                    s += (v0[0] * v0[0] + v0[1] * v0[1]) + (v0[2] * v0[2] + v0[3] * v0[3]) + (v1[0] * v1[0] + v1[1] * v1[1]) + (v1[2] * v1[2] + v1[3] * v1[3]);
                    u32x4 w; w.x = cvt_pk_bf16(v0[0], v0[1]); w.y = cvt_pk_bf16(v0[2], v0[3]); w.z = cvt_pk_bf16(v1[0], v1[1]); w.w = cvt_pk_bf16(v1[2], v1[3]);
                    *(u32x4*)(Y + (size_t)row * 2048 + col0 + bj * HALF) = w; }
                s += __shfl_xor(s, 16); s += __shfl_xor(s, 32);
                if (fq == 0) SSQ[(size_t)row * npart + u.pn * 4 + wc] = s;
            }
    }
};
struct EpiGLU {
    static constexpr bool PERM = true, AFTER_DRAIN = false;
    const bf16_t* GB; bf16_t* SPRE; const float* bias; float* SSQ2;
    __device__ __forceinline__ void operator()(const f32x4 (&acc)[2][2][4][2], const Unit& u, int wr, int wc, int fr, int fq) const {
        const int row0 = u.pm * BM + wr * 64 + fr, colb = u.pn * BM + wc * 32 + 8 * fq;
#pragma unroll
        for (int ai = 0; ai < 2; ++ai)
#pragma unroll
            for (int m = 0; m < 4; ++m) {
                const int row = row0 + ai * HALF + m * 16; float s = 0.f;
#pragma unroll
                for (int bj = 0; bj < 2; ++bj) {
                    const int col = colb + bj * HALF;
                    const u32x4 gw = *(const u32x4*)(GB + (size_t)row * 1024 + col);
                    const f32x4 b0 = *(const f32x4*)(bias + col), b1 = *(const f32x4*)(bias + col + 4);
                    const f32x4 z0 = acc[ai][bj][m][0] + b0, z1 = acc[ai][bj][m][1] + b1;
                    float o[8];
                    o[0] = bf_lo(gw.x) * sigmoid_f(z0[0]); o[1] = bf_hi(gw.x) * sigmoid_f(z0[1]); o[2] = bf_lo(gw.y) * sigmoid_f(z0[2]); o[3] = bf_hi(gw.y) * sigmoid_f(z0[3]);
                    o[4] = bf_lo(gw.z) * sigmoid_f(z1[0]); o[5] = bf_hi(gw.z) * sigmoid_f(z1[1]); o[6] = bf_lo(gw.w) * sigmoid_f(z1[2]); o[7] = bf_hi(gw.w) * sigmoid_f(z1[3]);
#pragma unroll
                    for (int k = 0; k < 8; ++k) s += o[k] * o[k];
                    u32x4 w; w.x = cvt_pk_bf16(o[0], o[1]); w.y = cvt_pk_bf16(o[2], o[3]); w.z = cvt_pk_bf16(o[4], o[5]); w.w = cvt_pk_bf16(o[6], o[7]);
                    *(u32x4*)(SPRE + (size_t)row * 1024 + col) = w;
                }
                s += __shfl_xor(s, 16); s += __shfl_xor(s, 32);
                if (fq == 0) SSQ2[(size_t)row * 16 + u.pn * 4 + wc] = s;
            }
    }
};
template <class Epi, class Sched, bool ALIGN_EPI = false, bool SP2 = false>
__device__ __forceinline__ void gemm_phase(PG8_LAS unsigned char* lds, const Gemm g, const Sched& S, const Epi& E) {
    const int tid = threadIdx.x, wid = __builtin_amdgcn_readfirstlane(tid >> 6), lane = tid & 63, wr = wid >> 2, wc = wid & 3, fr = lane & 15, fq = lane >> 4;
    const int K = g.K, nt = K / BK;
    unsigned voffA[2], voffB[2];
#pragma unroll
    for (int i = 0; i < 2; ++i) { int R, C; stage_rc(tid * 16 + i * 8192, R, C); const int Rb = Epi::PERM ? ((R & ~31) + perm32(R & 31)) : R;
        voffA[i] = (unsigned)(R * K + C) * 2u; voffB[i] = (unsigned)(Rb * K + C) * 2u; }
    const size_t kstep = (size_t)(BK * 2);
    const size_t hstep = (size_t)HALF * K * 2;
    const size_t tstep = 2 * hstep;
    const unsigned ldsw = (unsigned)wid * 1024u;
    const int aoff = lds_byte(wr * 64 + fr, fq * 8), boff = lds_byte(wc * 32 + fr, fq * 8);
#define PG8_SA(b, h) (((b) * 2 + (h)) * HTB)
#define PG8_SB(b, h) ((4 + (b) * 2 + (h)) * HTB)
#define PG8_STAGE(bufoff, gbase, voff) do { _Pragma("unroll") for (int _i = 0; _i < 2; ++_i) \
        __builtin_amdgcn_global_load_lds((const unsigned*)((const char*)(gbase) + (voff)[_i]), (PG8_LAS unsigned*)(lds + (bufoff) + ldsw + _i * 8192), 16, 0, 0); } while (0)
#define PG8_LDA(dst, b, h) do { _Pragma("unroll") for (int m = 0; m < 4; ++m) _Pragma("unroll") for (int k = 0; k < 2; ++k) dst[m][k] = *(const PG8_LAS bf16x8*)(lds + PG8_SA(b, h) + aoff + m * 2048 + k * 1024); } while (0)
#define PG8_LDB(dst, b, h) do { _Pragma("unroll") for (int n = 0; n < 2; ++n) _Pragma("unroll") for (int k = 0; k < 2; ++k) dst[n][k] = *(const PG8_LAS bf16x8*)(lds + PG8_SB(b, h) + boff + n * 2048 + k * 1024); } while (0)
#define PG8_MMA(ai, bj, At, Bt) do { __builtin_amdgcn_s_setprio(1); _Pragma("unroll") for (int m = 0; m < 4; ++m) _Pragma("unroll") for (int n = 0; n < 2; ++n) _Pragma("unroll") for (int k = 0; k < 2; ++k) \
        acc[ai][bj][m][n] = __builtin_amdgcn_mfma_f32_16x16x32_bf16(Bt[n][k], At[m][k], acc[ai][bj][m][n], 0, 0, 0); __builtin_amdgcn_s_setprio(0); } while (0)
#define PG8_WAIT_V(n) asm volatile("s_waitcnt vmcnt(" #n ")" ::: "memory")
#define PG8_WAIT_L(n) asm volatile("s_waitcnt lgkmcnt(" #n ")" ::: "memory")
#define PG8_BAR __builtin_amdgcn_s_barrier()
#define PG8_SCHED __builtin_amdgcn_sched_barrier(0)
    Unit cur, nxt; int ui = 0;
    if (!S.next(0, cur)) return;
    f32x4 acc[2][2][4][2];
#pragma unroll
    for (int a = 0; a < 2; ++a)
#pragma unroll
        for (int b = 0; b < 2; ++b)
#pragma unroll
            for (int m = 0; m < 4; ++m)
#pragma unroll
                for (int n = 0; n < 2; ++n) acc[a][b][m][n] = (f32x4){0.f, 0.f, 0.f, 0.f};
    bf16x8 At[4][2], B0[2][2], B1[2][2];
    const char* cA = (const char*)g.A + (size_t)cur.pm * tstep; const char* cB = (const char*)g.Bt + (size_t)cur.pn * tstep;
    S.a_ready(cur);
    if constexpr (SP2) {
        PG8_STAGE(PG8_SB(0, 0), cB, voffB); PG8_STAGE(PG8_SB(0, 1), cB + hstep, voffB); PG8_STAGE(PG8_SA(0, 0), cA, voffA); PG8_STAGE(PG8_SA(0, 1), cA + hstep, voffA);
        if (wr == 1) PG8_BAR;
        PG8_WAIT_V(2); PG8_BAR;
        PG8_STAGE(PG8_SB(1, 0), cB + kstep, voffB); PG8_STAGE(PG8_SA(1, 0), cA + kstep, voffA); PG8_STAGE(PG8_SB(1, 1), cB + hstep + kstep, voffB);
        PG8_WAIT_V(6); PG8_BAR;
    } else {
        PG8_STAGE(PG8_SB(0, 0), cB, voffB); PG8_STAGE(PG8_SA(0, 0), cA, voffA); PG8_STAGE(PG8_SB(0, 1), cB + hstep, voffB); PG8_STAGE(PG8_SA(0, 1), cA + hstep, voffA);
        if (wr == 1) PG8_BAR;
        PG8_WAIT_V(4); PG8_BAR;
        PG8_STAGE(PG8_SB(1, 0), cB + kstep, voffB); PG8_STAGE(PG8_SA(1, 0), cA + kstep, voffA); PG8_STAGE(PG8_SB(1, 1), cB + hstep + kstep, voffB);
        PG8_WAIT_V(6); PG8_BAR;
    }
    for (;;) {
        const bool has_next = S.next(ui + 1, nxt);
        const char* nA = has_next ? (const char*)g.A + (size_t)nxt.pm * tstep : cA; const char* nB = has_next ? (const char*)g.Bt + (size_t)nxt.pn * tstep : cB;
        for (int t = 0; t < nt; t += 2) {
            const bool last = (t == nt - 2);
            const char* a1 = cA + (size_t)(t + 1) * kstep;
            const char* a2 = last ? nA : cA + (size_t)(t + 2) * kstep; const char* b2 = last ? nB : cB + (size_t)(t + 2) * kstep;
            const char* a3 = a2 + kstep; const char* b3 = b2 + kstep;
            if (last && has_next) S.a_ready(nxt);
            if constexpr (SP2) {
            PG8_LDB(B0, 0, 0); PG8_LDB(B1, 0, 1); PG8_SCHED; PG8_LDA(At, 0, 0); PG8_STAGE(PG8_SA(1, 1), a1 + hstep, voffA);
            PG8_WAIT_V(8); PG8_WAIT_L(0); PG8_BAR; PG8_MMA(0, 0, At, B0); PG8_MMA(0, 1, At, B1); PG8_BAR; PG8_SCHED;
            PG8_LDA(At, 0, 1); PG8_STAGE(PG8_SB(0, 0), b2, voffB); PG8_STAGE(PG8_SB(0, 1), b2 + hstep, voffB); PG8_STAGE(PG8_SA(0, 0), a2, voffA);
            PG8_WAIT_V(8); PG8_WAIT_L(0); PG8_BAR; PG8_MMA(1, 0, At, B0); PG8_MMA(1, 1, At, B1); PG8_BAR; PG8_SCHED;
            PG8_LDB(B0, 1, 0); PG8_LDB(B1, 1, 1); PG8_SCHED; PG8_LDA(At, 1, 0); PG8_STAGE(PG8_SA(0, 1), a2 + hstep, voffA);
            PG8_WAIT_V(8); PG8_WAIT_L(0); PG8_BAR; PG8_MMA(0, 0, At, B0); PG8_MMA(0, 1, At, B1); PG8_BAR; PG8_SCHED;
            PG8_LDA(At, 1, 1); PG8_STAGE(PG8_SB(1, 0), b3, voffB); PG8_STAGE(PG8_SB(1, 1), b3 + hstep, voffB); PG8_STAGE(PG8_SA(1, 0), a3, voffA);
            PG8_WAIT_V(8); PG8_WAIT_L(0); PG8_BAR; PG8_MMA(1, 0, At, B0); PG8_MMA(1, 1, At, B1); PG8_BAR; PG8_SCHED;
            } else {
            PG8_LDB(B0, 0, 0); PG8_SCHED; PG8_LDA(At, 0, 0); PG8_STAGE(PG8_SA(1, 1), a1 + hstep, voffA);
            PG8_WAIT_L(8); PG8_BAR; PG8_WAIT_L(0); PG8_MMA(0, 0, At, B0); PG8_BAR; PG8_SCHED;
            PG8_LDB(B1, 0, 1); PG8_STAGE(PG8_SB(0, 0), b2, voffB);
            PG8_BAR; PG8_WAIT_L(0); PG8_MMA(0, 1, At, B1); PG8_BAR;
            PG8_LDA(At, 0, 1); PG8_STAGE(PG8_SA(0, 0), a2, voffA);
            PG8_BAR; PG8_WAIT_L(0); PG8_MMA(1, 0, At, B0); PG8_BAR; PG8_SCHED;
            PG8_STAGE(PG8_SB(0, 1), b2 + hstep, voffB);
            PG8_WAIT_V(6); PG8_BAR; PG8_MMA(1, 1, At, B1); PG8_BAR;
            PG8_LDB(B0, 1, 0); PG8_SCHED; PG8_LDA(At, 1, 0); PG8_STAGE(PG8_SA(0, 1), a2 + hstep, voffA);
            PG8_WAIT_L(8); PG8_BAR; PG8_WAIT_L(0); PG8_MMA(0, 0, At, B0); PG8_BAR; PG8_SCHED;
            PG8_LDB(B1, 1, 1); PG8_STAGE(PG8_SB(1, 0), b3, voffB);
            PG8_BAR; PG8_WAIT_L(0); PG8_MMA(0, 1, At, B1); PG8_BAR;
            PG8_LDA(At, 1, 1); PG8_STAGE(PG8_SA(1, 0), a3, voffA);
            PG8_BAR; PG8_WAIT_L(0); PG8_MMA(1, 0, At, B0); PG8_BAR; PG8_SCHED;
            PG8_STAGE(PG8_SB(1, 1), b3 + hstep, voffB);
            PG8_WAIT_V(6); PG8_BAR; PG8_MMA(1, 1, At, B1); PG8_BAR;
            }
        }
        if constexpr (ALIGN_EPI) { if (wr == 0) PG8_BAR; }
        if constexpr (!Epi::AFTER_DRAIN) { E(acc, cur, wr, wc, fr, fq); S.done(cur); }
        if (!has_next) break;
#pragma unroll
        for (int a = 0; a < 2; ++a)
#pragma unroll
            for (int b = 0; b < 2; ++b)
#pragma unroll
                for (int m = 0; m < 4; ++m)
#pragma unroll
                    for (int n = 0; n < 2; ++n) acc[a][b][m][n] = (f32x4){0.f, 0.f, 0.f, 0.f};
        cur = nxt; cA = nA; cB = nB; ++ui;
        if constexpr (ALIGN_EPI) { if (wr == 1) PG8_BAR; }
    }
    PG8_WAIT_V(0);
    if constexpr (!ALIGN_EPI) { if (wr == 0) PG8_BAR; }
    PG8_BAR;
    if constexpr (Epi::AFTER_DRAIN) { E.fused(acc, cur, wr, wc, fr, fq, lds, wid, lane); S.done(cur); }
#undef PG8_SA
#undef PG8_SB
#undef PG8_STAGE
#undef PG8_LDA
#undef PG8_LDB
#undef PG8_MMA
#undef PG8_WAIT_V
#undef PG8_WAIT_L
#undef PG8_BAR
#undef PG8_SCHED
}
}
namespace att {
typedef short bf16x8 __attribute__((ext_vector_type(8)));
typedef short s16x4 __attribute__((ext_vector_type(4)));
typedef float f32x16 __attribute__((ext_vector_type(16)));
typedef float f32x4 __attribute__((ext_vector_type(4)));
typedef unsigned u32x4 __attribute__((ext_vector_type(4)));
typedef unsigned short bf16_t;
constexpr int KVBLK = 64, LDK = 3072, NT = 2048 / KVBLK;
constexpr int SHM_V = KVBLK * 128 * 2, SHM_K = KVBLK * 128 * 2;
constexpr int WS_OFF = 131072;
constexpr float THRL = 11.5f;
#ifndef ATT_SDEPTH
#define ATT_SDEPTH 1
#endif
constexpr int SDEPTH = ATT_SDEPTH;
#define KSWZ(row, colB) ((row) * 256 + ((colB) ^ (((row) & 7) << 4)))
#define SBAR() __builtin_amdgcn_sched_barrier(0)
__device__ __forceinline__ int crow(int r, int hi) { return (r & 3) + 8 * (r >> 2) + 4 * hi; }
__device__ __forceinline__ unsigned cvtpk(float lo, float hi) { unsigned r; asm volatile("v_cvt_pk_bf16_f32 %0, %1, %2" : "=v"(r) : "v"(lo), "v"(hi)); return r; }

__device__ __forceinline__ void partialSM(f32x16& p0, f32x16& p1, float& m_reg, float& mn, float& alpha) {
  float pmax = p0[0];
#pragma unroll
  for (int r = 1; r < 16; ++r) pmax = fmaxf(pmax, p0[r]);
#pragma unroll
  for (int r = 0; r < 16; ++r) pmax = fmaxf(pmax, p1[r]);
  { auto rr = __builtin_amdgcn_permlane32_swap(__float_as_uint(pmax), __float_as_uint(pmax), false, false);
    pmax = fmaxf(__uint_as_float(rr[0]), __uint_as_float(rr[1])); }
  if (__builtin_expect(__all(pmax - m_reg <= THRL), 1)) { mn = m_reg; alpha = 1.f; }
  else { mn = fmaxf(m_reg, pmax); alpha = __builtin_amdgcn_exp2f(m_reg - mn); m_reg = mn; }
#pragma unroll
  for (int r = 0; r < 16; ++r) p0[r] = p0[r] - mn;
#pragma unroll
  for (int r = 0; r < 16; ++r) p1[r] = p1[r] - mn;
#pragma unroll
  for (int r = 0; r < 16; ++r) p0[r] = __builtin_amdgcn_exp2f(p0[r]);
}
__device__ __forceinline__ void finishSM(f32x16& p0, f32x16& p1, float alpha, float& l_reg, bf16x8& pa0, bf16x8& pa1, bf16x8& pa2, bf16x8& pa3) {
#pragma unroll
  for (int r = 0; r < 16; ++r) p1[r] = __builtin_amdgcn_exp2f(p1[r]);
  float ps = 0;
#pragma unroll
  for (int r = 0; r < 16; ++r) ps += p0[r];
#pragma unroll
  for (int r = 0; r < 16; ++r) ps += p1[r];
  { auto rr = __builtin_amdgcn_permlane32_swap(__float_as_uint(ps), __float_as_uint(ps), false, false);
    ps = __uint_as_float(rr[0]) + __uint_as_float(rr[1]); }
  l_reg = l_reg * alpha + ps;
#define PK4(P, BASE, OUT) do { unsigned a0 = cvtpk(P[BASE + 0], P[BASE + 1]), a1 = cvtpk(P[BASE + 2], P[BASE + 3]);   \
    unsigned b0 = cvtpk(P[BASE + 4], P[BASE + 5]), b1 = cvtpk(P[BASE + 6], P[BASE + 7]);                              \
    auto r0 = __builtin_amdgcn_permlane32_swap(a0, b0, false, false); auto r1 = __builtin_amdgcn_permlane32_swap(a1, b1, false, false); \
    u32x4 w = {r0[0], r1[0], r0[1], r1[1]}; OUT = *reinterpret_cast<bf16x8*>(&w); } while (0)
  PK4(p0, 0, pa0); PK4(p0, 8, pa1); PK4(p1, 0, pa2); PK4(p1, 8, pa3);
#undef PK4
}
__device__ __forceinline__ void qkt(f32x16& p0, f32x16& p1, const char* Ks, const char* qr, int r32, int hi, int cofs, float dq, float nsl) {
#pragma unroll
  for (int r = 0; r < 16; ++r) { const float cr = (float)((r & 3) + 8 * (r >> 2)); p0[r] = nsl * __builtin_fabsf(dq - cr); p1[r] = nsl * __builtin_fabsf(dq - (32.f + cr)); }
#pragma unroll
  for (int d0 = 0; d0 < 4; ++d0) { const int cb = cofs + d0 * 32 + hi * 16;
    bf16x8 b0 = *reinterpret_cast<const bf16x8*>(Ks + KSWZ(r32, cb));
    bf16x8 b1 = *reinterpret_cast<const bf16x8*>(Ks + KSWZ(32 + r32, cb));
    const bf16x8 qf = *reinterpret_cast<const bf16x8*>(qr + d0 * 1024);
    p0 = __builtin_amdgcn_mfma_f32_32x32x16_bf16(b0, qf, p0, 0, 0, 0);
    p1 = __builtin_amdgcn_mfma_f32_32x32x16_bf16(b1, qf, p1, 0, 0, 0); }
}
__device__ __forceinline__ int v_st(int k, int c) { const int kk = (k & ~0xC) | ((k & 4) << 1) | ((k & 8) >> 1); return ((kk >> 3) * 4 + (c >> 5)) * 512 + ((kk & 7) * 32 + (c & 31)) * 2; }
__device__ __forceinline__ int v_rd_base(int lane) { return ((lane & 3) << 3) | (((lane >> 2) & 3) << 6) | (((lane >> 4) & 1) << 5) | (((lane >> 5) & 1) << 8); }
constexpr int v_rd_off(int d0, int ks, int half) { return d0 * 512 + ks * 4096 + half * 2048; }
template <int OFF> __device__ __forceinline__ s16x4 tr_read(int vb) {
  s16x4 r; asm volatile("ds_read_b64_tr_b16 %0, %1 offset:%2" : "=&v"(r) : "v"(vb), "i"(OFF) : "memory"); return r;
}
template <int D0> __device__ __forceinline__ void pv_one(f32x16& od, int vb, bf16x8 pa0, bf16x8 pa1, bf16x8 pa2, bf16x8 pa3) {
  const s16x4 l0 = tr_read<v_rd_off(D0, 0, 0)>(vb), h0 = tr_read<v_rd_off(D0, 0, 1)>(vb), l1 = tr_read<v_rd_off(D0, 1, 0)>(vb), h1 = tr_read<v_rd_off(D0, 1, 1)>(vb);
  const s16x4 l2 = tr_read<v_rd_off(D0, 2, 0)>(vb), h2 = tr_read<v_rd_off(D0, 2, 1)>(vb), l3 = tr_read<v_rd_off(D0, 3, 0)>(vb), h3 = tr_read<v_rd_off(D0, 3, 1)>(vb);
  asm volatile("s_waitcnt lgkmcnt(0)" ::: "memory"); SBAR();
#define PK(L, H) (bf16x8){L[0], L[1], L[2], L[3], H[0], H[1], H[2], H[3]}
  od = __builtin_amdgcn_mfma_f32_32x32x16_bf16(pa0, PK(l0, h0), od, 0, 0, 0);
  od = __builtin_amdgcn_mfma_f32_32x32x16_bf16(pa1, PK(l1, h1), od, 0, 0, 0);
  od = __builtin_amdgcn_mfma_f32_32x32x16_bf16(pa2, PK(l2, h2), od, 0, 0, 0);
  od = __builtin_amdgcn_mfma_f32_32x32x16_bf16(pa3, PK(l3, h3), od, 0, 0, 0);
#undef PK
}
__device__ __forceinline__ void pv_d0(f32x16* o, int vb, bf16x8 pa0, bf16x8 pa1, bf16x8 pa2, bf16x8 pa3) {
  pv_one<0>(o[0], vb, pa0, pa1, pa2, pa3); pv_one<1>(o[1], vb, pa0, pa1, pa2, pa3); pv_one<2>(o[2], vb, pa0, pa1, pa2, pa3); pv_one<3>(o[3], vb, pa0, pa1, pa2, pa3);
}

__device__ __forceinline__ void attn_unit(const bf16_t* __restrict__ QKV, bf16_t* __restrict__ CAT, int b, int h, int qb, float lam, const float* __restrict__ head_g, char* lds) {
  const int tid = threadIdx.x, wid = tid >> 6, lane = tid & 63, r32 = lane & 31, hi = lane >> 5, cmap = wid >> 2, wq = wid & 3;
  char* V_lds = lds; char* K_lds = lds + 2 * SHM_V;
  float* ws = (float*)(lds + WS_OFF) + wid * 64; float* li_l = ws; float* al_l = ws + 32;
  float m_reg = -1e30f, l_reg = 0; f32x16 o[4] = {};
  char* qr = lds + 65536 + wid * 4096 + lane * 16;
  const bf16_t* Qw = QKV + (size_t)(b * 2048 + qb * 128 + wq * 32 + r32) * LDK + h * 128 + cmap * 64 + hi * 8;
#pragma unroll
  for (int d0 = 0; d0 < 4; ++d0) *reinterpret_cast<bf16x8*>(qr + d0 * 1024) = *reinterpret_cast<const bf16x8*>(Qw + d0 * 16);
  const bf16_t* Kh = QKV + (size_t)(b * 2048) * LDK + 1024 + h * 128;
  const bf16_t* Vh = QKV + (size_t)(b * 2048) * LDK + 2048 + h * 128;
  const float dqb = (float)(qb * 128 + wq * 32 + r32 - 4 * hi);
  const float nsl = -1.4426950408889634f * __builtin_amdgcn_exp2f(-(float)(h + 1));
  const int cofs = cmap * 128;
  const int sr = tid >> 4, sc = (tid & 15) * 8, vst0 = v_st(sr, sc), vst1 = v_st(32 + sr, sc);
  const int vb0 = (int)(uintptr_t)V_lds + v_rd_base(lane);
  struct { bf16x8 vs0, vs1, ks0, ks1; } sr_[SDEPTH];
#define SLOAD(i, k0) do { sr_[i].vs0 = *reinterpret_cast<const bf16x8*>(&Vh[(size_t)((k0) + sr) * LDK + sc]); sr_[i].vs1 = *reinterpret_cast<const bf16x8*>(&Vh[(size_t)((k0) + 32 + sr) * LDK + sc]); \
    sr_[i].ks0 = *reinterpret_cast<const bf16x8*>(&Kh[(size_t)((k0) + sr) * LDK + sc]); sr_[i].ks1 = *reinterpret_cast<const bf16x8*>(&Kh[(size_t)((k0) + 32 + sr) * LDK + sc]); } while (0)
#define SWRITE(bb, i) do { *(bf16x8*)(V_lds + (bb) * SHM_V + vst0) = sr_[i].vs0;          \
    *(bf16x8*)(V_lds + (bb) * SHM_V + vst1) = sr_[i].vs1; int kc = sc * 2;               \
    *(bf16x8*)(K_lds + (bb) * SHM_K + KSWZ(sr, kc)) = sr_[i].ks0;                       \
    *(bf16x8*)(K_lds + (bb) * SHM_K + KSWZ(32 + sr, kc)) = sr_[i].ks1; } while (0)
#define SWAIT() do { if constexpr (SDEPTH == 2) asm volatile("s_waitcnt vmcnt(4)" ::: "memory"); else asm volatile("s_waitcnt vmcnt(0)" ::: "memory"); } while (0)
#define RESC(a) do { if (__any((a) < 1.f)) { if (hi == 0) al_l[r32] = (a); asm volatile("s_waitcnt lgkmcnt(0)" ::: "memory"); \
    _Pragma("unroll") for (int d = 0; d < 4; ++d) _Pragma("unroll") for (int r = 0; r < 16; ++r) o[d][r] *= al_l[crow(r, hi)]; } } while (0)
  f32x16 pA0, pA1, pB0, pB1; float mnA, mnB, alA, alB; bf16x8 pa0, pa1, pa2, pa3;
  constexpr int SE = 0, SO = SDEPTH - 1;
  SLOAD(SE, 0); asm volatile("s_waitcnt vmcnt(0)" ::: "memory"); SWRITE(0, SE); __syncthreads();
  qkt(pA0, pA1, K_lds, qr, r32, hi, cofs, dqb, nsl); partialSM(pA0, pA1, m_reg, mnA, alA);
  SLOAD(SO, KVBLK); if constexpr (SDEPTH == 2) SLOAD(SE, 2 * KVBLK);
  SWAIT(); SWRITE(1, SO); __syncthreads();
  for (int j = 1; j + 1 < NT; j += 2) {
    SBAR(); qkt(pB0, pB1, K_lds + SHM_K, qr, r32, hi, cofs, dqb - (float)(j * KVBLK), nsl);
    finishSM(pA0, pA1, alA, l_reg, pa0, pa1, pa2, pa3); SBAR();
    SLOAD(SO, (j + SDEPTH) * KVBLK); SBAR();
    pv_d0(o, vb0, pa0, pa1, pa2, pa3); partialSM(pB0, pB1, m_reg, mnB, alB);
    __syncthreads(); SWAIT(); SWRITE(0, SE);
    RESC(alB); __syncthreads();
    SBAR(); qkt(pA0, pA1, K_lds, qr, r32, hi, cofs, dqb - (float)((j + 1) * KVBLK), nsl);
    finishSM(pB0, pB1, alB, l_reg, pa0, pa1, pa2, pa3); SBAR();
    if (SDEPTH == 1 || j + 3 < NT) SLOAD(SE, (j + 1 + SDEPTH) * KVBLK); SBAR();
    pv_d0(o, vb0 + SHM_V, pa0, pa1, pa2, pa3); partialSM(pA0, pA1, m_reg, mnA, alA);
    __syncthreads(); SWAIT(); SWRITE(1, SO);
    RESC(alA); __syncthreads();
  }
  SBAR(); qkt(pB0, pB1, K_lds + SHM_K, qr, r32, hi, cofs, dqb - (float)((NT - 1) * KVBLK), nsl);
  finishSM(pA0, pA1, alA, l_reg, pa0, pa1, pa2, pa3); SBAR();
  pv_d0(o, vb0, pa0, pa1, pa2, pa3); partialSM(pB0, pB1, m_reg, mnB, alB);
  __syncthreads(); RESC(alB);
  finishSM(pB0, pB1, alB, l_reg, pa0, pa1, pa2, pa3); SBAR();
  pv_d0(o, vb0 + SHM_V, pa0, pa1, pa2, pa3);
  if (hi == 0) li_l[r32] = l_reg; asm volatile("s_waitcnt lgkmcnt(0)" ::: "memory");
  float rli[16];
#pragma unroll
  for (int r = 0; r < 16; ++r) rli[r] = __builtin_amdgcn_rcpf(li_l[crow(r, hi)]);
  __syncthreads();
  float* OB = (float*)lds + cmap * 16384 + (wq * 32) * 128;
#pragma unroll
  for (int r = 0; r < 16; ++r) { const int orow = crow(r, hi);
#pragma unroll
    for (int d0 = 0; d0 < 4; ++d0) OB[orow * 128 + d0 * 32 + r32] = o[d0][r] * rli[r]; }
  __syncthreads();
  { const int row = tid >> 2, qtr = tid & 3;
    const f32x4* o1 = (const f32x4*)((const float*)lds + row * 128 + qtr * 32); const f32x4* o2 = o1 + 4096;
    f32x4 v[8]; float ssq = 0.f;
#pragma unroll
    for (int k = 0; k < 8; ++k) { v[k] = o1[k] - lam * o2[k]; ssq += (v[k][0] * v[k][0] + v[k][1] * v[k][1]) + (v[k][2] * v[k][2] + v[k][3] * v[k][3]); }
    ssq += __shfl_xor(ssq, 1); ssq += __shfl_xor(ssq, 2);
    const float rs = rsqrtf(ssq * (1.0f / 128.0f) + 1e-6f) * 0.8f;
    bf16_t* dst = CAT + (size_t)(b * 2048 + qb * 128 + row) * 2048 + h * 128 + qtr * 32;
    const f32x4* hg = (const f32x4*)(head_g + qtr * 32);
#pragma unroll
    for (int k = 0; k < 8; k += 2) { const f32x4 g0 = hg[k], g1 = hg[k + 1]; const f32x4 a = v[k] * rs * g0, c = v[k + 1] * rs * g1;
      u32x4 w; w.x = cvtpk(a[0], a[1]); w.y = cvtpk(a[2], a[3]); w.z = cvtpk(c[0], c[1]); w.w = cvtpk(c[2], c[3]);
      *(u32x4*)(dst + k * 4) = w; }
  }
  __syncthreads();
#undef SLOAD
#undef SWRITE
#undef SWAIT
#undef RESC
}
#undef SBAR
}
#define LAS __attribute__((address_space(3)))
typedef unsigned short bf16_t;
typedef short bf16x8 __attribute__((ext_vector_type(8)));
typedef float f32x4 __attribute__((ext_vector_type(4)));
typedef float f32x16 __attribute__((ext_vector_type(16)));
typedef unsigned u32x4 __attribute__((ext_vector_type(4)));
typedef unsigned u32x2 __attribute__((ext_vector_type(2)));
constexpr int DM = 2048, BATCH = 4, SEQ = 2048, MT = BATCH * SEQ, DFF = 5632, NGU = 2 * DFF, INC = 4096, SW = 1024;
constexpr int SG = 64, CT = 16, NCH = SEQ / CT, NROW = BATCH * NCH;
constexpr float EPS = 1e-6f;
constexpr int NWAVES = 8, LDS_BYTES = 136 * 1024;
constexpr size_t al256(size_t x) { return (x + 255) / 256 * 256; }
constexpr size_t WS_W1G = 0;
constexpr size_t WS_W1D = WS_W1G + (size_t)NGU * DM * 2;
constexpr size_t WS_WIN = WS_W1D + (size_t)DM * DFF * 2;
constexpr size_t WS_WOUT = WS_WIN + (size_t)INC * DM * 2;
constexpr size_t WS_WGLU = WS_WOUT + (size_t)DM * DM * 2;
constexpr size_t WS_XN = WS_WGLU + (size_t)SW * SW * 2;
constexpr size_t WS_HFF = WS_XN + (size_t)MT * DM * 2;
constexpr size_t WS_QKV = WS_HFF, WS_UG = WS_QKV + (size_t)MT * 3072 * 2, WS_HIN = WS_UG + (size_t)SG * NROW * 256 * 2;
constexpr size_t WS_Y = WS_HFF + (size_t)MT * DFF * 2;
constexpr size_t WS_SLOC = WS_Y, WS_GB = WS_SLOC + (size_t)SG * NROW * 256 * 4, WS_SPRE = WS_GB + (size_t)MT * SW * 2;
constexpr size_t WS_SSQ = WS_Y + (size_t)MT * DM * 4;
constexpr size_t WS_SSQ2 = WS_SSQ + (size_t)MT * 32 * 4;
constexpr size_t WS_EMAT = WS_SSQ2 + (size_t)MT * 16 * 4;
constexpr size_t WS_MFT = WS_EMAT + (size_t)SG * 8 * 16 * 1024;
constexpr size_t WS_ATAB = WS_MFT + (size_t)SG * 8 * 32 * 1024;
constexpr size_t WS_X1 = WS_ATAB + (size_t)SG * 2 * 64 * 2 * 4;
constexpr size_t WS_RS = WS_X1 + (size_t)MT * DM * 2;
constexpr size_t WS_CTL = WS_RS + (size_t)MT * 4;
constexpr size_t CTL_BYTES = 16384;
constexpr size_t WS_END = WS_CTL + CTL_BYTES;
constexpr int LDS_BARST = 133120;
static_assert(WS_HIN + (size_t)SG * NROW * 256 * 2 <= WS_Y && WS_SPRE + (size_t)MT * SW * 2 <= WS_SSQ, "overlays");

__device__ __forceinline__ unsigned cvtpk(float lo, float hi) { unsigned r; asm volatile("v_cvt_pk_bf16_f32 %0, %1, %2" : "=v"(r) : "v"(lo), "v"(hi)); return r; }
__device__ __forceinline__ float wave_sum(float v) {
#pragma unroll
    for (int o = 1; o < 64; o <<= 1) v += __shfl_xor(v, o);
    return v;
}
__device__ __forceinline__ float bf2f_lo(unsigned w) { return __uint_as_float(w << 16); }
__device__ __forceinline__ float bf2f_hi(unsigned w) { return __uint_as_float(w & 0xffff0000u); }

struct Params { const float* in[31]; float* out; unsigned char* ws; int ph_lo, ph_hi; };

__device__ __forceinline__ void transpose_item(const float* __restrict__ W, int K, int N, bf16_t* __restrict__ WT, int k0, int n0, int rowbase, LAS float* scr, int lane, const float* __restrict__ gk = nullptr) {
    const int r0 = lane >> 3, c4 = (lane & 7) * 4;
    const float* src = W + (size_t)(k0 + r0) * N + n0 + c4;
    f32x4 v[8];
#pragma unroll
    for (int i = 0; i < 8; ++i) v[i] = __builtin_nontemporal_load((const f32x4*)(src + (size_t)(8 * i) * N));
    if (gk) {
#pragma unroll
        for (int i = 0; i < 8; ++i) v[i] = v[i] * gk[k0 + r0 + 8 * i]; }
#pragma unroll
    for (int i = 0; i < 8; ++i) { LAS float* d = scr + (r0 + 8 * i) * 33 + c4; d[0] = v[i][0]; d[1] = v[i][1]; d[2] = v[i][2]; d[3] = v[i][3]; }
    asm volatile("s_waitcnt lgkmcnt(0)" ::: "memory");
    const int c = lane & 7;
#pragma unroll
    for (int j = 0; j < 4; ++j) { const int n = (lane >> 3) + 8 * j; const LAS float* s = scr + (8 * c) * 33 + n;
        u32x4 o; o.x = cvtpk(s[0 * 33], s[1 * 33]); o.y = cvtpk(s[2 * 33], s[3 * 33]); o.z = cvtpk(s[4 * 33], s[5 * 33]); o.w = cvtpk(s[6 * 33], s[7 * 33]);
        *(u32x4*)(WT + (size_t)(rowbase + n) * K + k0 + 8 * c) = o; }
    asm volatile("s_waitcnt lgkmcnt(0)" ::: "memory");
}
constexpr int GU_ITEMS = 2 * (DM / 64) * (DFF / 32);
__device__ __forceinline__ void convert_gateup(const float* wg, const float* wu, const float* gk, unsigned char* ws, LAS float* scr, int gw, int ngw, int lane, int it0 = 0, int it1 = GU_ITEMS) {
    constexpr int IG = (DM / 64) * (DFF / 32);
    bf16_t* G = (bf16_t*)(ws + WS_W1G);
    for (int it = it0 + gw; it < it1; it += ngw) {
        int r = it; const int up = r >= IG; if (up) r -= IG; const int nb = r % (DFF / 32), kb = r / (DFF / 32), n0 = nb * 32;
        transpose_item(up ? wu : wg, DM, DFF, G, kb * 64, n0, (n0 >> 7) * 256 + (n0 & 127) + up * 128, scr, lane, gk);
    }
}
__device__ __forceinline__ void convert_plain(const float* w, int K, int N, bf16_t* WT, LAS float* scr, int gw, int ngw, int lane, const float* gk = nullptr) {
    const int items = (K / 64) * (N / 32);
    for (int r = gw; r < items; r += ngw) { const int nb = r % (N / 32), kb = r / (N / 32); transpose_item(w, K, N, WT, kb * 64, nb * 32, nb * 32, scr, lane, gk); }
}
__device__ __forceinline__ void prenorm_rows(const float* __restrict__ X, bf16_t* __restrict__ XB, float* __restrict__ RS, int gw, int ngw, int lane) {
    for (int row = gw; row < MT; row += ngw) {
        const f32x4* xr = (const f32x4*)(X + (size_t)row * DM) + lane; f32x4 v[8]; float s = 0.f;
#pragma unroll
        for (int j = 0; j < 8; ++j) { v[j] = xr[64 * j]; s += (v[j][0] * v[j][0] + v[j][1] * v[j][1]) + (v[j][2] * v[j][2] + v[j][3] * v[j][3]); }
        s = wave_sum(s);
        if (lane == 0) RS[row] = rsqrtf(s * (1.0f / DM) + EPS);
        u32x2* o8 = (u32x2*)(XB + (size_t)row * DM) + lane;
#pragma unroll
        for (int j = 0; j < 8; ++j) { u32x2 w; w.x = cvtpk(v[j][0], v[j][1]); w.y = cvtpk(v[j][2], v[j][3]); o8[64 * j] = w; }
    }
}
template <bool SRCBF, bool FINAL>
__device__ __forceinline__ void resid_rows(const void* SRC, const bf16_t* __restrict__ Y, const float* __restrict__ SSQ, int npart, const float* __restrict__ gpost, float coef,
                                           float* OUTF, bf16_t* XB, float* RS, int gw, int ngw, int lane) {
    for (int row = gw; row < MT; row += ngw) {
        float s = lane < npart ? SSQ[(size_t)row * npart + lane] : 0.f;
        const float rs = rsqrtf(wave_sum(s) * (1.0f / DM) + EPS) * coef;
        const u32x2* yr = (const u32x2*)(Y + (size_t)row * DM) + lane;
        f32x4 v[8]; float s1 = 0.f;
#pragma unroll
        for (int j = 0; j < 8; ++j) { const f32x4 gg = ((const f32x4*)gpost)[lane + 64 * j];
            const u32x2 yw = yr[64 * j]; const f32x4 yv = {bf2f_lo(yw.x), bf2f_hi(yw.x), bf2f_lo(yw.y), bf2f_hi(yw.y)};
            f32x4 xv;
            if (SRCBF) { const u32x2 xw = ((const u32x2*)((const bf16_t*)SRC + (size_t)row * DM) + lane)[64 * j]; xv = (f32x4){bf2f_lo(xw.x), bf2f_hi(xw.x), bf2f_lo(xw.y), bf2f_hi(xw.y)}; }
            else xv = ((const f32x4*)((const float*)SRC + (size_t)row * DM) + lane)[64 * j];
            v[j] = xv + yv * rs * gg;
            s1 += (v[j][0] * v[j][0] + v[j][1] * v[j][1]) + (v[j][2] * v[j][2] + v[j][3] * v[j][3]); }
        if (FINAL) { f32x4* orow = (f32x4*)(OUTF + (size_t)row * DM) + lane;
#pragma unroll
            for (int j = 0; j < 8; ++j) __builtin_nontemporal_store(v[j], &orow[64 * j]);
        } else {
            s1 = wave_sum(s1);
            if (lane == 0) RS[row] = rsqrtf(s1 * (1.0f / DM) + EPS);
            u32x2* o8 = (u32x2*)(XB + (size_t)row * DM) + lane;
#pragma unroll
            for (int j = 0; j < 8; ++j) { u32x2 w; w.x = cvtpk(v[j][0], v[j][1]); w.y = cvtpk(v[j][2], v[j][3]); o8[64 * j] = w; }
        }
    }
}
__device__ __forceinline__ void snorm_rows(const bf16_t* __restrict__ SPRE, const float* __restrict__ SSQ2, const float* __restrict__ og, bf16_t* __restrict__ CAT, int gw, int ngw, int lane) {
    for (int row = gw; row < MT; row += ngw) {
        float s = lane < 16 ? SSQ2[(size_t)row * 16 + lane] : 0.f;
        const float rs = rsqrtf(wave_sum(s) * (1.0f / SW) + EPS);
#pragma unroll
        for (int j = 0; j < 2; ++j) { const int c8 = lane + 64 * j; const u32x4 w = *((const u32x4*)(SPRE + (size_t)row * SW) + c8);
            const f32x4 g0 = ((const f32x4*)og)[2 * c8], g1 = ((const f32x4*)og)[2 * c8 + 1]; u32x4 o;
            o.x = cvtpk(bf2f_lo(w.x) * rs * g0[0], bf2f_hi(w.x) * rs * g0[1]); o.y = cvtpk(bf2f_lo(w.y) * rs * g0[2], bf2f_hi(w.y) * rs * g0[3]);
            o.z = cvtpk(bf2f_lo(w.z) * rs * g1[0], bf2f_hi(w.z) * rs * g1[1]); o.w = cvtpk(bf2f_lo(w.w) * rs * g1[2], bf2f_hi(w.w) * rs * g1[3]);
            *((u32x4*)(CAT + (size_t)row * DM + SW) + c8) = o; }
    }
}

__device__ __forceinline__ void s5_tables(const Params& p, int g, float* L) {
    const int t = threadIdx.x;
    float* APOW = L; float* FF = APOW + 2 * 64 * 17 * 2; float* BB = FF + 2 * 64 * 2; float* CC = BB + 2 * 64 * 16 * 2; float* KL = CC + 2 * 16 * 65 * 2;
    unsigned char* ws = p.ws;
    __syncthreads();
    if (t < 128) {
        const int dir = t >> 6, n = t & 63, idx = (dir * SG + g) * 64 + n;
        const float lr = p.in[13][idx], li = p.in[14][idx], dt = expf(p.in[15][dir * SG + g]);
        const float mag = expf(lr * dt), ar = mag * cosf(li * dt), ai = mag * sinf(li * dt);
        const float den = lr * lr + li * li, nr = ar - 1.0f;
        FF[(dir * 64 + n) * 2] = (nr * lr + ai * li) / den; FF[(dir * 64 + n) * 2 + 1] = (ai * lr - nr * li) / den;
        float pr = 1.f, pi = 0.f;
        for (int k = 0; k <= 16; ++k) { APOW[((dir * 64 + n) * 17 + k) * 2] = pr; APOW[((dir * 64 + n) * 17 + k) * 2 + 1] = pi; const float qr = pr * ar - pi * ai, qi = pr * ai + pi * ar; pr = qr; pi = qi; }
        float* AT = (float*)(ws + WS_ATAB) + ((g * 2 + dir) * 64 + n) * 2;
        AT[0] = APOW[((dir * 64 + n) * 17 + 16) * 2]; AT[1] = APOW[((dir * 64 + n) * 17 + 16) * 2 + 1];
    }
    __syncthreads();
    for (int e = t; e < 2048; e += 512) {
        { const int dir = e >> 10, n = (e >> 4) & 63, q = e & 15; const size_t bi = ((size_t)(dir * SG + g) * 64 + n) * 16 + q;
          const float br = p.in[16][bi], bim = p.in[17][bi], fr = FF[(dir * 64 + n) * 2], fi = FF[(dir * 64 + n) * 2 + 1];
          BB[((dir * 64 + n) * 16 + q) * 2] = fr * br - fi * bim; BB[((dir * 64 + n) * 16 + q) * 2 + 1] = fr * bim + fi * br; }
        { const int dir = e >> 10, pp = (e >> 6) & 15, n = e & 63; const size_t ci = ((size_t)(dir * SG + g) * 16 + pp) * 64 + n;
          CC[((dir * 16 + pp) * 65 + n) * 2] = p.in[18][ci]; CC[((dir * 16 + pp) * 65 + n) * 2 + 1] = p.in[19][ci]; }
    }
    __syncthreads();
    {
        typedef float f32x2 __attribute__((ext_vector_type(2)));
        const int pp = t & 15, l = (t >> 4) & 15, dir = t >> 8;
        float acc[16];
#pragma unroll
        for (int q = 0; q < 16; ++q) acc[q] = 0.f;
        for (int n = 0; n < 64; ++n) {
            const f32x2 c = *(const f32x2*)(CC + ((dir * 16 + pp) * 65 + n) * 2), a = *(const f32x2*)(APOW + ((dir * 64 + n) * 17 + l) * 2);
            const float wr = c.x * a.x - c.y * a.y, wi = c.x * a.y + c.y * a.x;
#pragma unroll
            for (int q = 0; q < 16; ++q) { const f32x2 bq = *(const f32x2*)(BB + ((dir * 64 + n) * 16 + q) * 2); acc[q] += wr * bq.x - wi * bq.y; }
        }
#pragma unroll
        for (int q = 0; q < 16; ++q) KL[((dir * 16 + l) * 16 + pp) * 16 + q] = acc[q];
    }
    __syncthreads();
    for (int ch = t; ch < 8192; ch += 512) {
        const int lane = ch & 63, ks = (ch >> 6) & 15, nt = ch >> 10, np = nt * 32 + (lane & 31), dir = np >> 7, ri = (np >> 6) & 1, n = np & 63, q0 = (lane >> 5) * 8;
        const int pw = dir == 0 ? 15 - ks : ks;
        const float ar = APOW[((dir * 64 + n) * 17 + pw) * 2], ai = APOW[((dir * 64 + n) * 17 + pw) * 2 + 1];
        float z[8];
#pragma unroll
        for (int j = 0; j < 8; ++j) { const float br = BB[((dir * 64 + n) * 16 + q0 + j) * 2], bi = BB[((dir * 64 + n) * 16 + q0 + j) * 2 + 1]; z[j] = ri ? (ar * bi + ai * br) : (ar * br - ai * bi); }
        u32x4 o; o.x = cvtpk(z[0], z[1]); o.y = cvtpk(z[2], z[3]); o.z = cvtpk(z[4], z[5]); o.w = cvtpk(z[6], z[7]);
        *(u32x4*)(ws + WS_EMAT + ((size_t)((g * 8 + nt) * 16 + ks)) * 1024 + lane * 16) = o;
    }
    for (int ch = t; ch < 16384; ch += 512) {
        const int lane = ch & 63, ks = (ch >> 6) & 31, nt = ch >> 11, no = nt * 32 + (lane & 31), tau = no >> 4, pp = no & 15;
        float z[8];
        if (ks < 16) { const int sg = ks, q0 = (lane >> 5) * 8;
#pragma unroll
            for (int j = 0; j < 8; ++j) { const int q = q0 + j; float v = 0.f;
                if (sg <= tau) v += KL[((0 * 16 + (tau - sg)) * 16 + pp) * 16 + q];
                if (sg >= tau) v += KL[((1 * 16 + (sg - tau)) * 16 + pp) * 16 + q];
                if (sg == tau && pp == q) v += p.in[20][g * 16 + pp];
                z[j] = v; }
        } else { const int np0 = (ks - 16) * 16 + (lane >> 5) * 8, dir = np0 >> 7, ri = (np0 >> 6) & 1, n0 = np0 & 63, pw = dir == 0 ? tau + 1 : 16 - tau;
#pragma unroll
            for (int j = 0; j < 8; ++j) { const int n = n0 + j; const float cr = CC[((dir * 16 + pp) * 65 + n) * 2], ci = CC[((dir * 16 + pp) * 65 + n) * 2 + 1];
                const float ar = APOW[((dir * 64 + n) * 17 + pw) * 2], ai = APOW[((dir * 64 + n) * 17 + pw) * 2 + 1];
                z[j] = ri ? -(cr * ai + ci * ar) : (cr * ar - ci * ai); }
        }
        u32x4 o; o.x = cvtpk(z[0], z[1]); o.y = cvtpk(z[2], z[3]); o.z = cvtpk(z[4], z[5]); o.w = cvtpk(z[6], z[7]);
        *(u32x4*)(ws + WS_MFT + ((size_t)((g * 8 + nt) * 32 + ks)) * 1024 + lane * 16) = o;
    }
    __syncthreads();
}
__device__ __forceinline__ int crow16(int r, int hi) { return (r & 3) + 8 * (r >> 2) + 4 * hi; }
__device__ __forceinline__ void s5_estate(unsigned char* ws, int gw, int ngw, int lane) {
    for (int task = gw; task < SG * 16 * 2; task += ngw) {
        const int nh = task & 1, rt = (task >> 1) & 15, g = task >> 5, r32 = lane & 31, hi = lane >> 5;
        const bf16_t* A = (const bf16_t*)(ws + WS_UG) + ((size_t)(g * NROW + rt * 32 + r32)) * 256 + hi * 8;
        const unsigned char* B = ws + WS_EMAT + (size_t)(g * 8 + nh * 4) * 16 * 1024 + lane * 16;
        f32x16 acc[4] = {};
#pragma unroll 4
        for (int ks = 0; ks < 16; ++ks) { const bf16x8 a = *(const bf16x8*)(A + ks * 16);
#pragma unroll
            for (int nt = 0; nt < 4; ++nt) { const bf16x8 b = *(const bf16x8*)(B + (size_t)(nt * 16 + ks) * 1024); acc[nt] = __builtin_amdgcn_mfma_f32_32x32x16_bf16(a, b, acc[nt], 0, 0, 0); } }
        float* S = (float*)(ws + WS_SLOC) + ((size_t)(g * NROW + rt * 32)) * 256 + nh * 128 + r32;
#pragma unroll
        for (int nt = 0; nt < 4; ++nt)
#pragma unroll
            for (int r = 0; r < 16; ++r) S[(size_t)crow16(r, hi) * 256 + nt * 32] = acc[nt][r];
    }
}
__device__ __forceinline__ void s5_scan(unsigned char* ws, int gw, int ngw, int lane) {
    for (int task = gw; task < BATCH * SG * 2; task += ngw) {
        const int dir = task & 1, g = (task >> 1) & 63, b = task >> 7;
        const float* AT = (const float*)(ws + WS_ATAB) + ((g * 2 + dir) * 64 + lane) * 2; const float ar = AT[0], ai = AT[1];
        const float* S = (const float*)(ws + WS_SLOC) + ((size_t)(g * NROW + b * NCH)) * 256 + dir * 128 + lane;
        bf16_t* H = (bf16_t*)(ws + WS_HIN) + ((size_t)(g * NROW + b * NCH)) * 256 + dir * 128 + lane;
        float hr = 0.f, hi = 0.f;
        for (int c0 = 0; c0 < NCH; c0 += 16) {
            float sr[16], si[16];
#pragma unroll
            for (int k = 0; k < 16; ++k) { const int c = dir == 0 ? c0 + k : NCH - 1 - (c0 + k); sr[k] = S[(size_t)c * 256]; si[k] = S[(size_t)c * 256 + 64]; }
#pragma unroll
            for (int k = 0; k < 16; ++k) { const int c = dir == 0 ? c0 + k : NCH - 1 - (c0 + k);
                H[(size_t)c * 256] = (bf16_t)(cvtpk(hr, 0.f) & 0xffffu); H[(size_t)c * 256 + 64] = (bf16_t)(cvtpk(hi, 0.f) & 0xffffu);
                const float nr = ar * hr - ai * hi + sr[k], ni = ar * hi + ai * hr + si[k]; hr = nr; hi = ni; }
        }
    }
}
__device__ __forceinline__ void s5_output(unsigned char* ws, int gw, int ngw, int lane) {
    for (int task = gw; task < SG * 16 * 2; task += ngw) {
        const int nh = task & 1, rt = (task >> 1) & 15, g = task >> 5, r32 = lane & 31, hi = lane >> 5;
        const bf16_t* A0 = (const bf16_t*)(ws + WS_UG) + ((size_t)(g * NROW + rt * 32 + r32)) * 256 + hi * 8;
        const bf16_t* A1 = (const bf16_t*)(ws + WS_HIN) + ((size_t)(g * NROW + rt * 32 + r32)) * 256 + hi * 8;
        const unsigned char* B = ws + WS_MFT + (size_t)(g * 8 + nh * 4) * 32 * 1024 + lane * 16;
        f32x16 acc[4] = {};
#pragma unroll 4
        for (int ks = 0; ks < 16; ++ks) { const bf16x8 a = *(const bf16x8*)(A0 + ks * 16);
#pragma unroll
            for (int nt = 0; nt < 4; ++nt) { const bf16x8 b = *(const bf16x8*)(B + (size_t)(nt * 32 + ks) * 1024); acc[nt] = __builtin_amdgcn_mfma_f32_32x32x16_bf16(a, b, acc[nt], 0, 0, 0); } }
#pragma unroll 4
        for (int ks = 0; ks < 16; ++ks) { const bf16x8 a = *(const bf16x8*)(A1 + ks * 16);
#pragma unroll
            for (int nt = 0; nt < 4; ++nt) { const bf16x8 b = *(const bf16x8*)(B + (size_t)(nt * 32 + 16 + ks) * 1024); acc[nt] = __builtin_amdgcn_mfma_f32_32x32x16_bf16(a, b, acc[nt], 0, 0, 0); } }
        bf16_t* GBp = (bf16_t*)(ws + WS_GB);
#pragma unroll
        for (int nt = 0; nt < 4; ++nt) { const int no = nh * 128 + nt * 32 + r32, tau = no >> 4, pp = no & 15;
#pragma unroll
            for (int r = 0; r < 16; ++r) { const int crw = rt * 32 + crow16(r, hi); const float y = acc[nt][r];
                const float z2 = 1.5957691216057308f * (y + 0.044715f * y * y * y);
                const float gl = y * __builtin_amdgcn_rcpf(1.0f + __builtin_amdgcn_exp2f(-1.4426950408889634f * z2));
                GBp[(size_t)(crw * 16 + tau) * SW + g * 16 + pp] = (bf16_t)(cvtpk(gl, 0.f) & 0xffffu); } }
    }
}
#define XB_TMO      128
#define XB_XCNT(j)  (256  + 64 * (j))
#define XB_XSUB(j)  (1280 + 64 * (j))
#define XB_XGEN(j)  (2304 + 64 * (j))
#define XB_TOP      3328
#define XB_TOPGEN   3392
#define XCD_BAR_WORDS 3456
#define XB_SPIN_CAP (1u << 18)

__device__ __forceinline__ unsigned xb_ld(unsigned* p)              { return __hip_atomic_load(p, __ATOMIC_RELAXED, __HIP_MEMORY_SCOPE_AGENT); }
__device__ __forceinline__ unsigned xb_add(unsigned* p, unsigned v) { return __hip_atomic_fetch_add(p, v, __ATOMIC_RELAXED, __HIP_MEMORY_SCOPE_AGENT); }
__device__ __forceinline__ unsigned xb_xcc_id() { return (unsigned)__builtin_amdgcn_s_getreg((3 << 11) | 20) & 0xFu; }
#define XB_SPIN(cond, bar) do { unsigned _sp = 0; while (cond) { __builtin_amdgcn_s_sleep(1); \
    if ((++_sp & 255u) == 0u) { if (xb_ld(&(bar)[XB_TMO])) break; if (_sp > XB_SPIN_CAP) { atomicAdd(&(bar)[XB_TMO], 1u); break; } } } } while (0)

struct XcdBarrier {
    unsigned* bar; unsigned x;
    volatile LAS unsigned* st;
};

__device__ __forceinline__ XcdBarrier xcd_barrier_post(unsigned* bar, volatile LAS unsigned* st) {
    XcdBarrier b; b.bar = bar; b.x = xb_xcc_id(); b.st = st;
    if (threadIdx.x == 0) (void)xb_add(&bar[XB_XCNT(b.x)], 1u);
    return b;
}
__device__ __forceinline__ void xcd_barrier_complete(unsigned* bar, unsigned x, unsigned& nloc, unsigned& nx) {
    const unsigned G = gridDim.x * gridDim.y * gridDim.z;
    unsigned sum, cnt, mine, sp = 0u;
    for (;;) {
        sum = 0u; cnt = 0u; mine = 0u;
#pragma unroll
        for (unsigned j = 0; j < 16; ++j) { const unsigned c = xb_ld(&bar[XB_XCNT(j)]); sum += c; cnt += (c > 0u) ? 1u : 0u; mine = (j == x) ? c : mine; }
        if (sum == G) break;
        __builtin_amdgcn_s_sleep(1);
        if ((++sp & 255u) == 0u) { if (xb_ld(&bar[XB_TMO])) break; if (sp > XB_SPIN_CAP) { atomicAdd(&bar[XB_TMO], 1u); break; } }
    }
    nloc = mine > 0u ? mine : 1u; nx = cnt > 0u ? cnt : 1u;
}

__device__ __forceinline__ void xcd_barrier(const XcdBarrier& b) {
    asm volatile("s_waitcnt vmcnt(0)" ::: "memory");
    __syncthreads();
    if (threadIdx.x == 0) {
        unsigned* bar = b.bar;
        __builtin_amdgcn_s_waitcnt(0);
        unsigned nloc = b.st[0], nx = b.st[1];
        if (nloc == 0u) { xcd_barrier_complete(bar, b.x, nloc, nx); b.st[0] = nloc; b.st[1] = nx; }
        const unsigned old = xb_add(&bar[XB_XSUB(b.x)], 1u);
        const unsigned gen = old / nloc;
        if (old + 1u == (gen + 1u) * nloc) {
            __builtin_amdgcn_fence(__ATOMIC_RELEASE, "agent");
            asm volatile("s_waitcnt vmcnt(0)" ::: "memory");
            const unsigned og = xb_add(&bar[XB_TOP], 1u);
            const unsigned tg = og / nx;
            if (og + 1u == (tg + 1u) * nx) xb_add(&bar[XB_TOPGEN], 1u);
            else XB_SPIN(xb_ld(&bar[XB_TOPGEN]) == tg, bar);
            __builtin_amdgcn_fence(__ATOMIC_ACQUIRE, "agent");
            xb_add(&bar[XB_XGEN(b.x)], 1u);
            asm volatile("s_waitcnt vmcnt(0)" ::: "memory");
        } else {
            XB_SPIN(xb_ld(&bar[XB_XGEN(b.x)]) == gen, bar);
            __builtin_amdgcn_fence(__ATOMIC_ACQUIRE, "agent");
            asm volatile("s_waitcnt vmcnt(0)" ::: "memory");
        }
    }
    __syncthreads();
}

__global__ void __launch_bounds__(NWAVES * 64, 2) fwd_megakernel(Params p) {
    extern __shared__ __attribute__((aligned(16))) unsigned char lds[];
    cg::grid_group grid = cg::this_grid();
    const int tid = threadIdx.x, lane = tid & 63, wave = __builtin_amdgcn_readfirstlane(tid >> 6);
    const int G = gridDim.x, bx = blockIdx.x, vcu = (G % 8 == 0) ? (bx % 8) * (G / 8) + bx / 8 : bx;
    const int gw = vcu * NWAVES + wave, ngw = G * NWAVES;
    const int HB = G / 2, hgw = (bx - HB) * NWAVES + wave, hngw = (G - HB) * NWAVES;
    unsigned char* ws = p.ws;
    LAS unsigned char* ldsl = (LAS unsigned char*)lds;
    LAS float* scr = (LAS float*)(ldsl + wave * 8448);
    const int lo = p.ph_lo, hi = p.ph_hi;
#ifndef GU_SPLIT_PCT
#define GU_SPLIT_PCT 55
#endif
    constexpr int GU_SPLIT = GU_ITEMS / 100 * GU_SPLIT_PCT;
    if (tid < 2) ((volatile LAS unsigned*)(ldsl + LDS_BARST))[tid] = 0u;
    __syncthreads();
    XcdBarrier bar = xcd_barrier_post((unsigned*)(ws + WS_CTL), (volatile LAS unsigned*)(ldsl + LDS_BARST));
    if (hi > 1000) grid.sync();
#ifndef PH_MASK
#define PH_MASK 0x7fff
#endif
#define IN(k) (((PH_MASK >> (k)) & 1) && lo <= (k) && (k) < hi)
#ifndef DBL_MASK
#define DBL_MASK 0
#endif
#define REP(k) for (int _rp = 0; _rp < 1 + ((DBL_MASK >> (k)) & 1); ++_rp)
#ifndef SYNC_REP
#define SYNC_REP 1
#endif
#ifdef TSA
#define STAMP(i) do { if (bx == 0 && tid == 0) ((unsigned long long*)(ws + WS_CTL + 14336))[i] = __builtin_amdgcn_s_memrealtime(); } while (0)
#else
#define STAMP(i) do {} while (0)
#endif
#define SEAM(k) do { if (IN(k) && IN((k) + 1)) { for (int _r = 0; _r < SYNC_REP; ++_r) xcd_barrier(bar); } STAMP((k) + 1); } while (0)
    bf16_t* XN = (bf16_t*)(ws + WS_XN); bf16_t* X1 = (bf16_t*)(ws + WS_X1); float* RS = (float*)(ws + WS_RS); bf16_t* HFF = (bf16_t*)(ws + WS_HFF); bf16_t* Y = (bf16_t*)(ws + WS_Y); float* SSQ = (float*)(ws + WS_SSQ); float* SSQ2 = (float*)(ws + WS_SSQ2);
    bf16_t* QKV = (bf16_t*)(ws + WS_QKV); bf16_t* UG = (bf16_t*)(ws + WS_UG); bf16_t* GB = (bf16_t*)(ws + WS_GB); bf16_t* SPRE = (bf16_t*)(ws + WS_SPRE);

    STAMP(0);
    if (IN(0)) REP(0) {
        const int TB = G >= 128 ? G - 64 : G, NS = 2 * TB + (G - TB);
        for (int g = bx - TB; g >= 0 && g < SG; g += G - TB) s5_tables(p, g, (float*)lds);
        if (G < 128) for (int g = bx; g < SG; g += G) s5_tables(p, g, (float*)lds);
        const int nsl = bx < TB ? 2 : 1, sl0 = bx < TB ? 2 * bx : 2 * TB + (bx - TB);
        for (int sl = 0; sl < nsl; ++sl) {
            const int sgw = (sl0 + sl) * NWAVES + wave, sngw = NS * NWAVES;
            convert_gateup(p.in[2], p.in[3], p.in[1], ws, scr, sgw, sngw, lane);
            prenorm_rows(p.in[0], XN, RS, sgw, sngw, lane);
            convert_plain(p.in[24], DM, DM, (bf16_t*)(ws + WS_WOUT), scr, sgw, sngw, lane);
            convert_plain(p.in[21], SW, SW, (bf16_t*)(ws + WS_WGLU), scr, sgw, sngw, lane);
        }
    }
    SEAM(0);
#define FFN_GATEUP(AIN) do { pg8::Gemm g{AIN, (const bf16_t*)(ws + WS_W1G), MT, NGU, DM}; pg8::StaticOrder S; S.init(MT, NGU, G, bx); \
            pg8::EpiSwiGLU E{HFF, DFF, RS}; pg8::gemm_phase<pg8::EpiSwiGLU, pg8::StaticOrder, true, true>(ldsl, g, S, E); } while (0)
#define FFN_DOWN() do { pg8::Gemm g{HFF, (const bf16_t*)(ws + WS_W1D), MT, DM, DFF}; pg8::StaticOrder S; S.init(MT, DM, G, bx); \
            pg8::EpiYSsq E{Y, SSQ, 32}; pg8::gemm_phase<pg8::EpiYSsq, pg8::StaticOrder, true, true>(ldsl, g, S, E); } while (0)
    if (IN(1)) REP(1) { FFN_GATEUP(XN);
        if (bx >= HB) {
            convert_plain(p.in[4], DFF, DM, (bf16_t*)(ws + WS_W1D), scr, hgw, hngw, lane);
            convert_plain(p.in[7], DM, INC, (bf16_t*)(ws + WS_WIN), scr, hgw, hngw, lane, p.in[6]);
        } }
    SEAM(1);
    if (IN(2)) REP(2) FFN_DOWN();
    SEAM(2);
    if (IN(3)) REP(3) resid_rows<false, false>(p.in[0], Y, SSQ, 32, p.in[5], 0.5f, nullptr, X1, RS, gw, ngw, lane);
    SEAM(3);
    if (IN(4)) REP(4) {
        pg8::Gemm g{X1, (const bf16_t*)(ws + WS_WIN), MT, INC, DM}; pg8::StaticOrder S; S.init(MT, INC, G, bx);
        pg8::EpiQKVU E{QKV, UG, 0.125f * 1.4426950408889634f, RS};
        pg8::gemm_phase<pg8::EpiQKVU, pg8::StaticOrder, true, true>(ldsl, g, S, E);
    }
    SEAM(4);
    if (IN(5)) {
        float lam;
        { const float a = wave_sum(p.in[8][lane] * p.in[9][lane]), c = wave_sum(p.in[10][lane] * p.in[11][lane]); lam = expf(a) - expf(c) + 0.2f; }
        #ifndef ATT_REP
#define ATT_REP 1
#endif
        for (int u = vcu; u < ATT_REP * BATCH * 8 * 16; u += G) att::attn_unit(QKV, XN, (u >> 7) & 3, (u >> 4) & 7, u & 15, lam, p.in[12], (char*)lds);
#ifndef EST_REP
#define EST_REP 1
#endif
        for (int _r = 0; _r < EST_REP; ++_r) s5_estate(ws, gw, ngw, lane);
    }
    SEAM(5);
    if (IN(6)) REP(6) { s5_scan(ws, gw, ngw, lane);
        if (vcu >= 64) convert_gateup(p.in[27], p.in[28], p.in[26], ws, scr, (vcu - 64) * NWAVES + wave, (G - 64) * NWAVES, lane, 0, GU_SPLIT); }
    SEAM(6);
    if (IN(7)) REP(7) s5_output(ws, gw, ngw, lane);
    SEAM(7);
    if (IN(8)) REP(8) {
        pg8::Gemm g{GB, (const bf16_t*)(ws + WS_WGLU), MT, SW, SW}; pg8::StaticOrder S; S.init(MT, SW, G, bx);
        pg8::EpiGLU E{GB, SPRE, p.in[22], SSQ2};
        pg8::gemm_phase<pg8::EpiGLU, pg8::StaticOrder, true, true>(ldsl, g, S, E);
        if (bx >= HB) convert_gateup(p.in[27], p.in[28], p.in[26], ws, scr, hgw, hngw, lane, GU_SPLIT, GU_ITEMS);
    }
    SEAM(8);
    if (IN(9)) REP(9) snorm_rows(SPRE, SSQ2, p.in[23], XN, gw, ngw, lane);
    SEAM(9);
    if (IN(10)) REP(10) {
        pg8::Gemm g{XN, (const bf16_t*)(ws + WS_WOUT), MT, DM, DM}; pg8::StaticOrder S; S.init(MT, DM, G, bx);
        pg8::EpiYSsq E{Y, SSQ, 32};
        pg8::gemm_phase<pg8::EpiYSsq, pg8::StaticOrder, true, true>(ldsl, g, S, E);
    }
    SEAM(10);
    if (IN(11)) resid_rows<true, false>(X1, Y, SSQ, 32, p.in[25], 1.0f, nullptr, X1, RS, gw, ngw, lane);
    SEAM(11);
    if (IN(12)) { FFN_GATEUP(X1);
        if (bx >= HB) convert_plain(p.in[29], DFF, DM, (bf16_t*)(ws + WS_W1D), scr, hgw, hngw, lane); }
    SEAM(12);
    if (IN(13)) FFN_DOWN();
    SEAM(13);
    if (IN(14)) resid_rows<true, true>(X1, Y, SSQ, 32, p.in[30], 0.5f, p.out, nullptr, nullptr, gw, ngw, lane);
#ifdef TSA
    xcd_barrier(bar); STAMP(15); xcd_barrier(bar);
    { const unsigned long long* TS = (const unsigned long long*)(ws + WS_CTL + 14336);
      const float ta = (float)(TS[TSA + 1] - TS[TSA]) * 0.01f, tb = (TSB == 99) ? 100.f : (float)(TS[(TSB == 99 ? 0 : TSB) + 1] - TS[(TSB == 99 ? 0 : TSB)]) * 0.01f;
      for (size_t i = (size_t)bx * 512 + tid; i < (size_t)MT * DM; i += (size_t)G * 512) p.out[i] += 1000.f * tb;
      __syncthreads();
      if (bx == 0 && tid == 0) p.out[0] += 64000.f * ta; }
#endif
#undef IN
#undef SEAM
}

extern "C" void kernel_launch(void* const* d_in, const int* in_sizes, int n_in, void* d_out, int out_size, void* d_ws, size_t ws_size, hipStream_t stream) {
    static int grid = 0;
    if (grid == 0) {
        if (n_in != 31 || in_sizes[0] != MT * DM || out_size != MT * DM || ws_size < WS_END) {
            fprintf(stderr, "kernel_launch: shape/workspace mismatch: n_in %d in0 %d out %d ws %zu (need %zu)\n", n_in, n_in > 0 ? in_sizes[0] : -1, out_size, ws_size, (size_t)WS_END); grid = -1; return; }
        int dev = 0, cus = 0, per_cu = 0;
        hipGetDevice(&dev); hipDeviceGetAttribute(&cus, hipDeviceAttributeMultiprocessorCount, dev);
        if (hipFuncSetAttribute((const void*)fwd_megakernel, hipFuncAttributeMaxDynamicSharedMemorySize, LDS_BYTES) != hipSuccess) { fprintf(stderr, "kernel_launch: hipFuncSetAttribute failed\n"); grid = -1; return; }
        if (hipOccupancyMaxActiveBlocksPerMultiprocessor(&per_cu, (const void*)fwd_megakernel, NWAVES * 64, LDS_BYTES) != hipSuccess || per_cu < 1) { fprintf(stderr, "kernel_launch: occupancy query says %d\n", per_cu); (void)hipGetLastError(); per_cu = 1; }
        grid = cus;
        fprintf(stderr, "kernel_launch: grid %d (cus %d x per_cu %d), ws %zu need %zu\n", grid, cus, per_cu, ws_size, (size_t)WS_END);
    }
    if (grid < 0) return;
    if (hipMemsetAsync((char*)d_ws + WS_CTL, 0, CTL_BYTES, stream) != hipSuccess) { fprintf(stderr, "kernel_launch: memset failed\n"); return; }
    Params p{};
    for (int i = 0; i < 31; ++i) p.in[i] = (const float*)d_in[i];
    p.out = (float*)d_out; p.ws = (unsigned char*)d_ws;
#if MK_N_LAUNCHES == 1
    p.ph_lo = 0; p.ph_hi = 15;
    void* args[] = {&p};
    hipError_t e = hipLaunchCooperativeKernel((const void*)fwd_megakernel, dim3(grid), dim3(NWAVES * 64), args, LDS_BYTES, stream);
    if (e != hipSuccess) fprintf(stderr, "cooperative launch failed: %s (grid %d)\n", hipGetErrorString(e), grid);
#else
    for (int k = 0; k < 15; ++k) { p.ph_lo = k; p.ph_hi = k + 1; hipLaunchKernelGGL(fwd_megakernel, dim3(grid), dim3(NWAVES * 64), LDS_BYTES, stream, p); }
#endif
}
```

```cpp
#include <hip/hip_runtime.h>
#include <hip/hip_cooperative_groups.h>
#include <cstdio>
#include <cstdint>
namespace cg = cooperative_groups;
#ifndef MK_N_LAUNCHES
#define MK_N_LAUNCHES 1
#endif
namespace pg8 {
#define PG8_LAS __attribute__((address_space(3)))
typedef unsigned short bf16_t;
typedef short bf16x8 __attribute__((ext_vector_type(8)));
typedef float f32x4 __attribute__((ext_vector_type(4)));
typedef unsigned u32x4 __attribute__((ext_vector_type(4)));
constexpr int BM = 256, BK = 64, HALF = 128, HTB = HALF * BK * 2  , STAGE_BYTES = 8 * HTB, NXCD = 8, WGM = 8;

__host__ __device__ __forceinline__ int lds_byte(int r, int c) { const int st = (r >> 4) * 2 + (c >> 5), rr = r & 15, cc = c & 31, ob = rr * 64 + cc * 2; return st * 1024 + (ob ^ (((ob >> 9) & 1) << 5)); }
__host__ __device__ __forceinline__ void stage_rc(int b, int& R, int& C) { const int st = b / 1024, sb = b % 1024, swz = sb ^ (((sb >> 9) & 1) << 5); R = (st >> 1) * 16 + swz / 64; C = (st & 1) * 32 + (swz % 64) / 2; }
__host__ __device__ __forceinline__ int perm32(int rho) { const int n = rho >> 4, i = rho & 15; return 8 * (i >> 2) + 4 * n + (i & 3); }

struct Unit { int pm, pn; };
struct Gemm { const bf16_t* A; const bf16_t* Bt; int M, N, K; };

struct StaticOrder {
    int nM, nN, nwg, G, c;
    __host__ __device__ void init(int M, int N, int G_, int c_) { nM = M / BM; nN = N / BM; nwg = nM * nN; G = G_; c = c_; }
    __host__ __device__ bool next(int i, Unit& u) const {
        const long L = (long)i * G + c; if (L >= nwg) return false;
        int wgid = (int)L; { const int q = nwg / NXCD, r = nwg % NXCD, xcd = wgid % NXCD, off = wgid / NXCD; wgid = (xcd < r ? xcd * (q + 1) : r * (q + 1) + (xcd - r) * q) + off; }
        const int nig = WGM * nN, gid = wgid / nig, fm = gid * WGM, gsz = (nM - fm) < WGM ? (nM - fm) : WGM;
        u.pm = fm + ((wgid % nig) % gsz); u.pn = (wgid % nig) / gsz; return true;
    }
    __device__ __forceinline__ void a_ready(const Unit&) const {}
    __device__ __forceinline__ void done(const Unit&) const {}
};

__device__ __forceinline__ unsigned cvt_pk_bf16(float lo, float hi) { unsigned r; asm volatile("v_cvt_pk_bf16_f32 %0, %1, %2" : "=v"(r) : "v"(lo), "v"(hi)); return r; }
typedef unsigned u32x2 __attribute__((ext_vector_type(2)));
__device__ __forceinline__ float bf_lo(unsigned w) { return __uint_as_float(w << 16); }
__device__ __forceinline__ float bf_hi(unsigned w) { return __uint_as_float(w & 0xffff0000u); }
__device__ __forceinline__ float sigmoid_f(float z) { return __builtin_amdgcn_rcpf(1.0f + __builtin_amdgcn_exp2f(-1.4426950408889634f * z)); }
__device__ __forceinline__ float silu_f(float z) { return z * sigmoid_f(z); }

struct EpiSwiGLU {
    static constexpr bool PERM = true, AFTER_DRAIN = false;
    bf16_t* O; int ldc; const float* RS;
    __device__ __forceinline__ void operator()(const f32x4 (&acc)[2][2][4][2], const Unit& u, int wr, int wc, int fr, int fq) const {
        const int row0 = u.pm * BM + wr * 64 + fr, col0 = u.pn * HALF + wc * 32 + 8 * fq;
#pragma unroll
        for (int ai = 0; ai < 2; ++ai)
#pragma unroll
            for (int m = 0; m < 4; ++m) {
                bf16_t* rowp = O + (size_t)(row0 + ai * HALF + m * 16) * ldc + col0;
                const float rr = RS[row0 + ai * HALF + m * 16];
                const f32x4 g0 = acc[ai][0][m][0] * rr, g1 = acc[ai][0][m][1] * rr, u0 = acc[ai][1][m][0] * rr, u1 = acc[ai][1][m][1] * rr;
                u32x4 w;
                w.x = cvt_pk_bf16(silu_f(g0[0]) * u0[0], silu_f(g0[1]) * u0[1]); w.y = cvt_pk_bf16(silu_f(g0[2]) * u0[2], silu_f(g0[3]) * u0[3]);
                w.z = cvt_pk_bf16(silu_f(g1[0]) * u1[0], silu_f(g1[1]) * u1[1]); w.w = cvt_pk_bf16(silu_f(g1[2]) * u1[2], silu_f(g1[3]) * u1[3]);
                *(u32x4*)rowp = w;
            }
    }
};
struct EpiQKVU {
    static constexpr bool PERM = true, AFTER_DRAIN = false;
    bf16_t* QKV; bf16_t* UG; float qscale; const float* RS;
    __device__ __forceinline__ void operator()(const f32x4 (&acc)[2][2][4][2], const Unit& u, int wr, int wc, int fr, int fq) const {
        const int row0 = u.pm * BM + wr * 64 + fr, colt = u.pn * BM;
        const float sc = colt < 1024 ? qscale : 1.0f;
#pragma unroll
        for (int ai = 0; ai < 2; ++ai)
#pragma unroll
            for (int m = 0; m < 4; ++m) {
                const int row = row0 + ai * HALF + m * 16; const float scr = sc * RS[row];
#pragma unroll
                for (int bj = 0; bj < 2; ++bj) {
                    const int col = colt + bj * HALF + wc * 32 + 8 * fq;
                    const f32x4 v0 = acc[ai][bj][m][0] * scr, v1 = acc[ai][bj][m][1] * scr;
                    u32x4 w; w.x = cvt_pk_bf16(v0[0], v0[1]); w.y = cvt_pk_bf16(v0[2], v0[3]); w.z = cvt_pk_bf16(v1[0], v1[1]); w.w = cvt_pk_bf16(v1[2], v1[3]);
                    bf16_t* dst;
                    if (colt < 3072) dst = QKV + (size_t)row * 3072 + col;
                    else { const int cc = col - 3072; dst = UG + ((size_t)((cc >> 4) * 512 + (row >> 4)) * 256 + (row & 15) * 16 + (cc & 15)); }
                    *(u32x4*)dst = w;
                }
            }
    }
};
struct EpiYSsq {
    static constexpr bool PERM = true, AFTER_DRAIN = false;
    bf16_t* Y; float* SSQ; int npart;
    __device__ __forceinline__ void operator()(const f32x4 (&acc)[2][2][4][2], const Unit& u, int wr, int wc, int fr, int fq) const {
        const int row0 = u.pm * BM + wr * 64 + fr, col0 = u.pn * BM + wc * 32 + 8 * fq;
#pragma unroll
        for (int ai = 0; ai < 2; ++ai)
#pragma unroll
            for (int m = 0; m < 4; ++m) {
                const int row = row0 + ai * HALF + m * 16; float s = 0.f;
#pragma unroll
                for (int bj = 0; bj < 2; ++bj) { const f32x4 v0 = acc[ai][bj][m][0], v1 = acc[ai][bj][m][1];
                    s += (v0[0] * v0[0] + v0[1] * v0[1]) + (v0[2] * v0[2] + v0[3] * v0[3]) + (v1[0] * v1[0] + v1[1] * v1[1]) + (v1[2] * v1[2] + v1[3] * v1[3]);
                    u32x4 w; w.x = cvt_pk_bf16(v0[0], v0[1]); w.y = cvt_pk_bf16(v0[2], v0[3]); w.z = cvt_pk_bf16(v1[0], v1[1]); w.w = cvt_pk_bf16(v1[2], v1[3]);
                    *(u32x4*)(Y + (size_t)row * 2048 + col0 + bj * HALF) = w; }
                s += __shfl_xor(s, 16); s += __shfl_xor(s, 32);
                if (fq == 0) SSQ[(size_t)row * npart + u.pn * 4 + wc] = s;
            }
    }
};
struct EpiGLU {
    static constexpr bool PERM = true, AFTER_DRAIN = false;
    const bf16_t* GB; bf16_t* SPRE; const float* bias; float* SSQ2;
    __device__ __forceinline__ void operator()(const f32x4 (&acc)[2][2][4][2], const Unit& u, int wr, int wc, int fr, int fq) const {
        const int row0 = u.pm * BM + wr * 64 + fr, colb = u.pn * BM + wc * 32 + 8 * fq;
#pragma unroll
        for (int ai = 0; ai < 2; ++ai)
#pragma unroll
            for (int m = 0; m < 4; ++m) {
                const int row = row0 + ai * HALF + m * 16; float s = 0.f;
#pragma unroll
                for (int bj = 0; bj < 2; ++bj) {
                    const int col = colb + bj * HALF;
                    const u32x4 gw = *(const u32x4*)(GB + (size_t)row * 1024 + col);
                    const f32x4 b0 = *(const f32x4*)(bias + col), b1 = *(const f32x4*)(bias + col + 4);
                    const f32x4 z0 = acc[ai][bj][m][0] + b0, z1 = acc[ai][bj][m][1] + b1;
                    float o[8];
                    o[0] = bf_lo(gw.x) * sigmoid_f(z0[0]); o[1] = bf_hi(gw.x) * sigmoid_f(z0[1]); o[2] = bf_lo(gw.y) * sigmoid_f(z0[2]); o[3] = bf_hi(gw.y) * sigmoid_f(z0[3]);
                    o[4] = bf_lo(gw.z) * sigmoid_f(z1[0]); o[5] = bf_hi(gw.z) * sigmoid_f(z1[1]); o[6] = bf_lo(gw.w) * sigmoid_f(z1[2]); o[7] = bf_hi(gw.w) * sigmoid_f(z1[3]);
#pragma unroll
                    for (int k = 0; k < 8; ++k) s += o[k] * o[k];
                    u32x4 w; w.x = cvt_pk_bf16(o[0], o[1]); w.y = cvt_pk_bf16(o[2], o[3]); w.z = cvt_pk_bf16(o[4], o[5]); w.w = cvt_pk_bf16(o[6], o[7]);
                    *(u32x4*)(SPRE + (size_t)row * 1024 + col) = w;
                }
                s += __shfl_xor(s, 16); s += __shfl_xor(s, 32);
                if (fq == 0) SSQ2[(size_t)row * 16 + u.pn * 4 + wc] = s;
            }
    }
};
template <class Epi, class Sched, bool ALIGN_EPI = false, bool SP2 = false>
__device__ __forceinline__ void gemm_phase(PG8_LAS unsigned char* lds, const Gemm g, const Sched& S, const Epi& E) {
    const int tid = threadIdx.x, wid = __builtin_amdgcn_readfirstlane(tid >> 6), lane = tid & 63, wr = wid >> 2, wc = wid & 3, fr = lane & 15, fq = lane >> 4;
    const int K = g.K, nt = K / BK;
    unsigned voffA[2], voffB[2];
#pragma unroll
    for (int i = 0; i < 2; ++i) { int R, C; stage_rc(tid * 16 + i * 8192, R, C); const int Rb = Epi::PERM ? ((R & ~31) + perm32(R & 31)) : R;
        voffA[i] = (unsigned)(R * K + C) * 2u; voffB[i] = (unsigned)(Rb * K + C) * 2u; }
    const size_t kstep = (size_t)(BK * 2);
    const size_t hstep = (size_t)HALF * K * 2;
    const size_t tstep = 2 * hstep;
    const unsigned ldsw = (unsigned)wid * 1024u;
    const int aoff = lds_byte(wr * 64 + fr, fq * 8), boff = lds_byte(wc * 32 + fr, fq * 8);
#define PG8_SA(b, h) (((b) * 2 + (h)) * HTB)
#define PG8_SB(b, h) ((4 + (b) * 2 + (h)) * HTB)
#define PG8_STAGE(bufoff, gbase, voff) do { _Pragma("unroll") for (int _i = 0; _i < 2; ++_i) \
        __builtin_amdgcn_global_load_lds((const unsigned*)((const char*)(gbase) + (voff)[_i]), (PG8_LAS unsigned*)(lds + (bufoff) + ldsw + _i * 8192), 16, 0, 0); } while (0)
#define PG8_LDA(dst, b, h) do { _Pragma("unroll") for (int m = 0; m < 4; ++m) _Pragma("unroll") for (int k = 0; k < 2; ++k) dst[m][k] = *(const PG8_LAS bf16x8*)(lds + PG8_SA(b, h) + aoff + m * 2048 + k * 1024); } while (0)
#define PG8_LDB(dst, b, h) do { _Pragma("unroll") for (int n = 0; n < 2; ++n) _Pragma("unroll") for (int k = 0; k < 2; ++k) dst[n][k] = *(const PG8_LAS bf16x8*)(lds + PG8_SB(b, h) + boff + n * 2048 + k * 1024); } while (0)
#define PG8_MMA(ai, bj, At, Bt) do { __builtin_amdgcn_s_setprio(1); _Pragma("unroll") for (int m = 0; m < 4; ++m) _Pragma("unroll") for (int n = 0; n < 2; ++n) _Pragma("unroll") for (int k = 0; k < 2; ++k) \
        acc[ai][bj][m][n] = __builtin_amdgcn_mfma_f32_16x16x32_bf16(Bt[n][k], At[m][k], acc[ai][bj][m][n], 0, 0, 0); __builtin_amdgcn_s_setprio(0); } while (0)
#define PG8_WAIT_V(n) asm volatile("s_waitcnt vmcnt(" #n ")" ::: "memory")
#define PG8_WAIT_L(n) asm volatile("s_waitcnt lgkmcnt(" #n ")" ::: "memory")
#define PG8_BAR __builtin_amdgcn_s_barrier()
#define PG8_SCHED __builtin_amdgcn_sched_barrier(0)
    Unit cur, nxt; int ui = 0;
    if (!S.next(0, cur)) return;
    f32x4 acc[2][2][4][2];
#pragma unroll
    for (int a = 0; a < 2; ++a)
#pragma unroll
        for (int b = 0; b < 2; ++b)
#pragma unroll
            for (int m = 0; m < 4; ++m)
#pragma unroll
                for (int n = 0; n < 2; ++n) acc[a][b][m][n] = (f32x4){0.f, 0.f, 0.f, 0.f};
    bf16x8 At[4][2], B0[2][2], B1[2][2];
    const char* cA = (const char*)g.A + (size_t)cur.pm * tstep; const char* cB = (const char*)g.Bt + (size_t)cur.pn * tstep;
    S.a_ready(cur);
    if constexpr (SP2) {
        PG8_STAGE(PG8_SB(0, 0), cB, voffB); PG8_STAGE(PG8_SB(0, 1), cB + hstep, voffB); PG8_STAGE(PG8_SA(0, 0), cA, voffA); PG8_STAGE(PG8_SA(0, 1), cA + hstep, voffA);
        if (wr == 1) PG8_BAR;
        PG8_WAIT_V(2); PG8_BAR;
        PG8_STAGE(PG8_SB(1, 0), cB + kstep, voffB); PG8_STAGE(PG8_SA(1, 0), cA + kstep, voffA); PG8_STAGE(PG8_SB(1, 1), cB + hstep + kstep, voffB);
        PG8_WAIT_V(6); PG8_BAR;
    } else {
        PG8_STAGE(PG8_SB(0, 0), cB, voffB); PG8_STAGE(PG8_SA(0, 0), cA, voffA); PG8_STAGE(PG8_SB(0, 1), cB + hstep, voffB); PG8_STAGE(PG8_SA(0, 1), cA + hstep, voffA);
        if (wr == 1) PG8_BAR;
        PG8_WAIT_V(4); PG8_BAR;
        PG8_STAGE(PG8_SB(1, 0), cB + kstep, voffB); PG8_STAGE(PG8_SA(1, 0), cA + kstep, voffA); PG8_STAGE(PG8_SB(1, 1), cB + hstep + kstep, voffB);
        PG8_WAIT_V(6); PG8_BAR;
    }
    for (;;) {
        const bool has_next = S.next(ui + 1, nxt);
        const char* nA = has_next ? (const char*)g.A + (size_t)nxt.pm * tstep : cA; const char* nB = has_next ? (const char*)g.Bt + (size_t)nxt.pn * tstep : cB;
        for (int t = 0; t < nt; t += 2) {
            const bool last = (t == nt - 2);
            const char* a1 = cA + (size_t)(t + 1) * kstep;
            const char* a2 = last ? nA : cA + (size_t)(t + 2) * kstep; const char* b2 = last ? nB : cB + (size_t)(t + 2) * kstep;
            const char* a3 = a2 + kstep; const char* b3 = b2 + kstep;
            if (last && has_next) S.a_ready(nxt);
            if constexpr (SP2) {
            PG8_LDB(B0, 0, 0); PG8_LDB(B1, 0, 1); PG8_SCHED; PG8_LDA(At, 0, 0); PG8_STAGE(PG8_SA(1, 1), a1 + hstep, voffA);
            PG8_WAIT_V(8); PG8_WAIT_L(0); PG8_BAR; PG8_MMA(0, 0, At, B0); PG8_MMA(0, 1, At, B1); PG8_BAR; PG8_SCHED;
            PG8_LDA(At, 0, 1); PG8_STAGE(PG8_SB(0, 0), b2, voffB); PG8_STAGE(PG8_SB(0, 1), b2 + hstep, voffB); PG8_STAGE(PG8_SA(0, 0), a2, voffA);
            PG8_WAIT_V(8); PG8_WAIT_L(0); PG8_BAR; PG8_MMA(1, 0, At, B0); PG8_MMA(1, 1, At, B1); PG8_BAR; PG8_SCHED;
            PG8_LDB(B0, 1, 0); PG8_LDB(B1, 1, 1); PG8_SCHED; PG8_LDA(At, 1, 0); PG8_STAGE(PG8_SA(0, 1), a2 + hstep, voffA);
            PG8_WAIT_V(8); PG8_WAIT_L(0); PG8_BAR; PG8_MMA(0, 0, At, B0); PG8_MMA(0, 1, At, B1); PG8_BAR; PG8_SCHED;
            PG8_LDA(At, 1, 1); PG8_STAGE(PG8_SB(1, 0), b3, voffB); PG8_STAGE(PG8_SB(1, 1), b3 + hstep, voffB); PG8_STAGE(PG8_SA(1, 0), a3, voffA);
            PG8_WAIT_V(8); PG8_WAIT_L(0); PG8_BAR; PG8_MMA(1, 0, At, B0); PG8_MMA(1, 1, At, B1); PG8_BAR; PG8_SCHED;
            } else {
            PG8_LDB(B0, 0, 0); PG8_SCHED; PG8_LDA(At, 0, 0); PG8_STAGE(PG8_SA(1, 1), a1 + hstep, voffA);
            PG8_WAIT_L(8); PG8_BAR; PG8_WAIT_L(0); PG8_MMA(0, 0, At, B0); PG8_BAR; PG8_SCHED;
            PG8_LDB(B1, 0, 1); PG8_STAGE(PG8_SB(0, 0), b2, voffB);
            PG8_BAR; PG8_WAIT_L(0); PG8_MMA(0, 1, At, B1); PG8_BAR;
            PG8_LDA(At, 0, 1); PG8_STAGE(PG8_SA(0, 0), a2, voffA);
            PG8_BAR; PG8_WAIT_L(0); PG8_MMA(1, 0, At, B0); PG8_BAR; PG8_SCHED;
            PG8_STAGE(PG8_SB(0, 1), b2 + hstep, voffB);
            PG8_WAIT_V(6); PG8_BAR; PG8_MMA(1, 1, At, B1); PG8_BAR;
            PG8_LDB(B0, 1, 0); PG8_SCHED; PG8_LDA(At, 1, 0); PG8_STAGE(PG8_SA(0, 1), a2 + hstep, voffA);
            PG8_WAIT_L(8); PG8_BAR; PG8_WAIT_L(0); PG8_MMA(0, 0, At, B0); PG8_BAR; PG8_SCHED;
            PG8_LDB(B1, 1, 1); PG8_STAGE(PG8_SB(1, 0), b3, voffB);
            PG8_BAR; PG8_WAIT_L(0); PG8_MMA(0, 1, At, B1); PG8_BAR;
            PG8_LDA(At, 1, 1); PG8_STAGE(PG8_SA(1, 0), a3, voffA);
            PG8_BAR; PG8_WAIT_L(0); PG8_MMA(1, 0, At, B0); PG8_BAR; PG8_SCHED;
            PG8_STAGE(PG8_SB(1, 1), b3 + hstep, voffB);
            PG8_WAIT_V(6); PG8_BAR; PG8_MMA(1, 1, At, B1); PG8_BAR;
            }
        }
        if constexpr (ALIGN_EPI) { if (wr == 0) PG8_BAR; }
        if constexpr (!Epi::AFTER_DRAIN) { E(acc, cur, wr, wc, fr, fq); S.done(cur); }
        if (!has_next) break;
#pragma unroll
        for (int a = 0; a < 2; ++a)
#pragma unroll
            for (int b = 0; b < 2; ++b)
#pragma unroll
                for (int m = 0; m < 4; ++m)
#pragma unroll
                    for (int n = 0; n < 2; ++n) acc[a][b][m][n] = (f32x4){0.f, 0.f, 0.f, 0.f};
        cur = nxt; cA = nA; cB = nB; ++ui;
        if constexpr (ALIGN_EPI) { if (wr == 1) PG8_BAR; }
    }
    PG8_WAIT_V(0);
    if constexpr (!ALIGN_EPI) { if (wr == 0) PG8_BAR; }
    PG8_BAR;
    if constexpr (Epi::AFTER_DRAIN) { E.fused(acc, cur, wr, wc, fr, fq, lds, wid, lane); S.done(cur); }
#undef PG8_SA
#undef PG8_SB
#undef PG8_STAGE
#undef PG8_LDA
#undef PG8_LDB
#undef PG8_MMA
#undef PG8_WAIT_V
#undef PG8_WAIT_L
#undef PG8_BAR
#undef PG8_SCHED
}
}
namespace att {
typedef short bf16x8 __attribute__((ext_vector_type(8)));
typedef short s16x4 __attribute__((ext_vector_type(4)));
typedef float f32x16 __attribute__((ext_vector_type(16)));
typedef float f32x4 __attribute__((ext_vector_type(4)));
typedef unsigned u32x4 __attribute__((ext_vector_type(4)));
typedef unsigned short bf16_t;
constexpr int KVBLK = 64, LDK = 3072, NT = 2048 / KVBLK;
constexpr int SHM_V = KVBLK * 128 * 2, SHM_K = KVBLK * 128 * 2;
constexpr int WS_OFF = 131072;
constexpr float THRL = 11.5f;
#ifndef ATT_SDEPTH
#define ATT_SDEPTH 1
#endif
constexpr int SDEPTH = ATT_SDEPTH;
#define KSWZ(row, colB) ((row) * 256 + ((colB) ^ (((row) & 7) << 4)))
#define SBAR() __builtin_amdgcn_sched_barrier(0)
__device__ __forceinline__ int crow(int r, int hi) { return (r & 3) + 8 * (r >> 2) + 4 * hi; }
__device__ __forceinline__ unsigned cvtpk(float lo, float hi) { unsigned r; asm volatile("v_cvt_pk_bf16_f32 %0, %1, %2" : "=v"(r) : "v"(lo), "v"(hi)); return r; }

__device__ __forceinline__ float fadd_s(float a, float b) { float r; asm("v_add_f32_e32 %0, %1, %2" : "=v"(r) : "v"(a), "v"(b)); return r; }
__device__ __forceinline__ float fsub_s(float a, float b) { float r; asm("v_sub_f32_e32 %0, %1, %2" : "=v"(r) : "v"(a), "v"(b)); return r; }
__device__ __forceinline__ void partialSM(f32x16& p0, f32x16& p1, float& m_reg, float& mn, float& alpha) {
  float pmax = p0[0];
#pragma unroll
  for (int r = 1; r < 16; ++r) pmax = fmaxf(pmax, p0[r]);
#pragma unroll
  for (int r = 0; r < 16; ++r) pmax = fmaxf(pmax, p1[r]);
  { auto rr = __builtin_amdgcn_permlane32_swap(__float_as_uint(pmax), __float_as_uint(pmax), false, false);
    pmax = fmaxf(__uint_as_float(rr[0]), __uint_as_float(rr[1])); }
  if (__builtin_expect(__all(pmax - m_reg <= THRL), 1)) { mn = m_reg; alpha = 1.f; }
  else { mn = fmaxf(m_reg, pmax); alpha = __builtin_amdgcn_exp2f(m_reg - mn); m_reg = mn; }
#pragma unroll
  for (int r = 0; r < 16; ++r) p0[r] = fsub_s(p0[r], mn);
#pragma unroll
  for (int r = 0; r < 16; ++r) p1[r] = fsub_s(p1[r], mn);
#pragma unroll
  for (int r = 0; r < 16; ++r) p0[r] = __builtin_amdgcn_exp2f(p0[r]);
}
__device__ __forceinline__ void finishSM(f32x16& p0, f32x16& p1, float alpha, float& l_reg, bf16x8& pa0, bf16x8& pa1, bf16x8& pa2, bf16x8& pa3) {
#pragma unroll
  for (int r = 0; r < 16; ++r) p1[r] = __builtin_amdgcn_exp2f(p1[r]);
  float s0 = fadd_s(p0[0], p0[1]), s1 = fadd_s(p0[2], p0[3]), s2 = fadd_s(p1[0], p1[1]), s3 = fadd_s(p1[2], p1[3]);
#pragma unroll
  for (int r = 4; r < 16; r += 4) { s0 = fadd_s(s0, fadd_s(p0[r], p0[r + 1])); s1 = fadd_s(s1, fadd_s(p0[r + 2], p0[r + 3])); s2 = fadd_s(s2, fadd_s(p1[r], p1[r + 1])); s3 = fadd_s(s3, fadd_s(p1[r + 2], p1[r + 3])); }
  float ps = fadd_s(fadd_s(s0, s1), fadd_s(s2, s3));
  { auto rr = __builtin_amdgcn_permlane32_swap(__float_as_uint(ps), __float_as_uint(ps), false, false);
    ps = __uint_as_float(rr[0]) + __uint_as_float(rr[1]); }
  l_reg = l_reg * alpha + ps;
#define PK4(P, BASE, OUT) do { unsigned a0 = cvtpk(P[BASE + 0], P[BASE + 1]), a1 = cvtpk(P[BASE + 2], P[BASE + 3]);   \
    unsigned b0 = cvtpk(P[BASE + 4], P[BASE + 5]), b1 = cvtpk(P[BASE + 6], P[BASE + 7]);                              \
    auto r0 = __builtin_amdgcn_permlane32_swap(a0, b0, false, false); auto r1 = __builtin_amdgcn_permlane32_swap(a1, b1, false, false); \
    u32x4 w = {r0[0], r1[0], r0[1], r1[1]}; OUT = *reinterpret_cast<bf16x8*>(&w); } while (0)
  PK4(p0, 0, pa0); PK4(p0, 8, pa1); PK4(p1, 0, pa2); PK4(p1, 8, pa3);
#undef PK4
}
__device__ __forceinline__ float mul_abs(float a, float b) { float r; asm("v_mul_f32_e64 %0, %1, |%2|" : "=v"(r) : "v"(a), "v"(b)); return r; }
__device__ __forceinline__ void qkt(f32x16& p0, f32x16& p1, const char* Ks, const char* qr, int r32, int hi, int cofs, float dq, float nsl) {
#pragma unroll
  for (int r = 0; r < 16; ++r) { const float cr = (float)((r & 3) + 8 * (r >> 2)); p0[r] = mul_abs(nsl, dq - cr); p1[r] = mul_abs(nsl, dq - (32.f + cr)); }
#pragma unroll
  for (int d0 = 0; d0 < 4; ++d0) { const int cb = cofs + d0 * 32 + hi * 16;
    bf16x8 b0 = *reinterpret_cast<const bf16x8*>(Ks + KSWZ(r32, cb));
    bf16x8 b1 = *reinterpret_cast<const bf16x8*>(Ks + KSWZ(32 + r32, cb));
    const bf16x8 qf = *reinterpret_cast<const bf16x8*>(qr + d0 * 1024);
    p0 = __builtin_amdgcn_mfma_f32_32x32x16_bf16(b0, qf, p0, 0, 0, 0);
    p1 = __builtin_amdgcn_mfma_f32_32x32x16_bf16(b1, qf, p1, 0, 0, 0); }
}
__device__ __forceinline__ int v_st(int k, int c) { const int kk = (k & ~0xC) | ((k & 4) << 1) | ((k & 8) >> 1); return ((kk >> 3) * 4 + (c >> 5)) * 512 + ((kk & 7) * 32 + (c & 31)) * 2; }
__device__ __forceinline__ int v_rd_base(int lane) { return ((lane & 3) << 3) | (((lane >> 2) & 3) << 6) | (((lane >> 4) & 1) << 5) | (((lane >> 5) & 1) << 8); }
constexpr int v_rd_off(int d0, int ks, int half) { return d0 * 512 + ks * 4096 + half * 2048; }
template <int OFF> __device__ __forceinline__ s16x4 tr_read(int vb) {
  s16x4 r; asm volatile("ds_read_b64_tr_b16 %0, %1 offset:%2" : "=&v"(r) : "v"(vb), "i"(OFF) : "memory"); return r;
}
template <int D0> __device__ __forceinline__ void pv_one(f32x16& od, int vb, bf16x8 pa0, bf16x8 pa1, bf16x8 pa2, bf16x8 pa3) {
  const s16x4 l0 = tr_read<v_rd_off(D0, 0, 0)>(vb), h0 = tr_read<v_rd_off(D0, 0, 1)>(vb), l1 = tr_read<v_rd_off(D0, 1, 0)>(vb), h1 = tr_read<v_rd_off(D0, 1, 1)>(vb);
  const s16x4 l2 = tr_read<v_rd_off(D0, 2, 0)>(vb), h2 = tr_read<v_rd_off(D0, 2, 1)>(vb), l3 = tr_read<v_rd_off(D0, 3, 0)>(vb), h3 = tr_read<v_rd_off(D0, 3, 1)>(vb);
  asm volatile("s_waitcnt lgkmcnt(0)" ::: "memory"); SBAR();
#define PK(L, H) (bf16x8){L[0], L[1], L[2], L[3], H[0], H[1], H[2], H[3]}
  od = __builtin_amdgcn_mfma_f32_32x32x16_bf16(pa0, PK(l0, h0), od, 0, 0, 0);
  od = __builtin_amdgcn_mfma_f32_32x32x16_bf16(pa1, PK(l1, h1), od, 0, 0, 0);
  od = __builtin_amdgcn_mfma_f32_32x32x16_bf16(pa2, PK(l2, h2), od, 0, 0, 0);
  od = __builtin_amdgcn_mfma_f32_32x32x16_bf16(pa3, PK(l3, h3), od, 0, 0, 0);
#undef PK
}
__device__ __forceinline__ void pv_d0(f32x16* o, int vb, bf16x8 pa0, bf16x8 pa1, bf16x8 pa2, bf16x8 pa3) {
  pv_one<0>(o[0], vb, pa0, pa1, pa2, pa3); pv_one<1>(o[1], vb, pa0, pa1, pa2, pa3); pv_one<2>(o[2], vb, pa0, pa1, pa2, pa3); pv_one<3>(o[3], vb, pa0, pa1, pa2, pa3);
}

__device__ __forceinline__ void attn_unit(const bf16_t* __restrict__ QKV, bf16_t* __restrict__ CAT, int b, int h, int qb, float lam, const float* __restrict__ head_g, char* lds) {
  const int tid = threadIdx.x, wid = tid >> 6, lane = tid & 63, r32 = lane & 31, hi = lane >> 5, cmap = wid >> 2, wq = wid & 3;
  char* V_lds = lds; char* K_lds = lds + 2 * SHM_V;
  float* ws = (float*)(lds + WS_OFF) + wid * 64; float* li_l = ws; float* al_l = ws + 32;
  float m_reg = -1e30f, l_reg = 0; f32x16 o[4] = {};
  char* qr = lds + 65536 + wid * 4096 + lane * 16;
  const bf16_t* Qw = QKV + (size_t)(b * 2048 + qb * 128 + wq * 32 + r32) * LDK + h * 128 + cmap * 64 + hi * 8;
#pragma unroll
  for (int d0 = 0; d0 < 4; ++d0) *reinterpret_cast<bf16x8*>(qr + d0 * 1024) = *reinterpret_cast<const bf16x8*>(Qw + d0 * 16);
  const bf16_t* Kh = QKV + (size_t)(b * 2048) * LDK + 1024 + h * 128;
  const bf16_t* Vh = QKV + (size_t)(b * 2048) * LDK + 2048 + h * 128;
  const float dqb = (float)(qb * 128 + wq * 32 + r32 - 4 * hi);
  const float nsl = -1.4426950408889634f * __builtin_amdgcn_exp2f(-(float)(h + 1));
  const int cofs = cmap * 128;
  const int sr = tid >> 4, sc = (tid & 15) * 8, vst0 = v_st(sr, sc), vst1 = v_st(32 + sr, sc);
  const int vb0 = (int)(uintptr_t)V_lds + v_rd_base(lane);
  struct { bf16x8 vs0, vs1, ks0, ks1; } sr_[SDEPTH];
#define SLOAD(i, k0) do { sr_[i].vs0 = *reinterpret_cast<const bf16x8*>(&Vh[(size_t)((k0) + sr) * LDK + sc]); sr_[i].vs1 = *reinterpret_cast<const bf16x8*>(&Vh[(size_t)((k0) + 32 + sr) * LDK + sc]); \
    sr_[i].ks0 = *reinterpret_cast<const bf16x8*>(&Kh[(size_t)((k0) + sr) * LDK + sc]); sr_[i].ks1 = *reinterpret_cast<const bf16x8*>(&Kh[(size_t)((k0) + 32 + sr) * LDK + sc]); } while (0)
#define SWRITE(bb, i) do { *(bf16x8*)(V_lds + (bb) * SHM_V + vst0) = sr_[i].vs0;          \
    *(bf16x8*)(V_lds + (bb) * SHM_V + vst1) = sr_[i].vs1; int kc = sc * 2;               \
    *(bf16x8*)(K_lds + (bb) * SHM_K + KSWZ(sr, kc)) = sr_[i].ks0;                       \
    *(bf16x8*)(K_lds + (bb) * SHM_K + KSWZ(32 + sr, kc)) = sr_[i].ks1; } while (0)
#define SWAIT() do { if constexpr (SDEPTH == 2) asm volatile("s_waitcnt vmcnt(4)" ::: "memory"); else asm volatile("s_waitcnt vmcnt(0)" ::: "memory"); } while (0)
#define RESC(a) do { if (__any((a) < 1.f)) { if (hi == 0) al_l[r32] = (a); asm volatile("s_waitcnt lgkmcnt(0)" ::: "memory"); \
    _Pragma("unroll") for (int d = 0; d < 4; ++d) _Pragma("unroll") for (int r = 0; r < 16; ++r) o[d][r] *= al_l[crow(r, hi)]; } } while (0)
  f32x16 pA0, pA1, pB0, pB1; float mnA, mnB, alA, alB; bf16x8 pa0, pa1, pa2, pa3;
  constexpr int SE = 0, SO = SDEPTH - 1;
  SLOAD(SE, 0); asm volatile("s_waitcnt vmcnt(0)" ::: "memory"); SWRITE(0, SE); __syncthreads();
  qkt(pA0, pA1, K_lds, qr, r32, hi, cofs, dqb, nsl); partialSM(pA0, pA1, m_reg, mnA, alA);
  SLOAD(SO, KVBLK); if constexpr (SDEPTH == 2) SLOAD(SE, 2 * KVBLK);
  SWAIT(); SWRITE(1, SO); __syncthreads();
  for (int j = 1; j + 1 < NT; j += 2) {
    SBAR(); qkt(pB0, pB1, K_lds + SHM_K, qr, r32, hi, cofs, dqb - (float)(j * KVBLK), nsl);
    finishSM(pA0, pA1, alA, l_reg, pa0, pa1, pa2, pa3); SBAR();
    SLOAD(SO, (j + SDEPTH) * KVBLK); SBAR();
    pv_d0(o, vb0, pa0, pa1, pa2, pa3); partialSM(pB0, pB1, m_reg, mnB, alB);
    __syncthreads(); SWAIT(); SWRITE(0, SE);
    RESC(alB); __syncthreads();
    SBAR(); qkt(pA0, pA1, K_lds, qr, r32, hi, cofs, dqb - (float)((j + 1) * KVBLK), nsl);
    finishSM(pB0, pB1, alB, l_reg, pa0, pa1, pa2, pa3); SBAR();
    if (SDEPTH == 1 || j + 3 < NT) SLOAD(SE, (j + 1 + SDEPTH) * KVBLK); SBAR();
    pv_d0(o, vb0 + SHM_V, pa0, pa1, pa2, pa3); partialSM(pA0, pA1, m_reg, mnA, alA);
    __syncthreads(); SWAIT(); SWRITE(1, SO);
    RESC(alA); __syncthreads();
  }
  SBAR(); qkt(pB0, pB1, K_lds + SHM_K, qr, r32, hi, cofs, dqb - (float)((NT - 1) * KVBLK), nsl);
  finishSM(pA0, pA1, alA, l_reg, pa0, pa1, pa2, pa3); SBAR();
  pv_d0(o, vb0, pa0, pa1, pa2, pa3); partialSM(pB0, pB1, m_reg, mnB, alB);
  __syncthreads(); RESC(alB);
  finishSM(pB0, pB1, alB, l_reg, pa0, pa1, pa2, pa3); SBAR();
  pv_d0(o, vb0 + SHM_V, pa0, pa1, pa2, pa3);
  if (hi == 0) li_l[r32] = l_reg; asm volatile("s_waitcnt lgkmcnt(0)" ::: "memory");
  float rli[16];
#pragma unroll
  for (int r = 0; r < 16; ++r) rli[r] = __builtin_amdgcn_rcpf(li_l[crow(r, hi)]);
  __syncthreads();
  float* OB = (float*)lds + cmap * 16384 + (wq * 32) * 128;
#pragma unroll
  for (int r = 0; r < 16; ++r) { const int orow = crow(r, hi);
#pragma unroll
    for (int d0 = 0; d0 < 4; ++d0) OB[orow * 128 + d0 * 32 + r32] = o[d0][r] * rli[r]; }
  __syncthreads();
  { const int row = tid >> 2, qtr = tid & 3;
    const f32x4* o1 = (const f32x4*)((const float*)lds + row * 128 + qtr * 32); const f32x4* o2 = o1 + 4096;
    f32x4 v[8]; float ssq = 0.f;
#pragma unroll
    for (int k = 0; k < 8; ++k) { v[k] = o1[k] - lam * o2[k]; ssq += (v[k][0] * v[k][0] + v[k][1] * v[k][1]) + (v[k][2] * v[k][2] + v[k][3] * v[k][3]); }
    ssq += __shfl_xor(ssq, 1); ssq += __shfl_xor(ssq, 2);
    const float rs = rsqrtf(ssq * (1.0f / 128.0f) + 1e-6f) * 0.8f;
    bf16_t* dst = CAT + (size_t)(b * 2048 + qb * 128 + row) * 2048 + h * 128 + qtr * 32;
    const f32x4* hg = (const f32x4*)(head_g + qtr * 32);
#pragma unroll
    for (int k = 0; k < 8; k += 2) { const f32x4 g0 = hg[k], g1 = hg[k + 1]; const f32x4 a = v[k] * rs * g0, c = v[k + 1] * rs * g1;
      u32x4 w; w.x = cvtpk(a[0], a[1]); w.y = cvtpk(a[2], a[3]); w.z = cvtpk(c[0], c[1]); w.w = cvtpk(c[2], c[3]);
      *(u32x4*)(dst + k * 4) = w; }
  }
  __syncthreads();
#undef SLOAD
#undef SWRITE
#undef SWAIT
#undef RESC
}
#undef SBAR
}
#define LAS __attribute__((address_space(3)))
typedef unsigned short bf16_t;
typedef short bf16x8 __attribute__((ext_vector_type(8)));
typedef float f32x4 __attribute__((ext_vector_type(4)));
typedef float f32x16 __attribute__((ext_vector_type(16)));
typedef unsigned u32x4 __attribute__((ext_vector_type(4)));
typedef unsigned u32x2 __attribute__((ext_vector_type(2)));
constexpr int DM = 2048, BATCH = 4, SEQ = 2048, MT = BATCH * SEQ, DFF = 5632, NGU = 2 * DFF, INC = 4096, SW = 1024;
constexpr int SG = 64, CT = 16, NCH = SEQ / CT, NROW = BATCH * NCH;
constexpr float EPS = 1e-6f;
constexpr int NWAVES = 8, LDS_BYTES = 136 * 1024;
constexpr size_t al256(size_t x) { return (x + 255) / 256 * 256; }
constexpr size_t WS_W1G = 0;
constexpr size_t WS_W1D = WS_W1G + (size_t)NGU * DM * 2;
constexpr size_t WS_WIN = WS_W1D + (size_t)DM * DFF * 2;
constexpr size_t WS_WOUT = WS_WIN + (size_t)INC * DM * 2;
constexpr size_t WS_WGLU = WS_WOUT + (size_t)DM * DM * 2;
constexpr size_t WS_XN = WS_WGLU + (size_t)SW * SW * 2;
constexpr size_t WS_HFF = WS_XN + (size_t)MT * DM * 2;
constexpr size_t WS_QKV = WS_HFF, WS_UG = WS_QKV + (size_t)MT * 3072 * 2, WS_HIN = WS_UG + (size_t)SG * NROW * 256 * 2;
constexpr size_t WS_Y = WS_HFF + (size_t)MT * DFF * 2;
constexpr size_t WS_SLOC = WS_Y, WS_GB = WS_SLOC + (size_t)SG * NROW * 256 * 4, WS_SPRE = WS_GB + (size_t)MT * SW * 2;
constexpr size_t WS_SSQ = WS_Y + (size_t)MT * DM * 4;
constexpr size_t WS_SSQ2 = WS_SSQ + (size_t)MT * 32 * 4;
constexpr size_t WS_EMAT = WS_SSQ2 + (size_t)MT * 16 * 4;
constexpr size_t WS_MFT = WS_EMAT + (size_t)SG * 8 * 16 * 1024;
constexpr size_t WS_ATAB = WS_MFT + (size_t)SG * 8 * 32 * 1024;
constexpr size_t WS_X1 = WS_ATAB + (size_t)SG * 2 * 64 * 2 * 4;
constexpr size_t WS_RS = WS_X1 + (size_t)MT * DM * 2;
constexpr size_t WS_CTL = WS_RS + (size_t)MT * 4;
constexpr size_t CTL_BYTES = 16384;
constexpr size_t WS_END = WS_CTL + CTL_BYTES;
constexpr int LDS_BARST = 133120;
static_assert(WS_HIN + (size_t)SG * NROW * 256 * 2 <= WS_Y && WS_SPRE + (size_t)MT * SW * 2 <= WS_SSQ, "overlays");

__device__ __forceinline__ unsigned cvtpk(float lo, float hi) { unsigned r; asm volatile("v_cvt_pk_bf16_f32 %0, %1, %2" : "=v"(r) : "v"(lo), "v"(hi)); return r; }
__device__ __forceinline__ float wave_sum(float v) {
#pragma unroll
    for (int o = 1; o < 64; o <<= 1) v += __shfl_xor(v, o);
    return v;
}
__device__ __forceinline__ float bf2f_lo(unsigned w) { return __uint_as_float(w << 16); }
__device__ __forceinline__ float bf2f_hi(unsigned w) { return __uint_as_float(w & 0xffff0000u); }

struct Params { const float* in[31]; float* out; unsigned char* ws; int ph_lo, ph_hi; };

__device__ __forceinline__ void transpose_item(const float* __restrict__ W, int K, int N, bf16_t* __restrict__ WT, int k0, int n0, int rowbase, LAS float* scr, int lane, const float* __restrict__ gk = nullptr) {
    const int r0 = lane >> 3, c4 = (lane & 7) * 4;
    const float* src = W + (size_t)(k0 + r0) * N + n0 + c4;
    f32x4 v[8];
#pragma unroll
    for (int i = 0; i < 8; ++i) v[i] = __builtin_nontemporal_load((const f32x4*)(src + (size_t)(8 * i) * N));
    if (gk) {
#pragma unroll
        for (int i = 0; i < 8; ++i) v[i] = v[i] * gk[k0 + r0 + 8 * i]; }
#pragma unroll
    for (int i = 0; i < 8; ++i) { LAS float* d = scr + (r0 + 8 * i) * 33 + c4; d[0] = v[i][0]; d[1] = v[i][1]; d[2] = v[i][2]; d[3] = v[i][3]; }
    asm volatile("s_waitcnt lgkmcnt(0)" ::: "memory");
    const int c = lane & 7;
#pragma unroll
    for (int j = 0; j < 4; ++j) { const int n = (lane >> 3) + 8 * j; const LAS float* s = scr + (8 * c) * 33 + n;
        u32x4 o; o.x = cvtpk(s[0 * 33], s[1 * 33]); o.y = cvtpk(s[2 * 33], s[3 * 33]); o.z = cvtpk(s[4 * 33], s[5 * 33]); o.w = cvtpk(s[6 * 33], s[7 * 33]);
        *(u32x4*)(WT + (size_t)(rowbase + n) * K + k0 + 8 * c) = o; }
    asm volatile("s_waitcnt lgkmcnt(0)" ::: "memory");
}
constexpr int GU_ITEMS = 2 * (DM / 64) * (DFF / 32);
__device__ __forceinline__ void convert_gateup(const float* wg, const float* wu, const float* gk, unsigned char* ws, LAS float* scr, int gw, int ngw, int lane, int it0 = 0, int it1 = GU_ITEMS) {
    constexpr int IG = (DM / 64) * (DFF / 32);
    bf16_t* G = (bf16_t*)(ws + WS_W1G);
    for (int it = it0 + gw; it < it1; it += ngw) {
        int r = it; const int up = r >= IG; if (up) r -= IG; const int nb = r % (DFF / 32), kb = r / (DFF / 32), n0 = nb * 32;
        transpose_item(up ? wu : wg, DM, DFF, G, kb * 64, n0, (n0 >> 7) * 256 + (n0 & 127) + up * 128, scr, lane, gk);
    }
}
__device__ __forceinline__ void convert_plain(const float* w, int K, int N, bf16_t* WT, LAS float* scr, int gw, int ngw, int lane, const float* gk = nullptr) {
    const int items = (K / 64) * (N / 32);
    for (int r = gw; r < items; r += ngw) { const int nb = r % (N / 32), kb = r / (N / 32); transpose_item(w, K, N, WT, kb * 64, nb * 32, nb * 32, scr, lane, gk); }
}
__device__ __forceinline__ void prenorm_rows(const float* __restrict__ X, bf16_t* __restrict__ XB, float* __restrict__ RS, int gw, int ngw, int lane) {
    for (int row = gw; row < MT; row += ngw) {
        const f32x4* xr = (const f32x4*)(X + (size_t)row * DM) + lane; f32x4 v[8]; float s = 0.f;
#pragma unroll
        for (int j = 0; j < 8; ++j) { v[j] = xr[64 * j]; s += (v[j][0] * v[j][0] + v[j][1] * v[j][1]) + (v[j][2] * v[j][2] + v[j][3] * v[j][3]); }
        s = wave_sum(s);
        if (lane == 0) RS[row] = rsqrtf(s * (1.0f / DM) + EPS);
        u32x2* o8 = (u32x2*)(XB + (size_t)row * DM) + lane;
#pragma unroll
        for (int j = 0; j < 8; ++j) { u32x2 w; w.x = cvtpk(v[j][0], v[j][1]); w.y = cvtpk(v[j][2], v[j][3]); o8[64 * j] = w; }
    }
}
template <bool SRCBF, bool FINAL>
__device__ __forceinline__ void resid_rows(const void* SRC, const bf16_t* __restrict__ Y, const float* __restrict__ SSQ, int npart, const float* __restrict__ gpost, float coef,
                                           float* OUTF, bf16_t* XB, float* RS, int gw, int ngw, int lane) {
    for (int row = gw; row < MT; row += ngw) {
        float s = lane < npart ? SSQ[(size_t)row * npart + lane] : 0.f;
        const float rs = rsqrtf(wave_sum(s) * (1.0f / DM) + EPS) * coef;
        const u32x2* yr = (const u32x2*)(Y + (size_t)row * DM) + lane;
        f32x4 v[8]; float s1 = 0.f;
#pragma unroll
        for (int j = 0; j < 8; ++j) { const f32x4 gg = ((const f32x4*)gpost)[lane + 64 * j];
            const u32x2 yw = yr[64 * j]; const f32x4 yv = {bf2f_lo(yw.x), bf2f_hi(yw.x), bf2f_lo(yw.y), bf2f_hi(yw.y)};
            f32x4 xv;
            if (SRCBF) { const u32x2 xw = ((const u32x2*)((const bf16_t*)SRC + (size_t)row * DM) + lane)[64 * j]; xv = (f32x4){bf2f_lo(xw.x), bf2f_hi(xw.x), bf2f_lo(xw.y), bf2f_hi(xw.y)}; }
            else xv = ((const f32x4*)((const float*)SRC + (size_t)row * DM) + lane)[64 * j];
            v[j] = xv + yv * rs * gg;
            s1 += (v[j][0] * v[j][0] + v[j][1] * v[j][1]) + (v[j][2] * v[j][2] + v[j][3] * v[j][3]); }
        if (FINAL) { f32x4* orow = (f32x4*)(OUTF + (size_t)row * DM) + lane;
#pragma unroll
            for (int j = 0; j < 8; ++j) __builtin_nontemporal_store(v[j], &orow[64 * j]);
        } else {
            s1 = wave_sum(s1);
            if (lane == 0) RS[row] = rsqrtf(s1 * (1.0f / DM) + EPS);
            u32x2* o8 = (u32x2*)(XB + (size_t)row * DM) + lane;
#pragma unroll
            for (int j = 0; j < 8; ++j) { u32x2 w; w.x = cvtpk(v[j][0], v[j][1]); w.y = cvtpk(v[j][2], v[j][3]); o8[64 * j] = w; }
        }
    }
}
__device__ __forceinline__ void snorm_rows(const bf16_t* __restrict__ SPRE, const float* __restrict__ SSQ2, const float* __restrict__ og, bf16_t* __restrict__ CAT, int gw, int ngw, int lane) {
    for (int row = gw; row < MT; row += ngw) {
        float s = lane < 16 ? SSQ2[(size_t)row * 16 + lane] : 0.f;
        const float rs = rsqrtf(wave_sum(s) * (1.0f / SW) + EPS);
#pragma unroll
        for (int j = 0; j < 2; ++j) { const int c8 = lane + 64 * j; const u32x4 w = *((const u32x4*)(SPRE + (size_t)row * SW) + c8);
            const f32x4 g0 = ((const f32x4*)og)[2 * c8], g1 = ((const f32x4*)og)[2 * c8 + 1]; u32x4 o;
            o.x = cvtpk(bf2f_lo(w.x) * rs * g0[0], bf2f_hi(w.x) * rs * g0[1]); o.y = cvtpk(bf2f_lo(w.y) * rs * g0[2], bf2f_hi(w.y) * rs * g0[3]);
            o.z = cvtpk(bf2f_lo(w.z) * rs * g1[0], bf2f_hi(w.z) * rs * g1[1]); o.w = cvtpk(bf2f_lo(w.w) * rs * g1[2], bf2f_hi(w.w) * rs * g1[3]);
            *((u32x4*)(CAT + (size_t)row * DM + SW) + c8) = o; }
    }
}

__device__ __forceinline__ void s5_tables(const Params& p, int g, float* L) {
    const int t = threadIdx.x;
    float* APOW = L; float* FF = APOW + 2 * 64 * 17 * 2; float* BB = FF + 2 * 64 * 2; float* CC = BB + 2 * 64 * 16 * 2; float* KL = CC + 2 * 16 * 65 * 2;
    unsigned char* ws = p.ws;
    __syncthreads();
    if (t < 128) {
        const int dir = t >> 6, n = t & 63, idx = (dir * SG + g) * 64 + n;
        const float lr = p.in[13][idx], li = p.in[14][idx], dt = expf(p.in[15][dir * SG + g]);
        const float mag = expf(lr * dt), ar = mag * cosf(li * dt), ai = mag * sinf(li * dt);
        const float den = lr * lr + li * li, nr = ar - 1.0f;
        FF[(dir * 64 + n) * 2] = (nr * lr + ai * li) / den; FF[(dir * 64 + n) * 2 + 1] = (ai * lr - nr * li) / den;
        float pr = 1.f, pi = 0.f;
        for (int k = 0; k <= 16; ++k) { APOW[((dir * 64 + n) * 17 + k) * 2] = pr; APOW[((dir * 64 + n) * 17 + k) * 2 + 1] = pi; const float qr = pr * ar - pi * ai, qi = pr * ai + pi * ar; pr = qr; pi = qi; }
        float* AT = (float*)(ws + WS_ATAB) + ((g * 2 + dir) * 64 + n) * 2;
        AT[0] = APOW[((dir * 64 + n) * 17 + 16) * 2]; AT[1] = APOW[((dir * 64 + n) * 17 + 16) * 2 + 1];
    }
    __syncthreads();
    for (int e = t; e < 2048; e += 512) {
        { const int dir = e >> 10, n = (e >> 4) & 63, q = e & 15; const size_t bi = ((size_t)(dir * SG + g) * 64 + n) * 16 + q;
          const float br = p.in[16][bi], bim = p.in[17][bi], fr = FF[(dir * 64 + n) * 2], fi = FF[(dir * 64 + n) * 2 + 1];
          BB[((dir * 64 + n) * 16 + q) * 2] = fr * br - fi * bim; BB[((dir * 64 + n) * 16 + q) * 2 + 1] = fr * bim + fi * br; }
        { const int dir = e >> 10, pp = (e >> 6) & 15, n = e & 63; const size_t ci = ((size_t)(dir * SG + g) * 16 + pp) * 64 + n;
          CC[((dir * 16 + pp) * 65 + n) * 2] = p.in[18][ci]; CC[((dir * 16 + pp) * 65 + n) * 2 + 1] = p.in[19][ci]; }
    }
    __syncthreads();
    {
        typedef float f32x2 __attribute__((ext_vector_type(2)));
        const int pp = t & 15, l = (t >> 4) & 15, dir = t >> 8;
        float acc[16];
#pragma unroll
        for (int q = 0; q < 16; ++q) acc[q] = 0.f;
        for (int n = 0; n < 64; ++n) {
            const f32x2 c = *(const f32x2*)(CC + ((dir * 16 + pp) * 65 + n) * 2), a = *(const f32x2*)(APOW + ((dir * 64 + n) * 17 + l) * 2);
            const float wr = c.x * a.x - c.y * a.y, wi = c.x * a.y + c.y * a.x;
#pragma unroll
            for (int q = 0; q < 16; ++q) { const f32x2 bq = *(const f32x2*)(BB + ((dir * 64 + n) * 16 + q) * 2); acc[q] += wr * bq.x - wi * bq.y; }
        }
#pragma unroll
        for (int q = 0; q < 16; ++q) KL[((dir * 16 + l) * 16 + pp) * 16 + q] = acc[q];
    }
    __syncthreads();
    for (int ch = t; ch < 8192; ch += 512) {
        const int lane = ch & 63, ks = (ch >> 6) & 15, nt = ch >> 10, np = nt * 32 + (lane & 31), dir = np >> 7, ri = (np >> 6) & 1, n = np & 63, q0 = (lane >> 5) * 8;
        const int pw = dir == 0 ? 15 - ks : ks;
        const float ar = APOW[((dir * 64 + n) * 17 + pw) * 2], ai = APOW[((dir * 64 + n) * 17 + pw) * 2 + 1];
        float z[8];
#pragma unroll
        for (int j = 0; j < 8; ++j) { const float br = BB[((dir * 64 + n) * 16 + q0 + j) * 2], bi = BB[((dir * 64 + n) * 16 + q0 + j) * 2 + 1]; z[j] = ri ? (ar * bi + ai * br) : (ar * br - ai * bi); }
        u32x4 o; o.x = cvtpk(z[0], z[1]); o.y = cvtpk(z[2], z[3]); o.z = cvtpk(z[4], z[5]); o.w = cvtpk(z[6], z[7]);
        *(u32x4*)(ws + WS_EMAT + ((size_t)((g * 8 + nt) * 16 + ks)) * 1024 + lane * 16) = o;
    }
    for (int ch = t; ch < 16384; ch += 512) {
        const int lane = ch & 63, ks = (ch >> 6) & 31, nt = ch >> 11, no = nt * 32 + (lane & 31), tau = no >> 4, pp = no & 15;
        float z[8];
        if (ks < 16) { const int sg = ks, q0 = (lane >> 5) * 8;
#pragma unroll
            for (int j = 0; j < 8; ++j) { const int q = q0 + j; float v = 0.f;
                if (sg <= tau) v += KL[((0 * 16 + (tau - sg)) * 16 + pp) * 16 + q];
                if (sg >= tau) v += KL[((1 * 16 + (sg - tau)) * 16 + pp) * 16 + q];
                if (sg == tau && pp == q) v += p.in[20][g * 16 + pp];
                z[j] = v; }
        } else { const int np0 = (ks - 16) * 16 + (lane >> 5) * 8, dir = np0 >> 7, ri = (np0 >> 6) & 1, n0 = np0 & 63, pw = dir == 0 ? tau + 1 : 16 - tau;
#pragma unroll
            for (int j = 0; j < 8; ++j) { const int n = n0 + j; const float cr = CC[((dir * 16 + pp) * 65 + n) * 2], ci = CC[((dir * 16 + pp) * 65 + n) * 2 + 1];
                const float ar = APOW[((dir * 64 + n) * 17 + pw) * 2], ai = APOW[((dir * 64 + n) * 17 + pw) * 2 + 1];
                z[j] = ri ? -(cr * ai + ci * ar) : (cr * ar - ci * ai); }
        }
        u32x4 o; o.x = cvtpk(z[0], z[1]); o.y = cvtpk(z[2], z[3]); o.z = cvtpk(z[4], z[5]); o.w = cvtpk(z[6], z[7]);
        *(u32x4*)(ws + WS_MFT + ((size_t)((g * 8 + nt) * 32 + ks)) * 1024 + lane * 16) = o;
    }
    __syncthreads();
}
__device__ __forceinline__ int crow16(int r, int hi) { return (r & 3) + 8 * (r >> 2) + 4 * hi; }
__device__ __forceinline__ void s5_estate(unsigned char* ws, int gw, int ngw, int lane) {
    for (int task = gw; task < SG * 16 * 2; task += ngw) {
        const int nh = task & 1, rt = (task >> 1) & 15, g = task >> 5, r32 = lane & 31, hi = lane >> 5;
        const bf16_t* A = (const bf16_t*)(ws + WS_UG) + ((size_t)(g * NROW + rt * 32 + r32)) * 256 + hi * 8;
        const unsigned char* B = ws + WS_EMAT + (size_t)(g * 8 + nh * 4) * 16 * 1024 + lane * 16;
        f32x16 acc[4] = {};
#pragma unroll 4
        for (int ks = 0; ks < 16; ++ks) { const bf16x8 a = *(const bf16x8*)(A + ks * 16);
#pragma unroll
            for (int nt = 0; nt < 4; ++nt) { const bf16x8 b = *(const bf16x8*)(B + (size_t)(nt * 16 + ks) * 1024); acc[nt] = __builtin_amdgcn_mfma_f32_32x32x16_bf16(a, b, acc[nt], 0, 0, 0); } }
        float* S = (float*)(ws + WS_SLOC) + ((size_t)(g * NROW + rt * 32)) * 256 + nh * 128 + r32;
#pragma unroll
        for (int nt = 0; nt < 4; ++nt)
#pragma unroll
            for (int r = 0; r < 16; ++r) S[(size_t)crow16(r, hi) * 256 + nt * 32] = acc[nt][r];
    }
}
__device__ __forceinline__ void s5_scan(unsigned char* ws, int gw, int ngw, int lane) {
    for (int task = gw; task < BATCH * SG * 2; task += ngw) {
        const int dir = task & 1, g = (task >> 1) & 63, b = task >> 7;
        const float* AT = (const float*)(ws + WS_ATAB) + ((g * 2 + dir) * 64 + lane) * 2; const float ar = AT[0], ai = AT[1];
        const float* S = (const float*)(ws + WS_SLOC) + ((size_t)(g * NROW + b * NCH)) * 256 + dir * 128 + lane;
        bf16_t* H = (bf16_t*)(ws + WS_HIN) + ((size_t)(g * NROW + b * NCH)) * 256 + dir * 128 + lane;
        float hr = 0.f, hi = 0.f;
        for (int c0 = 0; c0 < NCH; c0 += 16) {
            float sr[16], si[16];
#pragma unroll
            for (int k = 0; k < 16; ++k) { const int c = dir == 0 ? c0 + k : NCH - 1 - (c0 + k); sr[k] = S[(size_t)c * 256]; si[k] = S[(size_t)c * 256 + 64]; }
#pragma unroll
            for (int k = 0; k < 16; ++k) { const int c = dir == 0 ? c0 + k : NCH - 1 - (c0 + k);
                H[(size_t)c * 256] = (bf16_t)(cvtpk(hr, 0.f) & 0xffffu); H[(size_t)c * 256 + 64] = (bf16_t)(cvtpk(hi, 0.f) & 0xffffu);
                const float nr = ar * hr - ai * hi + sr[k], ni = ar * hi + ai * hr + si[k]; hr = nr; hi = ni; }
        }
    }
}
__device__ __forceinline__ void s5_output(unsigned char* ws, int gw, int ngw, int lane) {
    for (int task = gw; task < SG * 16 * 2; task += ngw) {
        const int nh = task & 1, rt = (task >> 1) & 15, g = task >> 5, r32 = lane & 31, hi = lane >> 5;
        const bf16_t* A0 = (const bf16_t*)(ws + WS_UG) + ((size_t)(g * NROW + rt * 32 + r32)) * 256 + hi * 8;
        const bf16_t* A1 = (const bf16_t*)(ws + WS_HIN) + ((size_t)(g * NROW + rt * 32 + r32)) * 256 + hi * 8;
        const unsigned char* B = ws + WS_MFT + (size_t)(g * 8 + nh * 4) * 32 * 1024 + lane * 16;
        f32x16 acc[4] = {};
#pragma unroll 4
        for (int ks = 0; ks < 16; ++ks) { const bf16x8 a = *(const bf16x8*)(A0 + ks * 16);
#pragma unroll
            for (int nt = 0; nt < 4; ++nt) { const bf16x8 b = *(const bf16x8*)(B + (size_t)(nt * 32 + ks) * 1024); acc[nt] = __builtin_amdgcn_mfma_f32_32x32x16_bf16(a, b, acc[nt], 0, 0, 0); } }
#pragma unroll 4
        for (int ks = 0; ks < 16; ++ks) { const bf16x8 a = *(const bf16x8*)(A1 + ks * 16);
#pragma unroll
            for (int nt = 0; nt < 4; ++nt) { const bf16x8 b = *(const bf16x8*)(B + (size_t)(nt * 32 + 16 + ks) * 1024); acc[nt] = __builtin_amdgcn_mfma_f32_32x32x16_bf16(a, b, acc[nt], 0, 0, 0); } }
        bf16_t* GBp = (bf16_t*)(ws + WS_GB);
#pragma unroll
        for (int nt = 0; nt < 4; ++nt) { const int no = nh * 128 + nt * 32 + r32, tau = no >> 4, pp = no & 15;
#pragma unroll
            for (int r = 0; r < 16; ++r) { const int crw = rt * 32 + crow16(r, hi); const float y = acc[nt][r];
                const float z2 = 1.5957691216057308f * (y + 0.044715f * y * y * y);
                const float gl = y * __builtin_amdgcn_rcpf(1.0f + __builtin_amdgcn_exp2f(-1.4426950408889634f * z2));
                GBp[(size_t)(crw * 16 + tau) * SW + g * 16 + pp] = (bf16_t)(cvtpk(gl, 0.f) & 0xffffu); } }
    }
}
#define XB_TMO      128
#define XB_XCNT(j)  (256  + 64 * (j))
#define XB_XSUB(j)  (1280 + 64 * (j))
#define XB_XGEN(j)  (2304 + 64 * (j))
#define XB_TOP      3328
#define XB_TOPGEN   3392
#define XCD_BAR_WORDS 3456
#define XB_SPIN_CAP (1u << 18)

__device__ __forceinline__ unsigned xb_ld(unsigned* p)              { return __hip_atomic_load(p, __ATOMIC_RELAXED, __HIP_MEMORY_SCOPE_AGENT); }
__device__ __forceinline__ unsigned xb_add(unsigned* p, unsigned v) { return __hip_atomic_fetch_add(p, v, __ATOMIC_RELAXED, __HIP_MEMORY_SCOPE_AGENT); }
__device__ __forceinline__ unsigned xb_xcc_id() { return (unsigned)__builtin_amdgcn_s_getreg((3 << 11) | 20) & 0xFu; }
#define XB_SPIN(cond, bar) do { unsigned _sp = 0; while (cond) { __builtin_amdgcn_s_sleep(1); \
    if ((++_sp & 255u) == 0u) { if (xb_ld(&(bar)[XB_TMO])) break; if (_sp > XB_SPIN_CAP) { atomicAdd(&(bar)[XB_TMO], 1u); break; } } } } while (0)

struct XcdBarrier {
    unsigned* bar; unsigned x;
    volatile LAS unsigned* st;
};

__device__ __forceinline__ XcdBarrier xcd_barrier_post(unsigned* bar, volatile LAS unsigned* st) {
    XcdBarrier b; b.bar = bar; b.x = xb_xcc_id(); b.st = st;
    if (threadIdx.x == 0) (void)xb_add(&bar[XB_XCNT(b.x)], 1u);
    return b;
}
__device__ __forceinline__ void xcd_barrier_complete(unsigned* bar, unsigned x, unsigned& nloc, unsigned& nx) {
    const unsigned G = gridDim.x * gridDim.y * gridDim.z;
    unsigned sum, cnt, mine, sp = 0u;
    for (;;) {
        sum = 0u; cnt = 0u; mine = 0u;
#pragma unroll
        for (unsigned j = 0; j < 16; ++j) { const unsigned c = xb_ld(&bar[XB_XCNT(j)]); sum += c; cnt += (c > 0u) ? 1u : 0u; mine = (j == x) ? c : mine; }
        if (sum == G) break;
        __builtin_amdgcn_s_sleep(1);
        if ((++sp & 255u) == 0u) { if (xb_ld(&bar[XB_TMO])) break; if (sp > XB_SPIN_CAP) { atomicAdd(&bar[XB_TMO], 1u); break; } }
    }
    nloc = mine > 0u ? mine : 1u; nx = cnt > 0u ? cnt : 1u;
}

__device__ __forceinline__ void xcd_barrier(const XcdBarrier& b) {
    asm volatile("s_waitcnt vmcnt(0)" ::: "memory");
    __syncthreads();
    if (threadIdx.x == 0) {
        unsigned* bar = b.bar;
        __builtin_amdgcn_s_waitcnt(0);
        unsigned nloc = b.st[0], nx = b.st[1];
        if (nloc == 0u) { xcd_barrier_complete(bar, b.x, nloc, nx); b.st[0] = nloc; b.st[1] = nx; }
        const unsigned old = xb_add(&bar[XB_XSUB(b.x)], 1u);
        const unsigned gen = old / nloc;
        if (old + 1u == (gen + 1u) * nloc) {
            __builtin_amdgcn_fence(__ATOMIC_RELEASE, "agent");
            asm volatile("s_waitcnt vmcnt(0)" ::: "memory");
            const unsigned og = xb_add(&bar[XB_TOP], 1u);
            const unsigned tg = og / nx;
            if (og + 1u == (tg + 1u) * nx) xb_add(&bar[XB_TOPGEN], 1u);
            else XB_SPIN(xb_ld(&bar[XB_TOPGEN]) == tg, bar);
            __builtin_amdgcn_fence(__ATOMIC_ACQUIRE, "agent");
            xb_add(&bar[XB_XGEN(b.x)], 1u);
            asm volatile("s_waitcnt vmcnt(0)" ::: "memory");
        } else {
            XB_SPIN(xb_ld(&bar[XB_XGEN(b.x)]) == gen, bar);
            __builtin_amdgcn_fence(__ATOMIC_ACQUIRE, "agent");
            asm volatile("s_waitcnt vmcnt(0)" ::: "memory");
        }
    }
    __syncthreads();
}

__global__ void __launch_bounds__(NWAVES * 64, 2) fwd_megakernel(Params p) {
    extern __shared__ __attribute__((aligned(16))) unsigned char lds[];
    cg::grid_group grid = cg::this_grid();
    const int tid = threadIdx.x, lane = tid & 63, wave = __builtin_amdgcn_readfirstlane(tid >> 6);
    const int G = gridDim.x, bx = blockIdx.x, vcu = (G % 8 == 0) ? (bx % 8) * (G / 8) + bx / 8 : bx;
    const int gw = vcu * NWAVES + wave, ngw = G * NWAVES;
    const int HB = G / 2, hgw = (bx - HB) * NWAVES + wave, hngw = (G - HB) * NWAVES;
    unsigned char* ws = p.ws;
    LAS unsigned char* ldsl = (LAS unsigned char*)lds;
    LAS float* scr = (LAS float*)(ldsl + wave * 8448);
    const int lo = p.ph_lo, hi = p.ph_hi;
#ifndef GU_SPLIT_PCT
#define GU_SPLIT_PCT 55
#endif
    constexpr int GU_SPLIT = GU_ITEMS / 100 * GU_SPLIT_PCT;
    if (tid < 2) ((volatile LAS unsigned*)(ldsl + LDS_BARST))[tid] = 0u;
    __syncthreads();
    XcdBarrier bar = xcd_barrier_post((unsigned*)(ws + WS_CTL), (volatile LAS unsigned*)(ldsl + LDS_BARST));
    if (hi > 1000) grid.sync();
#ifndef PH_MASK
#define PH_MASK 0x7fff
#endif
#define IN(k) (((PH_MASK >> (k)) & 1) && lo <= (k) && (k) < hi)
#ifndef DBL_MASK
#define DBL_MASK 0
#endif
#define REP(k) for (int _rp = 0; _rp < 1 + ((DBL_MASK >> (k)) & 1); ++_rp)
#ifndef SYNC_REP
#define SYNC_REP 1
#endif
#ifdef TSA
#define STAMP(i) do { if (bx == 0 && tid == 0) ((unsigned long long*)(ws + WS_CTL + 14336))[i] = __builtin_amdgcn_s_memrealtime(); } while (0)
#else
#define STAMP(i) do {} while (0)
#endif
#define SEAM(k) do { if (IN(k) && IN((k) + 1)) { for (int _r = 0; _r < SYNC_REP; ++_r) xcd_barrier(bar); } STAMP((k) + 1); } while (0)
    bf16_t* XN = (bf16_t*)(ws + WS_XN); bf16_t* X1 = (bf16_t*)(ws + WS_X1); float* RS = (float*)(ws + WS_RS); bf16_t* HFF = (bf16_t*)(ws + WS_HFF); bf16_t* Y = (bf16_t*)(ws + WS_Y); float* SSQ = (float*)(ws + WS_SSQ); float* SSQ2 = (float*)(ws + WS_SSQ2);
    bf16_t* QKV = (bf16_t*)(ws + WS_QKV); bf16_t* UG = (bf16_t*)(ws + WS_UG); bf16_t* GB = (bf16_t*)(ws + WS_GB); bf16_t* SPRE = (bf16_t*)(ws + WS_SPRE);

    STAMP(0);
    if (IN(0)) REP(0) {
        const int TB = G >= 128 ? G - 64 : G, NS = 2 * TB + (G - TB);
        for (int g = bx - TB; g >= 0 && g < SG; g += G - TB) s5_tables(p, g, (float*)lds);
        if (G < 128) for (int g = bx; g < SG; g += G) s5_tables(p, g, (float*)lds);
        const int nsl = bx < TB ? 2 : 1, sl0 = bx < TB ? 2 * bx : 2 * TB + (bx - TB);
        for (int sl = 0; sl < nsl; ++sl) {
            const int sgw = (sl0 + sl) * NWAVES + wave, sngw = NS * NWAVES;
            convert_gateup(p.in[2], p.in[3], p.in[1], ws, scr, sgw, sngw, lane);
            prenorm_rows(p.in[0], XN, RS, sgw, sngw, lane);
            convert_plain(p.in[24], DM, DM, (bf16_t*)(ws + WS_WOUT), scr, sgw, sngw, lane);
            convert_plain(p.in[21], SW, SW, (bf16_t*)(ws + WS_WGLU), scr, sgw, sngw, lane);
        }
    }
    SEAM(0);
#define FFN_GATEUP(AIN) do { pg8::Gemm g{AIN, (const bf16_t*)(ws + WS_W1G), MT, NGU, DM}; pg8::StaticOrder S; S.init(MT, NGU, G, bx); \
            pg8::EpiSwiGLU E{HFF, DFF, RS}; pg8::gemm_phase<pg8::EpiSwiGLU, pg8::StaticOrder, true, true>(ldsl, g, S, E); } while (0)
#define FFN_DOWN() do { pg8::Gemm g{HFF, (const bf16_t*)(ws + WS_W1D), MT, DM, DFF}; pg8::StaticOrder S; S.init(MT, DM, G, bx); \
            pg8::EpiYSsq E{Y, SSQ, 32}; pg8::gemm_phase<pg8::EpiYSsq, pg8::StaticOrder, true, true>(ldsl, g, S, E); } while (0)
    if (IN(1)) REP(1) { FFN_GATEUP(XN);
        if (bx >= HB) {
            convert_plain(p.in[4], DFF, DM, (bf16_t*)(ws + WS_W1D), scr, hgw, hngw, lane);
            convert_plain(p.in[7], DM, INC, (bf16_t*)(ws + WS_WIN), scr, hgw, hngw, lane, p.in[6]);
        } }
    SEAM(1);
    if (IN(2)) REP(2) FFN_DOWN();
    SEAM(2);
    if (IN(3)) REP(3) resid_rows<false, false>(p.in[0], Y, SSQ, 32, p.in[5], 0.5f, nullptr, X1, RS, gw, ngw, lane);
    SEAM(3);
    if (IN(4)) REP(4) {
        pg8::Gemm g{X1, (const bf16_t*)(ws + WS_WIN), MT, INC, DM}; pg8::StaticOrder S; S.init(MT, INC, G, bx);
        pg8::EpiQKVU E{QKV, UG, 0.125f * 1.4426950408889634f, RS};
        pg8::gemm_phase<pg8::EpiQKVU, pg8::StaticOrder, true, true>(ldsl, g, S, E);
    }
    SEAM(4);
    if (IN(5)) {
        float lam;
        { const float a = wave_sum(p.in[8][lane] * p.in[9][lane]), c = wave_sum(p.in[10][lane] * p.in[11][lane]); lam = expf(a) - expf(c) + 0.2f; }
        #ifndef ATT_REP
#define ATT_REP 1
#endif
        for (int u = vcu; u < ATT_REP * BATCH * 8 * 16; u += G) att::attn_unit(QKV, XN, (u >> 7) & 3, (u >> 4) & 7, u & 15, lam, p.in[12], (char*)lds);
#ifndef EST_REP
#define EST_REP 1
#endif
        for (int _r = 0; _r < EST_REP; ++_r) s5_estate(ws, gw, ngw, lane);
    }
    SEAM(5);
    if (IN(6)) REP(6) { s5_scan(ws, gw, ngw, lane);
        if (vcu >= 64) convert_gateup(p.in[27], p.in[28], p.in[26], ws, scr, (vcu - 64) * NWAVES + wave, (G - 64) * NWAVES, lane, 0, GU_SPLIT); }
    SEAM(6);
    if (IN(7)) REP(7) s5_output(ws, gw, ngw, lane);
    SEAM(7);
    if (IN(8)) REP(8) {
        pg8::Gemm g{GB, (const bf16_t*)(ws + WS_WGLU), MT, SW, SW}; pg8::StaticOrder S; S.init(MT, SW, G, bx);
        pg8::EpiGLU E{GB, SPRE, p.in[22], SSQ2};
        pg8::gemm_phase<pg8::EpiGLU, pg8::StaticOrder, true, true>(ldsl, g, S, E);
        if (bx >= HB) convert_gateup(p.in[27], p.in[28], p.in[26], ws, scr, hgw, hngw, lane, GU_SPLIT, GU_ITEMS);
    }
    SEAM(8);
    if (IN(9)) REP(9) snorm_rows(SPRE, SSQ2, p.in[23], XN, gw, ngw, lane);
    SEAM(9);
    if (IN(10)) REP(10) {
        pg8::Gemm g{XN, (const bf16_t*)(ws + WS_WOUT), MT, DM, DM}; pg8::StaticOrder S; S.init(MT, DM, G, bx);
        pg8::EpiYSsq E{Y, SSQ, 32};
        pg8::gemm_phase<pg8::EpiYSsq, pg8::StaticOrder, true, true>(ldsl, g, S, E);
    }
    SEAM(10);
    if (IN(11)) resid_rows<true, false>(X1, Y, SSQ, 32, p.in[25], 1.0f, nullptr, X1, RS, gw, ngw, lane);
    SEAM(11);
    if (IN(12)) { FFN_GATEUP(X1);
        if (bx >= HB) convert_plain(p.in[29], DFF, DM, (bf16_t*)(ws + WS_W1D), scr, hgw, hngw, lane); }
    SEAM(12);
    if (IN(13)) FFN_DOWN();
    SEAM(13);
    if (IN(14)) resid_rows<true, true>(X1, Y, SSQ, 32, p.in[30], 0.5f, p.out, nullptr, nullptr, gw, ngw, lane);
#ifdef TSA
    xcd_barrier(bar); STAMP(15); xcd_barrier(bar);
    { const unsigned long long* TS = (const unsigned long long*)(ws + WS_CTL + 14336);
      const float ta = (float)(TS[TSA + 1] - TS[TSA]) * 0.01f, tb = (TSB == 99) ? 100.f : (float)(TS[(TSB == 99 ? 0 : TSB) + 1] - TS[(TSB == 99 ? 0 : TSB)]) * 0.01f;
      for (size_t i = (size_t)bx * 512 + tid; i < (size_t)MT * DM; i += (size_t)G * 512) p.out[i] += 1000.f * tb;
      __syncthreads();
      if (bx == 0 && tid == 0) p.out[0] += 64000.f * ta; }
#endif
#undef IN
#undef SEAM
}

extern "C" void kernel_launch(void* const* d_in, const int* in_sizes, int n_in, void* d_out, int out_size, void* d_ws, size_t ws_size, hipStream_t stream) {
    static int grid = 0;
    if (grid == 0) {
        if (n_in != 31 || in_sizes[0] != MT * DM || out_size != MT * DM || ws_size < WS_END) {
            fprintf(stderr, "kernel_launch: shape/workspace mismatch: n_in %d in0 %d out %d ws %zu (need %zu)\n", n_in, n_in > 0 ? in_sizes[0] : -1, out_size, ws_size, (size_t)WS_END); grid = -1; return; }
        int dev = 0, cus = 0, per_cu = 0;
        hipGetDevice(&dev); hipDeviceGetAttribute(&cus, hipDeviceAttributeMultiprocessorCount, dev);
        if (hipFuncSetAttribute((const void*)fwd_megakernel, hipFuncAttributeMaxDynamicSharedMemorySize, LDS_BYTES) != hipSuccess) { fprintf(stderr, "kernel_launch: hipFuncSetAttribute failed\n"); grid = -1; return; }
        if (hipOccupancyMaxActiveBlocksPerMultiprocessor(&per_cu, (const void*)fwd_megakernel, NWAVES * 64, LDS_BYTES) != hipSuccess || per_cu < 1) { fprintf(stderr, "kernel_launch: occupancy query says %d\n", per_cu); (void)hipGetLastError(); per_cu = 1; }
        grid = cus;
        fprintf(stderr, "kernel_launch: grid %d (cus %d x per_cu %d), ws %zu need %zu\n", grid, cus, per_cu, ws_size, (size_t)WS_END);
    }
    if (grid < 0) return;
    if (hipMemsetAsync((char*)d_ws + WS_CTL, 0, CTL_BYTES, stream) != hipSuccess) { fprintf(stderr, "kernel_launch: memset failed\n"); return; }
    Params p{};
    for (int i = 0; i < 31; ++i) p.in[i] = (const float*)d_in[i];
    p.out = (float*)d_out; p.ws = (unsigned char*)d_ws;
#if MK_N_LAUNCHES == 1
    p.ph_lo = 0; p.ph_hi = 15;
    void* args[] = {&p};
    hipError_t e = hipLaunchCooperativeKernel((const void*)fwd_megakernel, dim3(grid), dim3(NWAVES * 64), args, LDS_BYTES, stream);
    if (e != hipSuccess) fprintf(stderr, "cooperative launch failed: %s (grid %d)\n", hipGetErrorString(e), grid);
#else
    for (int k = 0; k < 15; ++k) { p.ph_lo = k; p.ph_hi = k + 1; hipLaunchKernelGGL(fwd_megakernel, dim3(grid), dim3(NWAVES * 64), LDS_BYTES, stream, p); }
#endif
}
```
